# Optimizing an MI355X kernel written in HIP

```python
import jax
import jax.numpy as jnp
from jax import lax
import numpy as np


D_MODEL = 2048
BATCH = 1
SEQ = 8192
DEPTH = 4

ML_HEADS = 4
ML_DIM = D_MODEL // 16
ML_WIDTH = ML_HEADS * ML_DIM
ML_CONV = 3
FORGET_BIAS_LO = 3.0
FORGET_BIAS_HI = 6.0
NEG_INIT = -1e30
RET_HEADS = 4
RET_QK = D_MODEL // 32
RET_V = D_MODEL // 16
RET_WIDTH = RET_HEADS * RET_V
RET_DECAY_BASE = 5.0
MLA_HEADS = 8
MLA_NOPE = D_MODEL // 16
ROPE_DIM = D_MODEL // 32
MLA_V = D_MODEL // 16
MLA_Q_RANK = D_MODEL // 4
MLA_KV_RANK = D_MODEL // 8
MLA_WIDTH = MLA_HEADS * MLA_V
MIX_WIDTH = ML_WIDTH + RET_WIDTH + MLA_WIDTH
IN_SIZES = (ML_WIDTH, ML_WIDTH, ML_WIDTH, ML_WIDTH, 4 * ML_HEADS,
            RET_HEADS * RET_QK, RET_HEADS * RET_QK, RET_WIDTH, RET_WIDTH,
            MLA_Q_RANK, MLA_KV_RANK, ROPE_DIM)
IN_WIDTH = sum(IN_SIZES)
D_FF = 4 * D_MODEL
CHUNK = 128
Q_BLOCK = 128
ROPE_THETA = 10000.0
EPS = 1e-6

kernel_name = 'hybrid_mlstm_retention_mla_encoder'


def _split_points():
    pts, acc = [], 0
    for s in IN_SIZES[:-1]:
        acc += s
        pts.append(acc)
    return pts


def _rms(x, g):
    xf = x.astype(jnp.float32)
    y = xf * lax.rsqrt(jnp.mean(xf * xf, axis=-1, keepdims=True) + EPS)
    return (y * g.astype(jnp.float32)).astype(x.dtype)


def _head_rms(h, g):
    B, S, H, d = h.shape
    hf = h.astype(jnp.float32)
    y = hf * lax.rsqrt(jnp.mean(hf * hf, axis=-1, keepdims=True) + EPS)
    return y.reshape(B, S, H * d) * g.astype(jnp.float32)


def _rope_tables(positions):
    half = ROPE_DIM // 2
    inv = ROPE_THETA ** (-jnp.arange(half, dtype=jnp.float32) / half)
    ang = positions.astype(jnp.float32)[..., None] * inv
    return jnp.cos(ang)[:, :, None, :], jnp.sin(ang)[:, :, None, :]


def _apply_rope(x, cos, sin):
    x1, x2 = jnp.split(x.astype(jnp.float32), 2, axis=-1)
    return jnp.concatenate([x1 * cos - x2 * sin, x2 * cos + x1 * sin], axis=-1).astype(x.dtype)


def _centred_conv(x, w):
    K = w.shape[0]
    pad = K // 2
    S = x.shape[1]
    xp = jnp.pad(x, ((0, 0), (pad, pad), (0, 0)))
    return sum(xp[:, j:j + S] * w[j] for j in range(K))


def _mlstm_chunkwise(q, k, v, log_i, log_f):
    B, H, S, d = q.shape
    nc = S // CHUNK
    qc = (q * d ** -0.5).reshape(B, H, nc, CHUNK, d)
    kc = k.reshape(B, H, nc, CHUNK, d)
    vc = v.reshape(B, H, nc, CHUNK, d)
    lic = log_i.reshape(B, H, nc, CHUNK)
    b = jnp.cumsum(log_f.reshape(B, H, nc, CHUNK), axis=-1)
    b_last = b[..., -1]
    w_end = b_last[..., None] - b + lic
    m_loc = jnp.max(w_end, axis=-1)
    e_end = jnp.exp(w_end - m_loc[..., None])
    c_loc = jnp.einsum('bhnld,bhnle,bhnl->bhnde', kc, vc, e_end)
    n_loc = jnp.einsum('bhnld,bhnl->bhnd', kc, e_end)

    def step(carry, inp):
        c, n, m = carry
        c_l, n_l, m_l, b_l = inp
        m_new = jnp.maximum(b_l + m, m_l)
        a = jnp.exp(b_l + m - m_new)
        g = jnp.exp(m_l - m_new)
        c_new = a[..., None, None] * c + g[..., None, None] * c_l
        n_new = a[..., None] * n + g[..., None] * n_l
        return (c_new, n_new, m_new), (c, n, m)

    init = (jnp.zeros((B, H, d, d), jnp.float32), jnp.zeros((B, H, d), jnp.float32),
            jnp.full((B, H), NEG_INIT, jnp.float32))
    xs = (jnp.moveaxis(c_loc, 2, 0), jnp.moveaxis(n_loc, 2, 0),
          jnp.moveaxis(m_loc, 2, 0), jnp.moveaxis(b_last, 2, 0))
    _, (c_st, n_st, m_st) = lax.scan(step, init, xs)
    c_st = jnp.moveaxis(c_st, 0, 2)
    n_st = jnp.moveaxis(n_st, 0, 2)
    m_st = jnp.moveaxis(m_st, 0, 2)

    mask = jnp.tril(jnp.ones((CHUNK, CHUNK), dtype=bool))
    d_log = jnp.where(mask, b[..., :, None] - b[..., None, :] + lic[..., None, :], -jnp.inf)
    inter_log = b + m_st[..., None]
    m_t = jnp.maximum(jnp.max(d_log, axis=-1), inter_log)
    w_intra = jnp.exp(d_log - m_t[..., None])
    w_inter = jnp.exp(inter_log - m_t)
    s = jnp.einsum('bhnld,bhnsd->bhnls', qc, kc) * w_intra
    num = (jnp.einsum('bhnls,bhnse->bhnle', s, vc)
           + w_inter[..., None] * jnp.einsum('bhnld,bhnde->bhnle', qc, c_st))
    den = jnp.sum(s, axis=-1) + w_inter * jnp.einsum('bhnld,bhnd->bhnl', qc, n_st)
    h = num / jnp.maximum(jnp.abs(den), jnp.exp(-m_t))[..., None]
    return h.reshape(B, H, S, d)


def _retention_chunkwise(q, k, v, log_gamma):
    B, H, S, dk = q.shape
    dv = v.shape[-1]
    nc = S // CHUNK
    qc = q.reshape(B, H, nc, CHUNK, dk)
    kc = k.reshape(B, H, nc, CHUNK, dk)
    vc = v.reshape(B, H, nc, CHUNK, dv)
    idx = jnp.arange(CHUNK, dtype=jnp.float32)
    diff = idx[:, None] - idx[None, :]
    lower = diff >= 0
    decay = jnp.where(lower[None], jnp.exp(jnp.where(lower, diff, 0.0)[None] * log_gamma[:, None, None]), 0.0)
    scores = jnp.einsum('bhnld,bhnsd->bhnls', qc, kc) * decay[None, :, None]
    y_intra = jnp.einsum('bhnls,bhnse->bhnle', scores, vc)
    zeta = jnp.exp((CHUNK - 1.0 - idx)[None, :] * log_gamma[:, None])
    r_loc = jnp.einsum('bhnld,bhnle,hl->bhnde', kc, vc, zeta)
    chunk_decay = jnp.exp(CHUNK * log_gamma)[None, :, None, None]

    def step(r, r_l):
        return chunk_decay * r + r_l, r

    _, r_start = lax.scan(step, jnp.zeros((B, H, dk, dv), jnp.float32), jnp.moveaxis(r_loc, 2, 0))
    r_start = jnp.moveaxis(r_start, 0, 2)
    inner = jnp.exp((idx + 1.0)[None, :] * log_gamma[:, None])
    y_inter = jnp.einsum('bhnld,bhnde->bhnle', qc, r_start) * inner[None, :, None, :, None]
    return (y_intra + y_inter).reshape(B, H, S, dv)


def _mlstm_group(q, k, v, o, gates, b_gates, w_conv, g_out):
    B, S, _ = q.shape
    qk = jax.nn.silu(_centred_conv(jnp.concatenate([q, k], axis=-1), w_conv))
    q, k = jnp.split(qk, 2, axis=-1)

    def to_heads(t):
        return t.astype(jnp.float32).reshape(B, S, ML_HEADS, ML_DIM).transpose(0, 2, 1, 3)

    qh, kh, vh = to_heads(q), to_heads(k), to_heads(v)
    gp = (gates + b_gates).astype(jnp.float32).reshape(B, S, 4, ML_HEADS).transpose(2, 0, 3, 1)
    i_fwd, f_fwd, i_bwd, f_bwd = gp[0], gp[1], gp[2], gp[3]

    def flip(t):
        return jnp.flip(t, axis=2)

    h_fwd = _mlstm_chunkwise(qh, kh, vh, i_fwd, jax.nn.log_sigmoid(f_fwd))
    h_bwd = flip(_mlstm_chunkwise(flip(qh), flip(kh), flip(vh), flip(i_bwd), jax.nn.log_sigmoid(flip(f_bwd))))
    h = (h_fwd + h_bwd).transpose(0, 2, 1, 3)
    return (jax.nn.sigmoid(o.astype(jnp.float32)) * _head_rms(h, g_out)).astype(v.dtype)


def _retention_group(q, k, v, g, cos, sin, g_out):
    B, S, _ = q.shape
    qh = _apply_rope(q.reshape(B, S, RET_HEADS, RET_QK), cos, sin).astype(jnp.float32).transpose(0, 2, 1, 3)
    kh = (_apply_rope(k.reshape(B, S, RET_HEADS, RET_QK), cos, sin).astype(jnp.float32)
          * RET_QK ** -0.5).transpose(0, 2, 1, 3)
    vh = v.astype(jnp.float32).reshape(B, S, RET_HEADS, RET_V).transpose(0, 2, 1, 3)
    log_gamma = jnp.log1p(-jnp.exp2(-RET_DECAY_BASE - jnp.arange(RET_HEADS, dtype=jnp.float32)))

    def flip(t):
        return jnp.flip(t, axis=2)

    y = (_retention_chunkwise(qh, kh, vh, log_gamma)
         + flip(_retention_chunkwise(flip(qh), flip(kh), flip(vh), log_gamma[::-1])))
    y = y.transpose(0, 2, 1, 3)
    return (jax.nn.silu(g.astype(jnp.float32)) * _head_rms(y, g_out)).astype(v.dtype)


def _mla_group(c_q, c_kv, k_rope, cos, sin, g_q_norm, w_q_up, g_kv_norm, w_kv_up):
    B, S, _ = c_q.shape
    q = (_rms(c_q, g_q_norm) @ w_q_up).reshape(B, S, MLA_HEADS, MLA_NOPE + ROPE_DIM)
    q = jnp.concatenate([q[..., :MLA_NOPE], _apply_rope(q[..., MLA_NOPE:], cos, sin)], axis=-1)
    kv = (_rms(c_kv, g_kv_norm) @ w_kv_up).reshape(B, S, MLA_HEADS, MLA_NOPE + MLA_V)
    k_nope, v = kv[..., :MLA_NOPE], kv[..., MLA_NOPE:]
    k_r = _apply_rope(k_rope[:, :, None, :], cos, sin)
    k = jnp.concatenate([k_nope, jnp.broadcast_to(k_r, (B, S, MLA_HEADS, ROPE_DIM))], axis=-1)
    scale = (MLA_NOPE + ROPE_DIM) ** -0.5
    nb = S // Q_BLOCK
    q_blocks = q.reshape(B, nb, Q_BLOCK, MLA_HEADS, MLA_NOPE + ROPE_DIM).transpose(1, 0, 2, 3, 4)

    def attend(qb):
        s = jnp.einsum('bqhd,bkhd->bhqk', qb, k).astype(jnp.float32) * scale
        p = jax.nn.softmax(s, axis=-1)
        return jnp.einsum('bhqk,bkhd->bqhd', p.astype(v.dtype), v)

    o = lax.map(attend, q_blocks)
    return o.transpose(1, 0, 2, 3, 4).reshape(B, S, MLA_WIDTH)


def _mixer(h, cos, sin, w_in, b_gates, w_conv, g_ml_out, g_ret_out, g_q_norm, w_q_up,
           g_kv_norm, w_kv_up, w_out):
    proj = h @ w_in
    (ml_q, ml_k, ml_v, ml_o, ml_gates, r_q, r_k, r_v, r_g,
     c_q, c_kv, k_rope) = jnp.split(proj, _split_points(), axis=-1)
    y_ml = _mlstm_group(ml_q, ml_k, ml_v, ml_o, ml_gates, b_gates, w_conv, g_ml_out)
    y_ret = _retention_group(r_q, r_k, r_v, r_g, cos, sin, g_ret_out)
    y_mla = _mla_group(c_q, c_kv, k_rope, cos, sin, g_q_norm, w_q_up, g_kv_norm, w_kv_up)
    y = jnp.concatenate([y_ml.astype(h.dtype), y_ret.astype(h.dtype), y_mla.astype(h.dtype)], axis=-1)
    return y @ w_out


def setup_inputs(seed: int = 0) -> dict:
    key = jax.random.key(seed)
    ks = jax.random.split(key, 20)

    def nrm(k, shape, scale):
        return jax.random.normal(k, shape, jnp.float32) * scale

    def gain(k, shape):
        return 1.0 + 0.02 * jax.random.normal(k, shape, jnp.float32)

    x = nrm(ks[0], (BATCH, SEQ, D_MODEL), 1.0)
    positions = (jax.random.randint(ks[1], (BATCH, 1), 0, 1024, dtype=jnp.int32)
                 + jnp.arange(SEQ, dtype=jnp.int32)[None, :]).astype(jnp.int32)
    forget = jnp.linspace(FORGET_BIAS_LO, FORGET_BIAS_HI, ML_HEADS, dtype=jnp.float32)
    zeros = jnp.zeros((ML_HEADS,), jnp.float32)
    b_gates = jnp.concatenate([zeros, forget, zeros, forget])[None, :] + nrm(ks[2], (DEPTH, 4 * ML_HEADS), 0.1)
    return {
        'x': x,
        'positions': positions,
        'g_mix': gain(ks[3], (DEPTH, D_MODEL)),
        'w_in': nrm(ks[4], (DEPTH, D_MODEL, IN_WIDTH), D_MODEL ** -0.5),
        'b_gates': b_gates,
        'w_conv': nrm(ks[5], (DEPTH, ML_CONV, 2 * ML_WIDTH), ML_CONV ** -0.5),
        'g_ml_out': gain(ks[6], (DEPTH, ML_WIDTH)),
        'g_ret_out': gain(ks[7], (DEPTH, RET_WIDTH)),
        'g_q_norm': gain(ks[8], (DEPTH, MLA_Q_RANK)),
        'w_q_up': nrm(ks[9], (DEPTH, MLA_Q_RANK, MLA_HEADS * (MLA_NOPE + ROPE_DIM)), MLA_Q_RANK ** -0.5),
        'g_kv_norm': gain(ks[10], (DEPTH, MLA_KV_RANK)),
        'w_kv_up': nrm(ks[11], (DEPTH, MLA_KV_RANK, MLA_HEADS * (MLA_NOPE + MLA_V)), MLA_KV_RANK ** -0.5),
        'w_out': nrm(ks[12], (DEPTH, MIX_WIDTH, D_MODEL), MIX_WIDTH ** -0.5),
        'g_ffn': gain(ks[13], (DEPTH, D_MODEL)),
        'w_ff1': nrm(ks[14], (DEPTH, D_MODEL, D_FF), D_MODEL ** -0.5),
        'w_ff2': nrm(ks[15], (DEPTH, D_FF, D_MODEL), D_FF ** -0.5),
        'g_final': gain(ks[16], (D_MODEL,)),
    }


def reference(x, positions, g_mix, w_in, b_gates, w_conv, g_ml_out, g_ret_out, g_q_norm, w_q_up,
              g_kv_norm, w_kv_up, w_out, g_ffn, w_ff1, w_ff2, g_final):
    cos, sin = _rope_tables(positions)
    for l in range(DEPTH):
        h = _rms(x, g_mix[l])
        x = x + _mixer(h, cos, sin, w_in[l], b_gates[l], w_conv[l], g_ml_out[l], g_ret_out[l],
                       g_q_norm[l], w_q_up[l], g_kv_norm[l], w_kv_up[l], w_out[l])
        u = _rms(x, g_ffn[l])
        x = x + jnp.square(jax.nn.relu(u @ w_ff1[l])) @ w_ff2[l]
    return _rms(x, g_final)
```

```cpp
#include <hip/hip_runtime.h>
#include <hip/hip_cooperative_groups.h>
#include <cstdio>
#include <cstdint>
namespace cg = cooperative_groups;

typedef unsigned short bf16_t;
typedef short bf16x8 __attribute__((ext_vector_type(8)));
typedef short s16x4 __attribute__((ext_vector_type(4)));
typedef float f32x4 __attribute__((ext_vector_type(4)));
typedef float f32x16 __attribute__((ext_vector_type(16)));
typedef unsigned u32x4 __attribute__((ext_vector_type(4)));
typedef unsigned u32x2 __attribute__((ext_vector_type(2)));
#define LAS __attribute__((address_space(3)))

constexpr int S_ = 8192, DM = 2048, NPROJ = 4432, NPROJP = 4608, DFF = 8192, NLAYER = 4;
constexpr float EPS_ = 1e-6f;
constexpr int LDS_BYTES = 147456;

constexpr int PC_MLQ = 0, PC_MLK = 512, PC_MLV = 1024, PC_MLO = 1536, PC_GATE = 2048, PC_RQ = 2064, PC_RK = 2320, PC_RV = 2576, PC_RG = 3088,
              PC_CQ = 3600, PC_CKV = 4112, PC_KR = 4368;

constexpr size_t SZ_WIN = (size_t)NPROJP * DM * 2, SZ_WQ = (size_t)1536 * 512 * 2, SZ_WKV = (size_t)2048 * 256 * 2, SZ_WOUT = (size_t)DM * DM * 2,
                 SZ_W1 = (size_t)DFF * DM * 2, SZ_W2 = (size_t)DM * DFF * 2;
constexpr size_t WO_IN = 0, WO_Q = WO_IN + SZ_WIN, WO_KV = WO_Q + SZ_WQ, WO_OUT = WO_KV + SZ_WKV, WO_1 = WO_OUT + SZ_WOUT, WO_2 = WO_1 + SZ_W1, SZ_WL = WO_2 + SZ_W2;
constexpr size_t OFF_W = 0;
constexpr size_t OFF_X = OFF_W + NLAYER * SZ_WL;
constexpr size_t OFF_H = OFF_X + (size_t)S_ * DM * 4;
constexpr size_t OFF_Y = OFF_H + (size_t)S_ * DM * 2;
constexpr size_t OFF_ROPE = OFF_Y + (size_t)S_ * DM * 2;
constexpr size_t OFF_G = OFF_ROPE + (size_t)S_ * 32 * 4 * 2;
constexpr size_t OFF_QKML = OFF_G + (size_t)S_ * 16 * 4;
constexpr size_t OFF_RQK = OFF_QKML + (size_t)S_ * 1024 * 2;
constexpr size_t OFF_CQN = OFF_RQK + (size_t)S_ * 512 * 2;
constexpr size_t OFF_CKVN = OFF_CQN + (size_t)S_ * 512 * 2;
constexpr size_t OFF_CLOC = OFF_CKVN + (size_t)S_ * 256 * 2;
constexpr size_t OFF_CST = OFF_CLOC + (size_t)512 * 16384 * 4;
constexpr size_t OFF_NLOC = OFF_CST + (size_t)512 * 16384 * 2;
constexpr size_t OFF_NST = OFF_NLOC + (size_t)512 * 128 * 4;
constexpr size_t OFF_MLOC = OFF_NST + (size_t)512 * 128 * 4;
constexpr size_t OFF_BLAST = OFF_MLOC + 2048;
constexpr size_t OFF_MST = OFF_BLAST + 2048;
constexpr size_t OFF_RLOC = OFF_MST + 2048;
constexpr size_t OFF_RST = OFF_RLOC + (size_t)512 * 8192 * 4;
constexpr size_t OFF_BAR = OFF_RST + (size_t)512 * 8192 * 2;
constexpr size_t OFF_SSQA = OFF_BAR + 16384;
constexpr size_t OFF_SSQB = OFF_SSQA + (size_t)S_ * 8;
constexpr size_t OFF_MIX = OFF_SSQB + (size_t)S_ * 8;
constexpr size_t OFF_PROJ = OFF_MIX;
constexpr size_t OFF_Q = OFF_PROJ + (size_t)S_ * NPROJP * 2;
constexpr size_t OFF_K = OFF_Q + (size_t)8 * S_ * 192 * 2;
constexpr size_t OFF_V = OFF_K + (size_t)8 * S_ * 192 * 2;
constexpr size_t OFF_END0 = OFF_V + (size_t)8 * S_ * 128 * 2;
constexpr size_t OFF_ACT = OFF_MIX;
constexpr size_t OFF_END1 = OFF_ACT + (size_t)S_ * DFF * 2;
constexpr size_t WS_END = OFF_END0 > OFF_END1 ? OFF_END0 : OFF_END1;

struct Params {
    const float* x; const int* pos; const float* g_mix; const float* w_in; const float* b_gates; const float* w_conv;
    const float* g_ml_out; const float* g_ret_out; const float* g_q_norm; const float* w_q_up; const float* g_kv_norm; const float* w_kv_up;
    const float* w_out; const float* g_ffn; const float* w_ff1; const float* w_ff2; const float* g_final;
    float* out; unsigned char* ws;
    int ph_lo, ph_hi;
};

__device__ __forceinline__ unsigned cvt_pk_bf16(float lo, float hi) { unsigned r; asm volatile("v_cvt_pk_bf16_f32 %0, %1, %2" : "=v"(r) : "v"(lo), "v"(hi)); return r; }
__device__ __forceinline__ int ltid() { int t = threadIdx.x; asm volatile("" : "+v"(t)); return t; }
__device__ __forceinline__ int lbid() { int t = blockIdx.x; asm volatile("" : "+s"(t)); return t; }
__device__ __forceinline__ float bf2f(bf16_t b) { return __uint_as_float(((unsigned)b) << 16); }
__device__ __forceinline__ float bflo(unsigned w) { return __uint_as_float(w << 16); }
__device__ __forceinline__ float bfhi(unsigned w) { return __uint_as_float(w & 0xffff0000u); }
__device__ __forceinline__ bf16_t f2bf(float f) { return (bf16_t)(cvt_pk_bf16(f, 0.f) & 0xffffu); }
__device__ __forceinline__ float wave_sum(float v) { for (int o = 32; o > 0; o >>= 1) v += __shfl_xor(v, o); return v; }
__device__ __forceinline__ float wave_max(float v) { for (int o = 32; o > 0; o >>= 1) v = fmaxf(v, __shfl_xor(v, o)); return v; }
__device__ __forceinline__ void unpack8(u32x4 w, float* f) { f[0] = bflo(w.x); f[1] = bfhi(w.x); f[2] = bflo(w.y); f[3] = bfhi(w.y); f[4] = bflo(w.z); f[5] = bfhi(w.z); f[6] = bflo(w.w); f[7] = bfhi(w.w); }
__device__ __forceinline__ u32x4 pack8(const float* f) { u32x4 w; w.x = cvt_pk_bf16(f[0], f[1]); w.y = cvt_pk_bf16(f[2], f[3]); w.z = cvt_pk_bf16(f[4], f[5]); w.w = cvt_pk_bf16(f[6], f[7]); return w; }


#define XB_TMO      128
#define XB_XCNT(j)  (256  + 64 * (j))
#define XB_XSUB(j)  (1280 + 64 * (j))
#define XB_XGEN(j)  (2304 + 64 * (j))
#define XB_TOP      3328
#define XB_TOPGEN   3392
#define XCD_BAR_WORDS 3456
#define XB_SPIN_CAP (1u << 18)

__device__ __forceinline__ unsigned xb_ld(unsigned* p)              { return __hip_atomic_load(p, __ATOMIC_RELAXED, __HIP_MEMORY_SCOPE_AGENT); }
__device__ __forceinline__ unsigned xb_add(unsigned* p, unsigned v) { return __hip_atomic_fetch_add(p, v, __ATOMIC_RELAXED, __HIP_MEMORY_SCOPE_AGENT); }
__device__ __forceinline__ unsigned xb_xcc_id() { return (unsigned)__builtin_amdgcn_s_getreg((3 << 11) | 20) & 0xFu; }
#define XB_SPIN(cond, bar) do { unsigned _sp = 0; while (cond) { __builtin_amdgcn_s_sleep(1); \
    if ((++_sp & 255u) == 0u) { if (xb_ld(&(bar)[XB_TMO])) break; if (_sp > XB_SPIN_CAP) { atomicAdd(&(bar)[XB_TMO], 1u); break; } } } } while (0)

struct XcdBarrier {
    unsigned* bar; unsigned x;
    volatile LAS unsigned* st;
};

__device__ __forceinline__ XcdBarrier xcd_barrier_post(unsigned* bar, volatile LAS unsigned* st) {
    XcdBarrier b; b.bar = bar; b.x = xb_xcc_id(); b.st = st;
    if (threadIdx.x == 0) (void)xb_add(&bar[XB_XCNT(b.x)], 1u);
    return b;
}
__device__ __forceinline__ void xcd_barrier_complete(unsigned* bar, unsigned x, unsigned& nloc, unsigned& nx) {
    const unsigned G = gridDim.x * gridDim.y * gridDim.z;
    unsigned sum, cnt, mine, sp = 0u;
    for (;;) {
        sum = 0u; cnt = 0u; mine = 0u;
#pragma unroll
        for (unsigned j = 0; j < 16; ++j) { const unsigned c = xb_ld(&bar[XB_XCNT(j)]); sum += c; cnt += (c > 0u) ? 1u : 0u; mine = (j == x) ? c : mine; }
        if (sum == G) break;
        __builtin_amdgcn_s_sleep(1);
        if ((++sp & 255u) == 0u) { if (xb_ld(&bar[XB_TMO])) break; if (sp > XB_SPIN_CAP) { atomicAdd(&bar[XB_TMO], 1u); break; } }
    }
    nloc = mine > 0u ? mine : 1u; nx = cnt > 0u ? cnt : 1u;
}

__device__ __forceinline__ void xcd_barrier(const XcdBarrier& b) {
    asm volatile("s_waitcnt vmcnt(0)" ::: "memory");
    __syncthreads();
    if (threadIdx.x == 0) {
        unsigned* bar = b.bar;
        __builtin_amdgcn_s_waitcnt(0);
        unsigned nloc = b.st[0], nx = b.st[1];
        if (nloc == 0u) { xcd_barrier_complete(bar, b.x, nloc, nx); b.st[0] = nloc; b.st[1] = nx; }
        const unsigned old = xb_add(&bar[XB_XSUB(b.x)], 1u);
        const unsigned gen = old / nloc;
        if (old + 1u == (gen + 1u) * nloc) {
            __builtin_amdgcn_fence(__ATOMIC_RELEASE, "agent");
            asm volatile("s_waitcnt vmcnt(0)" ::: "memory");
            const unsigned og = xb_add(&bar[XB_TOP], 1u);
            const unsigned tg = og / nx;
            if (og + 1u == (tg + 1u) * nx) xb_add(&bar[XB_TOPGEN], 1u);
            else XB_SPIN(xb_ld(&bar[XB_TOPGEN]) == tg, bar);
            __builtin_amdgcn_fence(__ATOMIC_ACQUIRE, "agent");
            xb_add(&bar[XB_XGEN(b.x)], 1u);
            asm volatile("s_waitcnt vmcnt(0)" ::: "memory");
        } else {
            XB_SPIN(xb_ld(&bar[XB_XGEN(b.x)]) == gen, bar);
            __builtin_amdgcn_fence(__ATOMIC_ACQUIRE, "agent");
            asm volatile("s_waitcnt vmcnt(0)" ::: "memory");
        }
    }
    __syncthreads();
}

namespace pg8 {
constexpr int BM = 256, BK = 64, HALF = 128, HTB = HALF * BK * 2, STAGE_BYTES = 8 * HTB, NXCD = 8, WGM = 8;
__host__ __device__ __forceinline__ int lds_byte(int r, int c) { const int st = (r >> 4) * 2 + (c >> 5), rr = r & 15, cc = c & 31, ob = rr * 64 + cc * 2; return st * 1024 + (ob ^ (((ob >> 9) & 1) << 5)); }
__host__ __device__ __forceinline__ void stage_rc(int b, int& R, int& C) { const int st = b / 1024, sb = b % 1024, swz = sb ^ (((sb >> 9) & 1) << 5); R = (st >> 1) * 16 + swz / 64; C = (st & 1) * 32 + (swz % 64) / 2; }
__host__ __device__ __forceinline__ int perm32(int rho) { const int n = rho >> 4, i = rho & 15; return 8 * (i >> 2) + 4 * n + (i & 3); }
struct Unit { int pm, pn; };
struct Gemm { const bf16_t* A; const bf16_t* Bt; int M, N, K; };
struct StaticOrder {
    int nM, nN, nwg, G, c, skip_lo, skip_n, ioff = 0, icnt = 1 << 20;
    __device__ void init(int M, int N, int G_, int c_, int slo = 1 << 20, int sn = 0) { nM = M / BM; nN = N / BM; nwg = nM * nN; G = G_; c = c_; skip_lo = slo; skip_n = sn; }
    __device__ bool next(int i, Unit& u) const {
        if (i >= icnt) return false; const long L = (long)(i + ioff) * G + c; if (L >= nwg) return false;
        int wgid = (int)L; { const int q = nwg / NXCD, r = nwg % NXCD, xcd = wgid % NXCD, off = wgid / NXCD; wgid = (xcd < r ? xcd * (q + 1) : r * (q + 1) + (xcd - r) * q) + off; }
        const int nig = WGM * nN, gid = wgid / nig, fm = gid * WGM, gsz = (nM - fm) < WGM ? (nM - fm) : WGM;
        u.pm = fm + ((wgid % nig) % gsz); u.pn = (wgid % nig) / gsz; if (u.pn >= skip_lo) u.pn += skip_n; return true;
    }
};
template <class Epi>
__device__ __forceinline__ void gemm_phase(LAS unsigned char* lds, const Gemm g, const StaticOrder& S, const Epi& E) {
    const int tid = ltid(), wid = __builtin_amdgcn_readfirstlane(tid >> 6), lane = tid & 63, wr = wid >> 2, wc = wid & 3, fr = lane & 15, fq = lane >> 4;
    int K = g.K; asm volatile("" : "+s"(K)); const int nt = K / BK;
    unsigned voffA[2], voffB[2];
#pragma unroll
    for (int i = 0; i < 2; ++i) { int R, C; stage_rc(tid * 16 + i * 8192, R, C); const int Rb = Epi::PERM ? ((R & ~31) + perm32(R & 31)) : R;
        voffA[i] = (unsigned)(R * K + C) * 2u; voffB[i] = (unsigned)(Rb * K + C) * 2u; }
    const size_t kstep = (size_t)(BK * 2);
    const size_t hstep = (size_t)HALF * K * 2;
    const size_t tstep = 2 * hstep;
    const unsigned ldsw = (unsigned)wid * 1024u;
    const int aoff = lds_byte(wr * 64 + fr, fq * 8), boff = lds_byte(wc * 32 + fr, fq * 8);
#define PG8_SA(b, h) (((b) * 2 + (h)) * HTB)
#define PG8_SB(b, h) ((4 + (b) * 2 + (h)) * HTB)
#define PG8_STAGE(bufoff, gbase, voff) do { _Pragma("unroll") for (int _i = 0; _i < 2; ++_i) \
        __builtin_amdgcn_global_load_lds((const unsigned*)((const char*)(gbase) + (voff)[_i]), (LAS unsigned*)(lds + (bufoff) + ldsw + _i * 8192), 16, 0, 0); } while (0)
#define PG8_LDA(dst, b, h) do { _Pragma("unroll") for (int m = 0; m < 4; ++m) _Pragma("unroll") for (int k = 0; k < 2; ++k) dst[m][k] = *(const LAS bf16x8*)(lds + PG8_SA(b, h) + aoff + m * 2048 + k * 1024); } while (0)
#define PG8_LDB(dst, b, h) do { _Pragma("unroll") for (int n = 0; n < 2; ++n) _Pragma("unroll") for (int k = 0; k < 2; ++k) dst[n][k] = *(const LAS bf16x8*)(lds + PG8_SB(b, h) + boff + n * 2048 + k * 1024); } while (0)
#define PG8_MMA(ai, bj, At, Bt) do { __builtin_amdgcn_s_setprio(1); _Pragma("unroll") for (int m = 0; m < 4; ++m) _Pragma("unroll") for (int n = 0; n < 2; ++n) _Pragma("unroll") for (int k = 0; k < 2; ++k) \
        acc[ai][bj][m][n] = __builtin_amdgcn_mfma_f32_16x16x32_bf16(Bt[n][k], At[m][k], acc[ai][bj][m][n], 0, 0, 0); __builtin_amdgcn_s_setprio(0); } while (0)
#define PG8_WAIT_V(n) asm volatile("s_waitcnt vmcnt(" #n ")" ::: "memory")
#define PG8_WAIT_L(n) asm volatile("s_waitcnt lgkmcnt(" #n ")" ::: "memory")
#define PG8_BAR __builtin_amdgcn_s_barrier()
#define PG8_SCHED __builtin_amdgcn_sched_barrier(0)
    Unit cur, nxt; int ui = 0;
    if (!S.next(0, cur)) return;
    f32x4 acc[2][2][4][2];
#pragma unroll
    for (int a = 0; a < 2; ++a)
#pragma unroll
        for (int b = 0; b < 2; ++b)
#pragma unroll
            for (int m = 0; m < 4; ++m)
#pragma unroll
                for (int n = 0; n < 2; ++n) acc[a][b][m][n] = (f32x4){0.f, 0.f, 0.f, 0.f};
    bf16x8 At[4][2], B0[2][2], B1[2][2];
    const char* cA = (const char*)g.A + (size_t)cur.pm * tstep; const char* cB = (const char*)g.Bt + (size_t)cur.pn * tstep;
    if (Epi::PRE) E.stash(E.prefetch(cur.pm, tid), lds, 0, tid);
    PG8_STAGE(PG8_SB(0, 0), cB, voffB); PG8_STAGE(PG8_SA(0, 0), cA, voffA); PG8_STAGE(PG8_SB(0, 1), cB + hstep, voffB); PG8_STAGE(PG8_SA(0, 1), cA + hstep, voffA);
    if (wr == 1) PG8_BAR;
    PG8_WAIT_V(4); PG8_BAR;
    PG8_STAGE(PG8_SB(1, 0), cB + kstep, voffB); PG8_STAGE(PG8_SA(1, 0), cA + kstep, voffA); PG8_STAGE(PG8_SB(1, 1), cB + hstep + kstep, voffB);
    PG8_WAIT_V(6); PG8_BAR;
    for (;;) {
        const bool has_next = S.next(ui + 1, nxt);
        const char* nA = has_next ? (const char*)g.A + (size_t)nxt.pm * tstep : cA; const char* nB = has_next ? (const char*)g.Bt + (size_t)nxt.pn * tstep : cB;
        for (int t = 0; t < nt; t += 2) {
            const bool last = (t == nt - 2);
            const char* a1 = cA + (size_t)(t + 1) * kstep;
            const char* a2 = last ? nA : cA + (size_t)(t + 2) * kstep; const char* b2 = last ? nB : cB + (size_t)(t + 2) * kstep;
            const char* a3 = a2 + kstep; const char* b3 = b2 + kstep;
            PG8_LDB(B0, 0, 0); PG8_SCHED; PG8_LDA(At, 0, 0); PG8_STAGE(PG8_SA(1, 1), a1 + hstep, voffA);
            PG8_WAIT_L(8); PG8_BAR; PG8_WAIT_L(0); PG8_MMA(0, 0, At, B0); PG8_BAR; PG8_SCHED;
            PG8_LDB(B1, 0, 1); PG8_STAGE(PG8_SB(0, 0), b2, voffB);
            PG8_BAR; PG8_WAIT_L(0); PG8_MMA(0, 1, At, B1); PG8_BAR;
            PG8_LDA(At, 0, 1); PG8_STAGE(PG8_SA(0, 0), a2, voffA);
            PG8_BAR; PG8_WAIT_L(0); PG8_MMA(1, 0, At, B0); PG8_BAR; PG8_SCHED;
            PG8_STAGE(PG8_SB(0, 1), b2 + hstep, voffB);
            PG8_WAIT_V(6); PG8_BAR; PG8_MMA(1, 1, At, B1); PG8_BAR;
            PG8_LDB(B0, 1, 0); PG8_SCHED; PG8_LDA(At, 1, 0); PG8_STAGE(PG8_SA(0, 1), a2 + hstep, voffA);
            PG8_WAIT_L(8); PG8_BAR; PG8_WAIT_L(0); PG8_MMA(0, 0, At, B0); PG8_BAR; PG8_SCHED;
            PG8_LDB(B1, 1, 1); PG8_STAGE(PG8_SB(1, 0), b3, voffB);
            PG8_BAR; PG8_WAIT_L(0); PG8_MMA(0, 1, At, B1); PG8_BAR;
            PG8_LDA(At, 1, 1); PG8_STAGE(PG8_SA(1, 0), a3, voffA);
            PG8_BAR; PG8_WAIT_L(0); PG8_MMA(1, 0, At, B0); PG8_BAR; PG8_SCHED;
            PG8_STAGE(PG8_SB(1, 1), b3 + hstep, voffB);
            PG8_WAIT_V(6); PG8_BAR; PG8_MMA(1, 1, At, B1); PG8_BAR;
        }
        E(acc, cur, wr, wc, fr, fq, lds, ui & 1, has_next ? nxt.pm : -1, tid);
        if (!has_next) break;
#pragma unroll
        for (int a = 0; a < 2; ++a)
#pragma unroll
            for (int b = 0; b < 2; ++b)
#pragma unroll
                for (int m = 0; m < 4; ++m)
#pragma unroll
                    for (int n = 0; n < 2; ++n) acc[a][b][m][n] = (f32x4){0.f, 0.f, 0.f, 0.f};
        cur = nxt; cA = nA; cB = nB; ++ui;
    }
    PG8_WAIT_V(0);
    if (wr == 0) PG8_BAR;
    PG8_BAR;
#undef PG8_SA
#undef PG8_SB
#undef PG8_STAGE
#undef PG8_LDA
#undef PG8_LDB
#undef PG8_MMA
#undef PG8_WAIT_V
#undef PG8_WAIT_L
#undef PG8_BAR
#undef PG8_SCHED
}

template <int ACT> struct EpiBf16 {
    static constexpr bool PERM = true, PRE = true;
    bf16_t* O; int ldc; const unsigned long long* ssq;
    __device__ __forceinline__ unsigned long long prefetch(int pm, int tid) const { return tid < 256 ? ssq[pm * BM + tid] : 0ull; }
    __device__ __forceinline__ void stash(unsigned long long v, LAS unsigned char* lds, int par, int tid) const { if (tid < 256) *(LAS float*)(lds + 131072 + par * 1024 + tid * 4) = rsqrtf((float)v * (1.f / (1048576.f * DM)) + EPS_); }
    __device__ __forceinline__ void operator()(const f32x4 (&acc)[2][2][4][2], const Unit& u, int wr, int wc, int fr, int fq, LAS unsigned char* lds, int par, int npm, int tid) const {
        const int row0 = u.pm * BM + wr * 64 + fr, col0 = u.pn * BM + wc * 32 + 8 * fq;
        unsigned long long nx = 0ull; if (npm >= 0) nx = prefetch(npm, tid);
#pragma unroll
        for (int ai = 0; ai < 2; ++ai)
#pragma unroll
            for (int m = 0; m < 4; ++m) { const int row = row0 + ai * HALF + m * 16; bf16_t* rowp = O + (size_t)row * ldc + col0;
                const float rstd = *(const LAS float*)(lds + 131072 + par * 1024 + (wr * 64 + fr + ai * HALF + m * 16) * 4);
#pragma unroll
                for (int bj = 0; bj < 2; ++bj) { f32x4 v0 = acc[ai][bj][m][0] * rstd, v1 = acc[ai][bj][m][1] * rstd;
                    if (ACT == 1) {
#pragma unroll
                        for (int j = 0; j < 4; ++j) { const float a = fmaxf(v0[j], 0.f), b = fmaxf(v1[j], 0.f); v0[j] = a * a; v1[j] = b * b; } }
                    u32x4 w; w.x = cvt_pk_bf16(v0[0], v0[1]); w.y = cvt_pk_bf16(v0[2], v0[3]); w.z = cvt_pk_bf16(v1[0], v1[1]); w.w = cvt_pk_bf16(v1[2], v1[3]);
                    *(u32x4*)(rowp + bj * HALF) = w; } }
        if (npm >= 0) stash(nx, lds, par ^ 1, tid);
    }
};
struct EpiResid {
    static constexpr bool PERM = true, PRE = false;
    __device__ __forceinline__ unsigned long long prefetch(int, int) const { return 0ull; }
    __device__ __forceinline__ void stash(unsigned long long, LAS unsigned char*, int, int) const {}
    bf16_t* Hb; unsigned long long* ssq; int ldc;
    __device__ __forceinline__ void operator()(const f32x4 (&acc)[2][2][4][2], const Unit& u, int wr, int wc, int fr, int fq, LAS unsigned char* lds, int par, int npm, int tid) const {
        const int row0 = u.pm * BM + wr * 64 + fr, col0 = u.pn * BM + wc * 32 + 8 * fq;
#pragma unroll
        for (int ai = 0; ai < 2; ++ai)
#pragma unroll
            for (int m = 0; m < 4; ++m) { const int row = row0 + ai * HALF + m * 16; bf16_t* hp = Hb + (size_t)row * ldc + col0;
                float part = 0.f;
#pragma unroll
                for (int bj = 0; bj < 2; ++bj) { u32x4* p = (u32x4*)(hp + bj * HALF); float o[8]; unpack8(*p, o);
                    const f32x4 a0 = acc[ai][bj][m][0], a1 = acc[ai][bj][m][1];
                    float v[8] = {o[0] + a0[0], o[1] + a0[1], o[2] + a0[2], o[3] + a0[3], o[4] + a1[0], o[5] + a1[1], o[6] + a1[2], o[7] + a1[3]};
#pragma unroll
                    for (int k = 0; k < 8; ++k) part += v[k] * v[k];
                    *p = pack8(v); }
                part += __shfl_xor(part, 16); part += __shfl_xor(part, 32);
                if (fq == 0) atomicAdd(ssq + row, (unsigned long long)(part * 1048576.f)); }
    }
};
struct EpiQup {
    static constexpr bool PERM = true, PRE = false;
    __device__ __forceinline__ unsigned long long prefetch(int, int) const { return 0ull; }
    __device__ __forceinline__ void stash(unsigned long long, LAS unsigned char*, int, int) const {}
    bf16_t* Q; const float* rc; const float* rs;
    __device__ __forceinline__ void operator()(const f32x4 (&acc)[2][2][4][2], const Unit& u, int wr, int wc, int fr, int fq, LAS unsigned char* lds, int par, int npm, int tid) const {
        const int row0 = u.pm * BM + wr * 64 + fr;
        if (u.pn < 4) {
            bf16_t* d0 = Q + ((size_t)(u.pn * 2) * S_ + row0) * 192 + wc * 32 + 8 * fq;
#pragma unroll
            for (int ai = 0; ai < 2; ++ai)
#pragma unroll
                for (int m = 0; m < 4; ++m) {
#pragma unroll
                    for (int bj = 0; bj < 2; ++bj) { const f32x4 v0 = acc[ai][bj][m][0], v1 = acc[ai][bj][m][1];
                        u32x4 w; w.x = cvt_pk_bf16(v0[0], v0[1]); w.y = cvt_pk_bf16(v0[2], v0[3]); w.z = cvt_pk_bf16(v1[0], v1[1]); w.w = cvt_pk_bf16(v1[2], v1[3]);
                        *(u32x4*)(d0 + (size_t)(ai * HALF + m * 16) * 192 + (size_t)bj * S_ * 192) = w; }
                    asm volatile("" ::: "memory"); }
        } else {
            const int jj0 = (wc & 1) * 32 + 8 * fq, j0 = jj0 >> 1;
            bf16_t* d0 = Q + ((size_t)((u.pn - 4) * 4 + (wc >> 1)) * S_ + row0) * 192 + 128 + jj0;
            const float* c0 = rc + (size_t)row0 * 32 + j0; const float* s0 = rs + (size_t)row0 * 32 + j0;
#pragma unroll
            for (int ai = 0; ai < 2; ++ai)
#pragma unroll
                for (int m = 0; m < 4; ++m) { const int ro = ai * HALF + m * 16;
                    const f32x4 c = *(const f32x4*)(c0 + ro * 32), s = *(const f32x4*)(s0 + ro * 32);
#pragma unroll
                    for (int bj = 0; bj < 2; ++bj) { const f32x4 v0 = acc[ai][bj][m][0], v1 = acc[ai][bj][m][1];
                        u32x4 w;
                        w.x = cvt_pk_bf16(v0[0] * c[0] - v0[1] * s[0], v0[1] * c[0] + v0[0] * s[0]);
                        w.y = cvt_pk_bf16(v0[2] * c[1] - v0[3] * s[1], v0[3] * c[1] + v0[2] * s[1]);
                        w.z = cvt_pk_bf16(v1[0] * c[2] - v1[1] * s[2], v1[1] * c[2] + v1[0] * s[2]);
                        w.w = cvt_pk_bf16(v1[2] * c[3] - v1[3] * s[3], v1[3] * c[3] + v1[2] * s[3]);
                        *(u32x4*)(d0 + (size_t)ro * 192 + (size_t)bj * 2 * S_ * 192) = w; }
                    asm volatile("" ::: "memory"); }
        }
    }
};
struct EpiKVup {
    static constexpr bool PERM = true, PRE = false;
    __device__ __forceinline__ unsigned long long prefetch(int, int) const { return 0ull; }
    __device__ __forceinline__ void stash(unsigned long long, LAS unsigned char*, int, int) const {}
    bf16_t* Kb; bf16_t* Vb;
    template <int LD> __device__ __forceinline__ void put(const f32x4 (&acc)[2][2][4][2], bf16_t* d0) const {
#pragma unroll
        for (int ai = 0; ai < 2; ++ai)
#pragma unroll
            for (int m = 0; m < 4; ++m)
#pragma unroll
                for (int bj = 0; bj < 2; ++bj) { const f32x4 v0 = acc[ai][bj][m][0], v1 = acc[ai][bj][m][1];
                    u32x4 w; w.x = cvt_pk_bf16(v0[0], v0[1]); w.y = cvt_pk_bf16(v0[2], v0[3]); w.z = cvt_pk_bf16(v1[0], v1[1]); w.w = cvt_pk_bf16(v1[2], v1[3]);
                    *(u32x4*)(d0 + (size_t)(ai * HALF + m * 16) * LD + (size_t)bj * S_ * LD) = w; }
    }
    __device__ __forceinline__ void operator()(const f32x4 (&acc)[2][2][4][2], const Unit& u, int wr, int wc, int fr, int fq, LAS unsigned char* lds, int par, int npm, int tid) const {
        const int row0 = u.pm * BM + wr * 64 + fr;
        if (u.pn < 4) put<192>(acc, Kb + ((size_t)(u.pn * 2) * S_ + row0) * 192 + wc * 32 + 8 * fq);
        else put<128>(acc, Vb + ((size_t)((u.pn - 4) * 2) * S_ + row0) * 128 + wc * 32 + 8 * fq);
    }
};
}

namespace att {
constexpr int DQ = 192, DV = 128, NW = 8, QBLK = 32, KVBLK = 64;
constexpr float SCALE = 0.07216878364870322f;
constexpr float THR = 8.f;
#ifndef ATT_SDEPTH
#define ATT_SDEPTH 1
#endif
constexpr int SDEPTH = ATT_SDEPTH;
#ifndef ATT_NQREG
#define ATT_NQREG 12
#endif
constexpr int NQREG = ATT_NQREG;
constexpr int LDQ = 192, LDKK = 192, LDVV = 128, LDO = 2048;
constexpr int SHM_V = KVBLK * DV * 2, SHM_K = KVBLK * 400, SHM_QR = 2 * SHM_V + 2 * SHM_K + NW * 64 * 4, SHM_ATTN = SHM_QR + NW * (12 - NQREG) * 64 * 16;
#define KSWZ(row, colB) ((row) * 400 + (colB))
#define SBAR() __builtin_amdgcn_sched_barrier(0)
__device__ __forceinline__ int crow(int r, int hi) { return (r & 3) + 8 * (r >> 2) + 4 * hi; }
__device__ __forceinline__ void partialSM(f32x16& p0, f32x16& p1, float& m_reg, float& mn, float& alpha) {
  constexpr float C = SCALE * 1.4426950408889634f;
  float pmax = p0[0]; for (int r = 1; r < 16; ++r) pmax = fmaxf(pmax, p0[r]); for (int r = 0; r < 16; ++r) pmax = fmaxf(pmax, p1[r]);
  { auto rr = __builtin_amdgcn_permlane32_swap(__float_as_uint(pmax), __float_as_uint(pmax), false, false);
    pmax = fmaxf(__uint_as_float(rr[0]), __uint_as_float(rr[1])); }
  if (__builtin_expect(__all(pmax - m_reg <= THR / SCALE), 1)) { mn = m_reg; alpha = 1.f; }
  else { mn = fmaxf(m_reg, pmax); alpha = __builtin_amdgcn_exp2f((m_reg - mn) * C); m_reg = mn; }
  float mnC = -mn * C;
  for (int r = 0; r < 16; ++r) p0[r] = fmaf(p0[r], C, mnC); for (int r = 0; r < 16; ++r) p1[r] = fmaf(p1[r], C, mnC);
  for (int r = 0; r < 16; ++r) p0[r] = __builtin_amdgcn_exp2f(p0[r]);
}
__device__ __forceinline__ void finishSM(f32x16& p0, f32x16& p1, float alpha, float& l_reg, bf16x8& pa0, bf16x8& pa1, bf16x8& pa2, bf16x8& pa3) {
  for (int r = 0; r < 16; ++r) p1[r] = __builtin_amdgcn_exp2f(p1[r]);
  float ps = 0; for (int r = 0; r < 16; ++r) ps += p0[r]; for (int r = 0; r < 16; ++r) ps += p1[r];
  { auto rr = __builtin_amdgcn_permlane32_swap(__float_as_uint(ps), __float_as_uint(ps), false, false);
    ps = __uint_as_float(rr[0]) + __uint_as_float(rr[1]); }
  l_reg = l_reg * alpha + ps;
#define PK4(P, BASE, OUT) do { unsigned a0 = cvt_pk_bf16(P[BASE + 0], P[BASE + 1]), a1 = cvt_pk_bf16(P[BASE + 2], P[BASE + 3]);   \
    unsigned b0 = cvt_pk_bf16(P[BASE + 4], P[BASE + 5]), b1 = cvt_pk_bf16(P[BASE + 6], P[BASE + 7]);                              \
    auto r0 = __builtin_amdgcn_permlane32_swap(a0, b0, false, false); auto r1 = __builtin_amdgcn_permlane32_swap(a1, b1, false, false); \
    u32x4 w = {r0[0], r1[0], r0[1], r1[1]}; OUT = *reinterpret_cast<bf16x8*>(&w); } while (0)
  PK4(p0, 0, pa0); PK4(p0, 8, pa1); PK4(p1, 0, pa2); PK4(p1, 8, pa3);
#undef PK4
}
__device__ __forceinline__ void qkt(f32x16& p0, f32x16& p1, const bf16_t* Ks, const bf16x8* qr, const bf16x8* qrl, int r32, int hi) {
  p0 = f32x16{}; p1 = f32x16{};
#pragma unroll
  for (int d0 = 0; d0 < 12; ++d0) { int cb = (d0 * 16 + hi * 8) * 2;
    bf16x8 b0 = *reinterpret_cast<const bf16x8*>((const char*)Ks + KSWZ(r32, cb));
    bf16x8 b1 = *reinterpret_cast<const bf16x8*>((const char*)Ks + KSWZ(32 + r32, cb));
    const bf16x8 qv = d0 < NQREG ? qr[d0 < NQREG ? d0 : 0] : qrl[(d0 - NQREG) * 64];
    p0 = __builtin_amdgcn_mfma_f32_32x32x16_bf16(b0, qv, p0, 0, 0, 0);
    p1 = __builtin_amdgcn_mfma_f32_32x32x16_bf16(b1, qv, p1, 0, 0, 0); }
}
__device__ __forceinline__ int v_st(int k, int c) { const int kk = (k & ~0xC) | ((k & 4) << 1) | ((k & 8) >> 1); return ((kk >> 3) * 4 + (c >> 5)) * 512 + ((kk & 7) * 32 + (c & 31)) * 2; }
__device__ __forceinline__ int v_rd_base(int lane) { return ((lane & 3) << 3) | (((lane >> 2) & 3) << 6) | (((lane >> 4) & 1) << 5) | (((lane >> 5) & 1) << 8); }
constexpr int v_rd_off(int d0, int ks, int half) { return d0 * 512 + ks * 4096 + half * 2048; }
template <int OFF> __device__ __forceinline__ s16x4 tr_read(int vb) {
  s16x4 r; asm volatile("ds_read_b64_tr_b16 %0, %1 offset:%2" : "=&v"(r) : "v"(vb), "i"(OFF) : "memory"); return r;
}
template <int D0> __device__ __forceinline__ void pv_one(f32x16& od, int vb, bf16x8 pa0, bf16x8 pa1, bf16x8 pa2, bf16x8 pa3) {
  const s16x4 l0 = tr_read<v_rd_off(D0, 0, 0)>(vb), h0 = tr_read<v_rd_off(D0, 0, 1)>(vb), l1 = tr_read<v_rd_off(D0, 1, 0)>(vb), h1 = tr_read<v_rd_off(D0, 1, 1)>(vb);
  const s16x4 l2 = tr_read<v_rd_off(D0, 2, 0)>(vb), h2 = tr_read<v_rd_off(D0, 2, 1)>(vb), l3 = tr_read<v_rd_off(D0, 3, 0)>(vb), h3 = tr_read<v_rd_off(D0, 3, 1)>(vb);
  asm volatile("s_waitcnt lgkmcnt(0)" ::: "memory"); SBAR();
#define PK(L, H) (bf16x8){L[0], L[1], L[2], L[3], H[0], H[1], H[2], H[3]}
  od = __builtin_amdgcn_mfma_f32_32x32x16_bf16(pa0, PK(l0, h0), od, 0, 0, 0);
  od = __builtin_amdgcn_mfma_f32_32x32x16_bf16(pa1, PK(l1, h1), od, 0, 0, 0);
  od = __builtin_amdgcn_mfma_f32_32x32x16_bf16(pa2, PK(l2, h2), od, 0, 0, 0);
  od = __builtin_amdgcn_mfma_f32_32x32x16_bf16(pa3, PK(l3, h3), od, 0, 0, 0);
#undef PK
}
__device__ __forceinline__ void pv_d0(f32x16* o, int vb, bf16x8 pa0, bf16x8 pa1, bf16x8 pa2, bf16x8 pa3) {
  pv_one<0>(o[0], vb, pa0, pa1, pa2, pa3); pv_one<1>(o[1], vb, pa0, pa1, pa2, pa3); pv_one<2>(o[2], vb, pa0, pa1, pa2, pa3); pv_one<3>(o[3], vb, pa0, pa1, pa2, pa3);
}
__device__ __forceinline__ void attn_body(const bf16_t* __restrict__ Qb, const bf16_t* __restrict__ Kh, const bf16_t* __restrict__ Vh,
                                          bf16_t* __restrict__ Ob, int seq, char* lds) {
  const int tid = ltid(), wid = tid >> 6, lane = tid & 63, r32 = lane & 31, hi = lane >> 5;
  bf16_t* V_lds = (bf16_t*)lds; bf16_t* K_lds = (bf16_t*)(lds + 2 * SHM_V);
  float* ws = (float*)(lds + 2 * SHM_V + 2 * SHM_K) + wid * 64; float* li_l = ws; float* al_l = ws + 32;
  float m_reg = -1e30f, l_reg = 0; f32x16 o[4] = {}; bf16x8 qr[NQREG];
  const bf16_t* Qw = Qb + (long)(wid * QBLK + r32) * LDQ + hi * 8;
  bf16x8* qrl = (bf16x8*)(lds + SHM_QR) + wid * ((12 - NQREG) * 64) + lane;
#pragma unroll
  for (int d0 = 0; d0 < NQREG; ++d0) qr[d0] = *reinterpret_cast<const bf16x8*>(Qw + d0 * 16);
#pragma unroll
  for (int d0 = NQREG; d0 < 12; ++d0) qrl[(d0 - NQREG) * 64] = *reinterpret_cast<const bf16x8*>(Qw + d0 * 16);
  const int sr = tid >> 4, sc = (tid & 15) * 8, vst0 = v_st(sr, sc), vst1 = v_st(32 + sr, sc);
  const int kc0 = tid, kc1 = tid + 512, kc2 = tid + 1024;
  const int kr0 = kc0 / 24, kr1 = kc1 / 24, kr2 = kc2 / 24, ke0 = (kc0 % 24) * 8, ke1 = (kc1 % 24) * 8, ke2 = (kc2 % 24) * 8;
  const int kw0 = KSWZ(kr0, ke0 * 2), kw1 = KSWZ(kr1, ke1 * 2), kw2 = KSWZ(kr2, ke2 * 2);
  const int vb0 = (int)(uintptr_t)V_lds + v_rd_base(lane);
  struct { bf16x8 vs0, vs1, ks0, ks1, ks2; } sr_[SDEPTH];
#define SLOAD(i, k0) do { sr_[i].vs0 = *(const bf16x8*)(&Vh[(long)((k0) + sr) * LDVV + sc]); sr_[i].vs1 = *(const bf16x8*)(&Vh[(long)((k0) + 32 + sr) * LDVV + sc]); \
    { const char* kt_ = (const char*)Kh + (size_t)(k0) * 384; sr_[i].ks0 = *(const bf16x8*)(kt_ + tid * 16); sr_[i].ks1 = *(const bf16x8*)(kt_ + 8192 + tid * 16); \
    sr_[i].ks2 = *(const bf16x8*)(kt_ + 16384 + tid * 16); } } while (0)
#define SWRITE(b, i) do { *(bf16x8*)((char*)V_lds + (b) * SHM_V + vst0) = sr_[i].vs0;          \
    *(bf16x8*)((char*)V_lds + (b) * SHM_V + vst1) = sr_[i].vs1;               \
    *(bf16x8*)((char*)K_lds + (b) * SHM_K + kw0) = sr_[i].ks0;                       \
    *(bf16x8*)((char*)K_lds + (b) * SHM_K + kw1) = sr_[i].ks1;                       \
    *(bf16x8*)((char*)K_lds + (b) * SHM_K + kw2) = sr_[i].ks2; } while (0)
#define SWAIT() do { if constexpr (SDEPTH == 2) asm volatile("s_waitcnt vmcnt(5)" ::: "memory"); else asm volatile("s_waitcnt vmcnt(0)" ::: "memory"); } while (0)
#define RESC(a) do { if (__any((a) < 1.f)) { if (hi == 0) al_l[r32] = (a); asm volatile("s_waitcnt lgkmcnt(0)" ::: "memory"); \
    for (int d = 0; d < 4; ++d) for (int r = 0; r < 16; ++r) o[d][r] *= al_l[crow(r, hi)]; } } while (0)
  f32x16 pA0, pA1, pB0, pB1; float mnA, mnB, alA, alB; bf16x8 pa0, pa1, pa2, pa3; const int NT = seq / KVBLK;
  constexpr int SE = 0, SO = SDEPTH - 1;
  SLOAD(SE, 0); asm volatile("s_waitcnt vmcnt(0)" ::: "memory"); SWRITE(0, SE); __syncthreads();
  qkt(pA0, pA1, K_lds, qr, qrl, r32, hi); partialSM(pA0, pA1, m_reg, mnA, alA);
  SLOAD(SO, KVBLK); if constexpr (SDEPTH == 2) { if (2 < NT) SLOAD(SE, 2 * KVBLK); }
  SWAIT(); SWRITE(1, SO); __syncthreads();
  for (int j = 1; j + 1 < NT; j += 2) {
    SBAR(); qkt(pB0, pB1, (bf16_t*)((char*)K_lds + SHM_K), qr, qrl, r32, hi);
    finishSM(pA0, pA1, alA, l_reg, pa0, pa1, pa2, pa3); SBAR();
    SLOAD(SO, (j + SDEPTH) * KVBLK); SBAR();
    pv_d0(o, vb0, pa0, pa1, pa2, pa3); partialSM(pB0, pB1, m_reg, mnB, alB);
    __syncthreads(); SWAIT(); SWRITE(0, SE);
    RESC(alB); __syncthreads();
    SBAR(); qkt(pA0, pA1, K_lds, qr, qrl, r32, hi);
    finishSM(pB0, pB1, alB, l_reg, pa0, pa1, pa2, pa3); SBAR();
    if (SDEPTH == 1 || j + 3 < NT) SLOAD(SE, (j + 1 + SDEPTH) * KVBLK); SBAR();
    pv_d0(o, vb0 + (int)SHM_V, pa0, pa1, pa2, pa3); partialSM(pA0, pA1, m_reg, mnA, alA);
    __syncthreads(); SWAIT(); SWRITE(1, SO);
    RESC(alA); __syncthreads();
  }
  SBAR(); qkt(pB0, pB1, (bf16_t*)((char*)K_lds + SHM_K), qr, qrl, r32, hi);
  finishSM(pA0, pA1, alA, l_reg, pa0, pa1, pa2, pa3); SBAR();
  pv_d0(o, vb0, pa0, pa1, pa2, pa3); partialSM(pB0, pB1, m_reg, mnB, alB);
  __syncthreads(); RESC(alB);
  finishSM(pB0, pB1, alB, l_reg, pa0, pa1, pa2, pa3); SBAR();
  pv_d0(o, vb0 + (int)SHM_V, pa0, pa1, pa2, pa3);
  if (hi == 0) li_l[r32] = l_reg; asm volatile("s_waitcnt lgkmcnt(0)" ::: "memory");
  float rli[16];
#pragma unroll
  for (int r = 0; r < 16; ++r) rli[r] = __builtin_amdgcn_rcpf(li_l[crow(r, hi)]);
  bf16_t* Ow = Ob + (long)(wid * QBLK) * LDO;
#pragma unroll
  for (int r = 0; r < 16; ++r) { int orow = crow(r, hi);
    for (int d0 = 0; d0 < 4; ++d0) Ow[(long)orow * LDO + d0 * 32 + r32] = f2bf(o[d0][r] * rli[r]); }
  asm volatile("s_waitcnt vmcnt(0)" ::: "memory");
  __syncthreads();
#undef SLOAD
#undef SWRITE
#undef SWAIT
#undef RESC
}
}

template <int K, int NT>
__device__ __forceinline__ void mma_tile(f32x4 (&acc)[4][NT], const LAS bf16_t* A, int lda, const LAS bf16_t* Bt, int ldb, int wr, int wc, int fr, int fq) {
#pragma unroll 1
    for (int k0 = 0; k0 < K; k0 += 32) {
        bf16x8 a[4], b[NT];
#pragma unroll
        for (int m = 0; m < 4; ++m) a[m] = *(const LAS bf16x8*)(A + (64 * wr + 16 * m + fr) * lda + k0 + fq * 8);
#pragma unroll
        for (int n = 0; n < NT; ++n) b[n] = *(const LAS bf16x8*)(Bt + (16 * NT * wc + 16 * n + fr) * ldb + k0 + fq * 8);
#pragma unroll
        for (int m = 0; m < 4; ++m)
#pragma unroll
            for (int n = 0; n < NT; ++n) acc[m][n] = __builtin_amdgcn_mfma_f32_16x16x32_bf16(a[m], b[n], acc[m][n], 0, 0, 0);
    }
}
template <int NT> __device__ __forceinline__ void zero_acc(f32x4 (&acc)[4][NT]) {
#pragma unroll
    for (int m = 0; m < 4; ++m)
#pragma unroll
        for (int n = 0; n < NT; ++n) acc[m][n] = (f32x4){0.f, 0.f, 0.f, 0.f};
}
template <int R, int C> __device__ __forceinline__ void stage_N(LAS bf16_t* dst, int ld, const bf16_t* __restrict__ src, size_t ldg) {
    constexpr int CH = C / 8;
    for (int idx = ltid(); idx < R * CH; idx += 512) { const int r = idx / CH, c = (idx % CH) * 8;
        *(LAS u32x4*)(dst + r * ld + c) = *(const u32x4*)(src + (size_t)r * ldg + c); }
}
template <int C, bool SCL> __device__ __forceinline__ void stage_T(LAS bf16_t* dst, int ld, const bf16_t* __restrict__ src, size_t ldg, const LAS float* sc) {
    for (int idx = ltid(); idx < 128 * (C / 8); idx += 512) { const int r = idx & 127, c0 = (idx >> 7) * 8;
        const u32x4 w = *(const u32x4*)(src + (size_t)r * ldg + c0); float f[8]; unpack8(w, f);
        float s = 1.f; if (SCL) s = sc[r];
#pragma unroll
        for (int i = 0; i < 8; ++i) dst[(c0 + i) * ld + r] = f2bf(f[i] * s); }
}
template <int R, int C> __device__ __forceinline__ void ld_N(u32x4 (&r)[R * C / 8 / 512], const bf16_t* __restrict__ src, size_t ldg, int tid) {
    constexpr int CH = C / 8;
#pragma unroll
    for (int i = 0; i < R * CH / 512; ++i) { const int idx = tid + 512 * i, rr = idx / CH, c = (idx % CH) * 8; r[i] = *(const u32x4*)(src + (size_t)rr * ldg + c); }
}
template <int R, int C> __device__ __forceinline__ void st_N(LAS bf16_t* dst, int ld, const u32x4 (&r)[R * C / 8 / 512], int tid) {
    constexpr int CH = C / 8;
#pragma unroll
    for (int i = 0; i < R * CH / 512; ++i) { const int idx = tid + 512 * i, rr = idx / CH, c = (idx % CH) * 8; *(LAS u32x4*)(dst + rr * ld + c) = r[i]; }
}
template <int C> __device__ __forceinline__ void ld_T(u32x4 (&r)[128 * C / 8 / 512], const bf16_t* __restrict__ src, size_t ldg, int tid) {
#pragma unroll
    for (int i = 0; i < 128 * C / 8 / 512; ++i) { const int idx = tid + 512 * i, rr = idx & 127, c0 = (idx >> 7) * 8; r[i] = *(const u32x4*)(src + (size_t)rr * ldg + c0); }
}
template <int C, bool SCL> __device__ __forceinline__ void st_T(LAS bf16_t* dst, int ld, const u32x4 (&r)[128 * C / 8 / 512], const LAS float* sc, int tid) {
#pragma unroll
    for (int i = 0; i < 128 * C / 8 / 512; ++i) { const int idx = tid + 512 * i, rr = idx & 127, c0 = (idx >> 7) * 8;
        if (SCL) { float f[8]; unpack8(r[i], f); const float sv = sc[rr];
#pragma unroll
            for (int k = 0; k < 8; ++k) dst[(c0 + k) * ld + rr] = f2bf(f[k] * sv); }
        else { const unsigned w[4] = {r[i].x, r[i].y, r[i].z, r[i].w};
#pragma unroll
            for (int k = 0; k < 4; ++k) { dst[(c0 + 2 * k) * ld + rr] = (bf16_t)(w[k] & 0xffffu); dst[(c0 + 2 * k + 1) * ld + rr] = (bf16_t)(w[k] >> 16); } } }
}
__device__ __forceinline__ float scan_add64(float v, int lane) {
#pragma unroll
    for (int o = 1; o < 64; o <<= 1) { const float t = __shfl_up(v, o); if (lane >= o) v += t; } return v; }
__device__ __forceinline__ float scan_max64(float v, int lane) {
#pragma unroll
    for (int o = 1; o < 64; o <<= 1) { const float t = __shfl_up(v, o); if (lane >= o) v = fmaxf(v, t); } return v; }

constexpr int CB0 = 0, CB1 = 34816, CB2 = 69632, CB3 = 104448, CVEC = 139264;
constexpr int RQB = 0, RKB = 18432, RST_ = 36864, RVT = 71680, RRT = 106496;

struct Bufs {
    bf16_t *Wl, *H, *Y, *QKML, *RQK, *CQN, *CKVN, *CST, *RST, *PROJ, *Q, *K, *V, *ACT;
    float *X, *RC, *RS, *G, *CLOC, *NLOC, *NST, *MLOC, *BLAST, *MST, *RLOC;
};

__device__ __forceinline__ void mlstm_local(const Bufs& B, int item, LAS unsigned char* lds) {
    const int tid = ltid(), wid = tid >> 6, lane = tid & 63, wr = wid >> 2, wc = wid & 3, fr = lane & 15, fq = lane >> 4;
    const int c = item & 63, h = (item >> 6) & 3, dir = item >> 8, s0 = c * 128;
    LAS bf16_t* T0 = (LAS bf16_t*)(lds + CB0); LAS bf16_t* T1 = (LAS bf16_t*)(lds + CB1); LAS float* ve = (LAS float*)(lds + CVEC);
    u32x4 rk[4], rv[4];
    ld_T<128>(rk, B.QKML + (size_t)s0 * 1024 + 512 + h * 128, 1024, tid);
    ld_T<128>(rv, B.PROJ + (size_t)s0 * NPROJP + PC_MLV + h * 128, NPROJP, tid);
    if (wid == 0) {
        const int l0 = 2 * lane, l1 = l0 + 1, p0 = dir ? 127 - l0 : l0, p1 = dir ? 127 - l1 : l1, gi = 8 * dir + h, gf = gi + 4;
        const float li0 = B.G[(size_t)(s0 + p0) * 16 + gi], lf0 = B.G[(size_t)(s0 + p0) * 16 + gf], li1 = B.G[(size_t)(s0 + p1) * 16 + gi], lf1 = B.G[(size_t)(s0 + p1) * 16 + gf];
        const float t = lf0 + lf1, incl = scan_add64(t, lane), b0 = incl - t + lf0, b1 = incl, btot = __shfl(incl, 63);
        const float w0 = btot - b0 + li0, w1 = btot - b1 + li1, mloc = wave_max(fmaxf(w0, w1));
        ve[p0] = __expf(w0 - mloc); ve[p1] = __expf(w1 - mloc);
        if (lane == 0) { B.MLOC[item] = mloc; B.BLAST[item] = btot; }
    }
    st_T<128, false>(T0, 136, rk, ve, tid);
    __syncthreads();
    st_T<128, true>(T1, 136, rv, ve, tid);
    __syncthreads();
    f32x4 acc[4][2]; zero_acc<2>(acc);
    mma_tile<128, 2>(acc, T1, 136, T0, 136, wr, wc, fr, fq);
    float* dst = B.CLOC + (size_t)item * 16384;
#pragma unroll
    for (int m = 0; m < 4; ++m)
#pragma unroll
        for (int n = 0; n < 2; ++n)
#pragma unroll
            for (int j = 0; j < 4; ++j) dst[(64 * wr + 16 * m + 4 * fq + j) * 128 + 32 * wc + 16 * n + fr] = acc[m][n][j];
    { const int dk = tid >> 2, qd = tid & 3; float s = 0.f;
#pragma unroll
        for (int i = 0; i < 4; ++i) { float kv[8]; unpack8(*(const LAS u32x4*)(T0 + dk * 136 + qd * 32 + i * 8), kv);
#pragma unroll
            for (int k = 0; k < 8; ++k) s += kv[k] * ve[qd * 32 + i * 8 + k]; }
        s += __shfl_xor(s, 1); s += __shfl_xor(s, 2);
        if (qd == 0) B.NLOC[(size_t)item * 128 + dk] = s; }
    __syncthreads();
}

__device__ __forceinline__ void ret_local(const Bufs& B, int item, LAS unsigned char* lds) {
    const int tid = ltid(), wid = tid >> 6, lane = tid & 63, wr = wid >> 2, wc = wid & 3, fr = lane & 15, fq = lane >> 4;
    const int c = item & 63, h = (item >> 6) & 3, dir = item >> 8, s0 = c * 128, hd = dir ? 3 - h : h;
    const float lg = log1pf(-exp2f(-5.f - (float)hd));
    LAS bf16_t* T0 = (LAS bf16_t*)(lds + CB0); LAS bf16_t* T1 = (LAS bf16_t*)(lds + CB1); LAS float* vz = (LAS float*)(lds + CVEC);
    u32x4 rk[2], rv[4];
    ld_T<64>(rk, B.RQK + (size_t)s0 * 512 + 256 + h * 64, 512, tid);
    ld_T<128>(rv, B.PROJ + (size_t)s0 * NPROJP + PC_RV + h * 128, NPROJP, tid);
    if (tid < 128) { const int lp = dir ? 127 - tid : tid; vz[tid] = __expf((float)(127 - lp) * lg); }
    st_T<64, false>(T0, 136, rk, vz, tid);
    __syncthreads();
    st_T<128, true>(T1, 136, rv, vz, tid);
    __syncthreads();
    f32x4 acc[4][1]; zero_acc<1>(acc);
    mma_tile<128, 1>(acc, T1, 136, T0, 136, wr, wc, fr, fq);
    float* dst = B.RLOC + (size_t)item * 8192;
#pragma unroll
    for (int m = 0; m < 4; ++m)
#pragma unroll
        for (int j = 0; j < 4; ++j) dst[(64 * wr + 16 * m + 4 * fq + j) * 64 + 16 * wc + fr] = acc[m][0][j];
    __syncthreads();
}

__device__ __forceinline__ void scan_phase(const Bufs& B) {
    const int gt = lbid() * 512 + ltid();
    if (gt < 131072) {
        const int dh = gt >> 14, idx = gt & 16383, dir = dh >> 2;
        float cst = 0.f, nst = 0.f, m = -1e30f;
#pragma unroll 1
        for (int s0 = 0; s0 < 64; s0 += 16) {
            float cl[16], ml[16], bl[16], nl[16];
#pragma unroll
            for (int u = 0; u < 16; ++u) { const int ch = dir ? 63 - (s0 + u) : s0 + u, it = dh * 64 + ch;
                cl[u] = B.CLOC[(size_t)it * 16384 + idx]; ml[u] = B.MLOC[it]; bl[u] = B.BLAST[it]; nl[u] = idx < 128 ? B.NLOC[(size_t)it * 128 + idx] : 0.f; }
#pragma unroll
            for (int u = 0; u < 16; ++u) { const int ch = dir ? 63 - (s0 + u) : s0 + u, it = dh * 64 + ch;
                B.CST[(size_t)it * 16384 + idx] = f2bf(cst);
                if (idx < 128) { B.NST[(size_t)it * 128 + idx] = nst; if (idx == 0) B.MST[it] = m; }
                const float mnew = fmaxf(bl[u] + m, ml[u]), a = __expf(bl[u] + m - mnew), g = __expf(ml[u] - mnew);
                cst = a * cst + g * cl[u]; nst = a * nst + g * nl[u]; m = mnew; }
        }
    }
    if (gt < 65536) {
        const int dh = gt >> 13, idx = gt & 8191, dir = dh >> 2, h = dh & 3, hd = dir ? 3 - h : h;
        const float cd = __expf(128.f * log1pf(-exp2f(-5.f - (float)hd)));
        float r = 0.f;
#pragma unroll 1
        for (int s0 = 0; s0 < 64; s0 += 16) {
            float rl[16];
#pragma unroll
            for (int u = 0; u < 16; ++u) { const int ch = dir ? 63 - (s0 + u) : s0 + u; rl[u] = B.RLOC[(size_t)(dh * 64 + ch) * 8192 + idx]; }
#pragma unroll
            for (int u = 0; u < 16; ++u) { const int ch = dir ? 63 - (s0 + u) : s0 + u; B.RST[(size_t)(dh * 64 + ch) * 8192 + idx] = f2bf(r); r = cd * r + rl[u]; }
        }
    }
}

__device__ __forceinline__ void mlstm_out(const Bufs& B, const float* __restrict__ g_out, int item, LAS unsigned char* lds) {
    const int tid = ltid(), wid = tid >> 6, lane = tid & 63, wr = wid >> 2, wc = wid & 3, fr = lane & 15, fq = lane >> 4;
    const int c = item >> 2, h = item & 3, s0 = c * 128;
    constexpr float SC = 0.08838834764831845f;
    LAS bf16_t* T0 = (LAS bf16_t*)(lds + CB0); LAS bf16_t* T1 = (LAS bf16_t*)(lds + CB1); LAS bf16_t* T2 = (LAS bf16_t*)(lds + CB2); LAS bf16_t* T3 = (LAS bf16_t*)(lds + CB3);
    LAS float* vea = (LAS float*)(lds + CVEC); LAS float* veM = vea + 256; LAS float* vedn = vea + 512; LAS float* vn = vea + 768; LAS float* vqn = vea + 1024;
    LAS float* vrs = vea + 1280; LAS float* vf = vea + 1408; LAS float* vsc = vea + 1536;
    LAS float* HT = (LAS float*)(lds + CB1);
    const float mst0 = B.MST[(0 * 4 + h) * 64 + c], mst1 = B.MST[(1 * 4 + h) * 64 + c];
    { u32x4 rq[4], rk[4], rv[4], rc[4];
        ld_N<128, 128>(rq, B.QKML + (size_t)s0 * 1024 + h * 128, 1024, tid);
        ld_N<128, 128>(rk, B.QKML + (size_t)s0 * 1024 + 512 + h * 128, 1024, tid);
        ld_T<128>(rv, B.PROJ + (size_t)s0 * NPROJP + PC_MLV + h * 128, NPROJP, tid);
        ld_N<128, 128>(rc, B.CST + (size_t)((0 * 4 + h) * 64 + c) * 16384, 128, tid);
        st_N<128, 128>(T0, 136, rq, tid); st_N<128, 128>(T1, 136, rk, tid); st_T<128, false>(T2, 136, rv, vea, tid); st_N<128, 128>(T3, 136, rc, tid); }
    if (wid < 2) {
        const int dir = wid; const float mst = dir ? mst1 : mst0;
        const int l0 = 2 * lane, l1 = l0 + 1, p0 = dir ? 127 - l0 : l0, p1 = dir ? 127 - l1 : l1, gi = 8 * dir + h, gf = gi + 4;
        const float li0 = B.G[(size_t)(s0 + p0) * 16 + gi], lf0 = B.G[(size_t)(s0 + p0) * 16 + gf], li1 = B.G[(size_t)(s0 + p1) * 16 + gi], lf1 = B.G[(size_t)(s0 + p1) * 16 + gf];
        const float t = lf0 + lf1, incl = scan_add64(t, lane), b0 = incl - t + lf0, b1 = incl;
        const float a0 = li0 - b0, a1 = li1 - b1, inm = scan_max64(fmaxf(a0, a1), lane);
        float exm = __shfl_up(inm, 1); if (lane == 0) exm = -3.0e38f;
        const float A0 = fmaxf(exm, a0), A1 = inm, amax = __shfl(inm, 63), cc = fmaxf(amax, mst);
        const float M0 = fmaxf(A0, mst), M1 = fmaxf(A1, mst);
        vea[dir * 128 + p0] = __expf(a0 - cc); vea[dir * 128 + p1] = __expf(a1 - cc);
        veM[dir * 128 + p0] = __expf(cc - M0) * SC; veM[dir * 128 + p1] = __expf(cc - M1) * SC;
        vedn[dir * 128 + p0] = __expf(-(b0 + M0)); vedn[dir * 128 + p1] = __expf(-(b1 + M1));
        if (lane == 0) vsc[dir] = __expf(mst - cc);
    }
    if (tid < 256) { const int dir = tid >> 7, d = tid & 127; vn[tid] = B.NST[(size_t)((dir * 4 + h) * 64 + c) * 128 + d]; }
    __syncthreads();
    f32x4 accS[4][2]; zero_acc<2>(accS);
    mma_tile<128, 2>(accS, T1, 136, T0, 136, wr, wc, fr, fq);
    { const int row = tid >> 2, qd = tid & 3; float q0 = 0.f, q1 = 0.f;
#pragma unroll
        for (int i = 0; i < 4; ++i) { float qv[8]; unpack8(*(const LAS u32x4*)(T0 + row * 136 + qd * 32 + i * 8), qv);
            const f32x4 n0a = *(const LAS f32x4*)(vn + qd * 32 + i * 8), n0b = *(const LAS f32x4*)(vn + qd * 32 + i * 8 + 4);
            const f32x4 n1a = *(const LAS f32x4*)(vn + 128 + qd * 32 + i * 8), n1b = *(const LAS f32x4*)(vn + 128 + qd * 32 + i * 8 + 4);
#pragma unroll
            for (int k = 0; k < 4; ++k) { q0 += qv[k] * n0a[k] + qv[4 + k] * n0b[k]; q1 += qv[k] * n1a[k] + qv[4 + k] * n1b[k]; } }
        q0 += __shfl_xor(q0, 1); q0 += __shfl_xor(q0, 2); q1 += __shfl_xor(q1, 1); q1 += __shfl_xor(q1, 2);
        if (qd == 0) { vqn[row] = q0; vqn[128 + row] = q1; } }
    __syncthreads();
    f32x4 hacc[4][2]; zero_acc<2>(hacc);
    u32x4 rc1[4]; ld_N<128, 128>(rc1, B.CST + (size_t)((1 * 4 + h) * 64 + c) * 16384, 128, tid);
#pragma unroll 1
    for (int dir = 0; dir < 2; ++dir) {
        if (dir == 1) st_N<128, 128>(T3, 136, rc1, tid);
        const float r = vsc[dir];
#pragma unroll
        for (int m = 0; m < 4; ++m)
#pragma unroll
            for (int n = 0; n < 2; ++n) { const int l = 32 * wc + 16 * n + fr, sb = 64 * wr + 16 * m + 4 * fq;
                const f32x4 e4 = *(const LAS f32x4*)(vea + dir * 128 + sb); float v[4];
#pragma unroll
                for (int j = 0; j < 4; ++j) { const int s = sb + j; const bool ok = dir ? (s >= l) : (s <= l); v[j] = ok ? accS[m][n][j] * e4[j] : 0.f; }
                u32x2 w; w.x = cvt_pk_bf16(v[0], v[1]); w.y = cvt_pk_bf16(v[2], v[3]);
                *(LAS u32x2*)(T1 + l * 136 + sb) = w; }
        __syncthreads();
        { const int row = tid >> 2, qd = tid & 3; float s = 0.f;
#pragma unroll
            for (int i = 0; i < 4; ++i) { float sv[8]; unpack8(*(const LAS u32x4*)(T1 + row * 136 + qd * 32 + i * 8), sv);
#pragma unroll
                for (int k = 0; k < 8; ++k) s += sv[k]; }
            s += __shfl_xor(s, 1); s += __shfl_xor(s, 2);
            if (qd == 0) { const float eM = veM[dir * 128 + row], den = eM * (s + r * vqn[dir * 128 + row]);
                vf[row] = eM / fmaxf(fabsf(den), vedn[dir * 128 + row]); } }
        f32x4 accN[4][2]; zero_acc<2>(accN);
        mma_tile<128, 2>(accN, T0, 136, T3, 136, wr, wc, fr, fq);
#pragma unroll
        for (int m = 0; m < 4; ++m)
#pragma unroll
            for (int n = 0; n < 2; ++n) accN[m][n] *= r;
        mma_tile<128, 2>(accN, T1, 136, T2, 136, wr, wc, fr, fq);
        __syncthreads();
#pragma unroll
        for (int m = 0; m < 4; ++m) { const f32x4 f4 = *(const LAS f32x4*)(vf + 64 * wr + 16 * m + 4 * fq);
#pragma unroll
            for (int n = 0; n < 2; ++n) hacc[m][n] += accN[m][n] * f4; }
        __syncthreads();
    }
    const int erow = tid >> 2, eqd = tid & 3, es = s0 + erow;
    u32x4 og4[4]; f32x4 gp4[8];
    { const bf16_t* og = B.PROJ + (size_t)es * NPROJP + PC_MLO + h * 128 + eqd * 32; const float* gp = g_out + h * 128 + eqd * 32;
#pragma unroll
        for (int i = 0; i < 4; ++i) og4[i] = *(const u32x4*)(og + i * 8);
#pragma unroll
        for (int i = 0; i < 8; ++i) gp4[i] = *(const f32x4*)(gp + i * 4); }
#pragma unroll
    for (int m = 0; m < 4; ++m)
#pragma unroll
        for (int n = 0; n < 2; ++n)
#pragma unroll
            for (int j = 0; j < 4; ++j) HT[(64 * wr + 16 * m + 4 * fq + j) * 132 + 32 * wc + 16 * n + fr] = hacc[m][n][j];
    __syncthreads();
    { float ssq = 0.f; f32x4 x4[8];
#pragma unroll
        for (int i = 0; i < 8; ++i) { x4[i] = *(const LAS f32x4*)(HT + erow * 132 + eqd * 32 + i * 4);
            ssq += x4[i][0] * x4[i][0] + x4[i][1] * x4[i][1] + x4[i][2] * x4[i][2] + x4[i][3] * x4[i][3]; }
        ssq += __shfl_xor(ssq, 1); ssq += __shfl_xor(ssq, 2);
        const float rstd = rsqrtf(ssq * (1.f / 128.f) + EPS_);
        bf16_t* yo = B.Y + (size_t)es * DM + h * 128 + eqd * 32;
#pragma unroll
        for (int i = 0; i < 4; ++i) { float o8[8]; unpack8(og4[i], o8); float r8[8];
#pragma unroll
            for (int k = 0; k < 8; ++k) { const float sg = __builtin_amdgcn_rcpf(1.f + __expf(-o8[k])); r8[k] = sg * x4[2 * i + (k >> 2)][k & 3] * rstd * gp4[2 * i + (k >> 2)][k & 3]; }
            *(u32x4*)(yo + i * 8) = pack8(r8); } }
    __syncthreads();
}

__device__ __forceinline__ void ret_out(const Bufs& B, const float* __restrict__ g_out, int item, LAS unsigned char* lds) {
    const int tid = ltid(), wid = tid >> 6, lane = tid & 63, wr = wid >> 2, wc = wid & 3, fr = lane & 15, fq = lane >> 4;
    const int c = item >> 2, h = item & 3, s0 = c * 128;
    LAS bf16_t* QB = (LAS bf16_t*)(lds + RQB); LAS bf16_t* KB = (LAS bf16_t*)(lds + RKB); LAS bf16_t* ST = (LAS bf16_t*)(lds + RST_); LAS bf16_t* VT = (LAS bf16_t*)(lds + RVT); LAS bf16_t* RT = (LAS bf16_t*)(lds + RRT);
    LAS float* HT = (LAS float*)(lds + RST_); LAS float* vcs = (LAS float*)(lds + CVEC); LAS float* vrw = vcs + 256;
    u32x4 rr1[2];
    { u32x4 rq[2], rk[2], rv[4], rr0[2];
        ld_N<128, 64>(rq, B.RQK + (size_t)s0 * 512 + h * 64, 512, tid);
        ld_N<128, 64>(rk, B.RQK + (size_t)s0 * 512 + 256 + h * 64, 512, tid);
        ld_T<128>(rv, B.PROJ + (size_t)s0 * NPROJP + PC_RV + h * 128, NPROJP, tid);
        ld_N<128, 64>(rr0, B.RST + (size_t)((0 * 4 + h) * 64 + c) * 8192, 64, tid);
        ld_N<128, 64>(rr1, B.RST + (size_t)((1 * 4 + h) * 64 + c) * 8192, 64, tid);
        st_N<128, 64>(QB, 72, rq, tid); st_N<128, 64>(KB, 72, rk, tid); st_T<128, false>(VT, 136, rv, HT, tid); st_N<128, 64>(RT, 72, rr0, tid); }
    if (tid < 256) { const int dir = tid >> 7, p = tid & 127, lp = dir ? 127 - p : p, hd = dir ? 3 - h : h; const float lg = log1pf(-exp2f(-5.f - (float)hd));
        vcs[tid] = __expf(-(float)lp * lg); vrw[tid] = __expf((float)lp * lg); }
    __syncthreads();
    f32x4 accS[4][2]; zero_acc<2>(accS);
    mma_tile<64, 2>(accS, KB, 72, QB, 72, wr, wc, fr, fq);
    f32x4 yacc[4][2]; zero_acc<2>(yacc);
#pragma unroll 1
    for (int dir = 0; dir < 2; ++dir) {
        const int hd = dir ? 3 - h : h; const float gam = 1.f - exp2f(-5.f - (float)hd);
        if (dir == 1) st_N<128, 64>(RT, 72, rr1, tid);
#pragma unroll
        for (int m = 0; m < 4; ++m)
#pragma unroll
            for (int n = 0; n < 2; ++n) { const int l = 32 * wc + 16 * n + fr, sb = 64 * wr + 16 * m + 4 * fq;
                const f32x4 c4 = *(const LAS f32x4*)(vcs + dir * 128 + sb); float v[4];
#pragma unroll
                for (int j = 0; j < 4; ++j) { const int s = sb + j; const bool ok = dir ? (s >= l) : (s <= l); v[j] = ok ? accS[m][n][j] * c4[j] : 0.f; }
                u32x2 w; w.x = cvt_pk_bf16(v[0], v[1]); w.y = cvt_pk_bf16(v[2], v[3]);
                *(LAS u32x2*)(ST + l * 136 + sb) = w; }
        __syncthreads();
        f32x4 accR[4][2]; zero_acc<2>(accR);
        mma_tile<64, 2>(accR, QB, 72, RT, 72, wr, wc, fr, fq);
#pragma unroll
        for (int m = 0; m < 4; ++m)
#pragma unroll
            for (int n = 0; n < 2; ++n) accR[m][n] *= gam;
        mma_tile<128, 2>(accR, ST, 136, VT, 136, wr, wc, fr, fq);
        __syncthreads();
#pragma unroll
        for (int m = 0; m < 4; ++m) { const f32x4 r4 = *(const LAS f32x4*)(vrw + dir * 128 + 64 * wr + 16 * m + 4 * fq);
#pragma unroll
            for (int n = 0; n < 2; ++n) yacc[m][n] += accR[m][n] * r4; }
    }
    const int erow = tid >> 2, eqd = tid & 3, es = s0 + erow;
    u32x4 og4[4]; f32x4 gp4[8];
    { const bf16_t* gg = B.PROJ + (size_t)es * NPROJP + PC_RG + h * 128 + eqd * 32; const float* gp = g_out + h * 128 + eqd * 32;
#pragma unroll
        for (int i = 0; i < 4; ++i) og4[i] = *(const u32x4*)(gg + i * 8);
#pragma unroll
        for (int i = 0; i < 8; ++i) gp4[i] = *(const f32x4*)(gp + i * 4); }
#pragma unroll
    for (int m = 0; m < 4; ++m)
#pragma unroll
        for (int n = 0; n < 2; ++n)
#pragma unroll
            for (int j = 0; j < 4; ++j) HT[(64 * wr + 16 * m + 4 * fq + j) * 132 + 32 * wc + 16 * n + fr] = yacc[m][n][j];
    __syncthreads();
    { float ssq = 0.f; f32x4 x4[8];
#pragma unroll
        for (int i = 0; i < 8; ++i) { x4[i] = *(const LAS f32x4*)(HT + erow * 132 + eqd * 32 + i * 4);
            ssq += x4[i][0] * x4[i][0] + x4[i][1] * x4[i][1] + x4[i][2] * x4[i][2] + x4[i][3] * x4[i][3]; }
        ssq += __shfl_xor(ssq, 1); ssq += __shfl_xor(ssq, 2);
        const float rstd = rsqrtf(ssq * (1.f / 128.f) + EPS_);
        bf16_t* yo = B.Y + (size_t)es * DM + 512 + h * 128 + eqd * 32;
#pragma unroll
        for (int i = 0; i < 4; ++i) { float o8[8]; unpack8(og4[i], o8); float r8[8];
#pragma unroll
            for (int k = 0; k < 8; ++k) { const float sl = o8[k] * __builtin_amdgcn_rcpf(1.f + __expf(-o8[k])); r8[k] = sl * x4[2 * i + (k >> 2)][k & 3] * rstd * gp4[2 * i + (k >> 2)][k & 3]; }
            *(u32x4*)(yo + i * 8) = pack8(r8); } }
    __syncthreads();
}

__device__ __forceinline__ int map_col(int n, int mode) {
    if (mode == 1) { const int h = n / 192, d = n % 192; if (d < 128) return h * 128 + d; const int jj = d - 128; return 1024 + h * 64 + 2 * (jj & 31) + (jj >> 5); }
    if (mode == 2) { const int h = n >> 8, d = n & 255; return d < 128 ? h * 128 + d : 1024 + h * 128 + (d - 128); }
    return n;
}
struct CvtTile { const float* W; bf16_t* dst; const float* gk; int K, N, kt, nt, mode; };
constexpr int TILES_L = 576 + 48 + 32 + 256 + 1024 + 1024;
__device__ __forceinline__ CvtTile cvt_get(const Params& p, int t) {
    const int l = t / TILES_L; int r = t % TILES_L; unsigned char* Wl = p.ws + OFF_W + (size_t)l * SZ_WL; CvtTile c; int nT; c.mode = 0; c.gk = nullptr;
    if (r < 576) { c.W = p.w_in + (size_t)l * DM * NPROJ; c.K = DM; c.N = NPROJ; nT = 18; c.dst = (bf16_t*)(Wl + WO_IN); c.gk = p.g_mix + l * DM; }
    else if ((r -= 576) < 48) { c.W = p.w_q_up + (size_t)l * 512 * 1536; c.K = 512; c.N = 1536; nT = 6; c.mode = 1; c.dst = (bf16_t*)(Wl + WO_Q); }
    else if ((r -= 48) < 32) { c.W = p.w_kv_up + (size_t)l * 256 * 2048; c.K = 256; c.N = 2048; nT = 8; c.mode = 2; c.dst = (bf16_t*)(Wl + WO_KV); }
    else if ((r -= 32) < 256) { c.W = p.w_out + (size_t)l * DM * DM; c.K = DM; c.N = DM; nT = 8; c.dst = (bf16_t*)(Wl + WO_OUT); }
    else if ((r -= 256) < 1024) { c.W = p.w_ff1 + (size_t)l * DM * DFF; c.K = DM; c.N = DFF; nT = 32; c.dst = (bf16_t*)(Wl + WO_1); c.gk = p.g_ffn + l * DM; }
    else { r -= 1024; c.W = p.w_ff2 + (size_t)l * DFF * DM; c.K = DFF; c.N = DM; nT = 8; c.dst = (bf16_t*)(Wl + WO_2); }
    c.kt = r / nT; c.nt = r % nT; return c;
}
__device__ __forceinline__ void cvt_load(const CvtTile& c, f32x4 (&v)[8], int tid) {
#pragma unroll
    for (int i = 0; i < 8; ++i) { const int k = (tid >> 6) + 8 * i, gn = c.nt * 256 + (tid & 63) * 4;
        v[i] = (f32x4){0.f, 0.f, 0.f, 0.f};
        if (gn < c.N) { v[i] = __builtin_nontemporal_load((const f32x4*)(c.W + (size_t)(c.kt * 64 + k) * c.N + gn)); if (c.gk) v[i] = v[i] * c.gk[c.kt * 64 + k]; } }
}
__device__ __forceinline__ void convert_phase(const Params& p, LAS unsigned char* lds) {
    LAS float* T = (LAS float*)lds;
    const int tid = ltid(), G = gridDim.x;
    int t = lbid();
    f32x4 v[8]; CvtTile c;
    if (t < NLAYER * TILES_L) { c = cvt_get(p, t); cvt_load(c, v, tid); }
    while (t < NLAYER * TILES_L) {
#pragma unroll
        for (int i = 0; i < 8; ++i) { const int k = (tid >> 6) + 8 * i, n4 = (tid & 63) * 4;
            T[k * 257 + n4] = v[i][0]; T[k * 257 + n4 + 1] = v[i][1]; T[k * 257 + n4 + 2] = v[i][2]; T[k * 257 + n4 + 3] = v[i][3]; }
        __syncthreads();
        const CvtTile cur = c; const int tn = t + G;
        if (tn < NLAYER * TILES_L) { c = cvt_get(p, tn); cvt_load(c, v, tid); }
#pragma unroll
        for (int i = 0; i < 4; ++i) { const int ch = tid + 512 * i, n = ch >> 3, k8 = (ch & 7) * 8, gn = cur.nt * 256 + n;
            if (gn < cur.N) { float f[8];
#pragma unroll
                for (int j = 0; j < 8; ++j) f[j] = T[(k8 + j) * 257 + n];
                *(u32x4*)(cur.dst + (size_t)map_col(gn, cur.mode) * cur.K + cur.kt * 64 + k8) = pack8(f); } }
        __syncthreads();
        t = tn;
    }
    constexpr int PADV = (NPROJP - NPROJ) * DM * 2 / 16;
    for (int i = lbid() * 512 + tid; i < NLAYER * PADV; i += G * 512) { const int l = i / PADV, j = i % PADV;
        ((u32x4*)(p.ws + OFF_W + (size_t)l * SZ_WL + WO_IN + (size_t)NPROJ * DM * 2))[j] = (u32x4){0u, 0u, 0u, 0u}; }
    for (int i = lbid() * 512 + tid; i < S_ * 32; i += G * 512) { const int s = i >> 5, j = i & 31;
        const float inv = powf(10000.f, -(float)j * (1.f / 32.f)); const float ang = (float)p.pos[s] * inv;
        const double a = (double)ang, tw = 6.283185307179586476925; const double r = a - tw * rint(a / tw); const float rf = (float)r;
        ((float*)(p.ws + OFF_ROPE))[i] = __cosf(rf); ((float*)(p.ws + OFF_ROPE))[S_ * 32 + i] = __sinf(rf); }
    { const int wid = tid >> 6, lane = tid & 63; bf16_t* H = (bf16_t*)(p.ws + OFF_H); unsigned long long* ssqa = (unsigned long long*)(p.ws + OFF_SSQA);
        for (int row = lbid() * 8 + wid; row < S_; row += G * 8) { const float* xr = p.x + (size_t)row * DM; float ssq = 0.f;
#pragma unroll
            for (int i = 0; i < 8; ++i) { const int col = (i * 64 + lane) * 4; const f32x4 x = *(const f32x4*)(xr + col);
                ssq += x[0] * x[0] + x[1] * x[1] + x[2] * x[2] + x[3] * x[3];
                u32x2 w; w.x = cvt_pk_bf16(x[0], x[1]); w.y = cvt_pk_bf16(x[2], x[3]); *(u32x2*)(H + (size_t)row * DM + col) = w; }
            ssq = wave_sum(ssq); if (lane == 0) ssqa[row] = (unsigned long long)(ssq * 1048576.f); } }
}

template <int MODE>
__device__ __forceinline__ void rms_phase(const float* __restrict__ src, const float* __restrict__ g, bf16_t* __restrict__ H, float* __restrict__ Xcopy, float* __restrict__ outf) {
    const int wid = ltid() >> 6, lane = ltid() & 63;
    for (int row = lbid() * 8 + wid; row < S_; row += gridDim.x * 8) {
        const float* xr = src + (size_t)row * DM; f32x4 v[8]; float ssq = 0.f;
#pragma unroll
        for (int i = 0; i < 8; ++i) { v[i] = *(const f32x4*)(xr + (i * 64 + lane) * 4); ssq += v[i][0] * v[i][0] + v[i][1] * v[i][1] + v[i][2] * v[i][2] + v[i][3] * v[i][3]; }
        ssq = wave_sum(ssq);
        const float rstd = rsqrtf(ssq * (1.f / DM) + EPS_);
#pragma unroll
        for (int i = 0; i < 8; ++i) { const int col = (i * 64 + lane) * 4; const f32x4 gv = *(const f32x4*)(g + col);
            const f32x4 y = v[i] * rstd * gv;
            if (MODE == 0) { u32x2 w; w.x = cvt_pk_bf16(y[0], y[1]); w.y = cvt_pk_bf16(y[2], y[3]); *(u32x2*)(H + (size_t)row * DM + col) = w;
                if (Xcopy) *(f32x4*)(Xcopy + (size_t)row * DM + col) = v[i]; }
            else *(f32x4*)(outf + (size_t)row * DM + col) = y; }
    }
}

__device__ __forceinline__ void final_phase(const bf16_t* __restrict__ H, const float* __restrict__ g, float* __restrict__ outf) {
    const int tid = ltid(), wid = tid >> 6, lane = tid & 63;
    for (int row = lbid() * 8 + wid; row < S_; row += gridDim.x * 8) {
        float v[32]; float ssq = 0.f;
#pragma unroll
        for (int i = 0; i < 4; ++i) { float f[8]; unpack8(*(const u32x4*)(H + (size_t)row * DM + (i * 64 + lane) * 8), f);
#pragma unroll
            for (int k = 0; k < 8; ++k) { v[i * 8 + k] = f[k]; ssq += f[k] * f[k]; } }
        ssq = wave_sum(ssq);
        const float rstd = rsqrtf(ssq * (1.f / DM) + EPS_);
#pragma unroll
        for (int i = 0; i < 4; ++i) { const int col = (i * 64 + lane) * 8;
#pragma unroll
            for (int q = 0; q < 2; ++q) { const f32x4 gv = *(const f32x4*)(g + col + q * 4); f32x4 y;
#pragma unroll
                for (int k = 0; k < 4; ++k) y[k] = v[i * 8 + q * 4 + k] * rstd * gv[k];
                *(f32x4*)(outf + (size_t)row * DM + col + q * 4) = y; } }
    }
}

__device__ __forceinline__ void prep_phase(const Params& p, const Bufs& B, int l) {
    const int wid = ltid() >> 6, lane = ltid() & 63;
    const float* wconv = p.w_conv + (size_t)l * 3 * 1024; const float* bg = p.b_gates + l * 16;
    const float* gq = p.g_q_norm + l * 512; const float* gkv = p.g_kv_norm + l * 256;
    for (int s = lbid() * 8 + wid; s < S_; s += gridDim.x * 8) {
        const bf16_t* pr = B.PROJ + (size_t)s * NPROJP;
#pragma unroll
        for (int hf = 0; hf < 2; ++hf) { const int c0 = lane * 16 + hf * 8; float xm[8], x0[8], xp[8], r[8];
            if (s > 0) unpack8(*(const u32x4*)(pr - NPROJP + c0), xm); else { for (int i = 0; i < 8; ++i) xm[i] = 0.f; }
            unpack8(*(const u32x4*)(pr + c0), x0);
            if (s < S_ - 1) unpack8(*(const u32x4*)(pr + NPROJP + c0), xp); else { for (int i = 0; i < 8; ++i) xp[i] = 0.f; }
#pragma unroll
            for (int i = 0; i < 8; ++i) { const float v = xm[i] * wconv[c0 + i] + x0[i] * wconv[1024 + c0 + i] + xp[i] * wconv[2048 + c0 + i]; r[i] = v / (1.f + __expf(-v)); }
            *(u32x4*)(B.QKML + (size_t)s * 1024 + c0) = pack8(r); }
        { const int tensor = lane >> 5, head = (lane & 31) >> 3, j0 = (lane & 7) * 4, base = PC_RQ + tensor * 256 + head * 64;
            const u32x2 w1 = *(const u32x2*)(pr + base + j0), w2 = *(const u32x2*)(pr + base + 32 + j0);
            const float x1[4] = {bflo(w1.x), bfhi(w1.x), bflo(w1.y), bfhi(w1.y)}, x2[4] = {bflo(w2.x), bfhi(w2.x), bflo(w2.y), bfhi(w2.y)};
            const f32x4 c = *(const f32x4*)(B.RC + (size_t)s * 32 + j0), sn = *(const f32x4*)(B.RS + (size_t)s * 32 + j0);
            const float sc = tensor ? 0.125f : 1.f; float o1[4], o2[4];
#pragma unroll
            for (int i = 0; i < 4; ++i) { o1[i] = (x1[i] * c[i] - x2[i] * sn[i]) * sc; o2[i] = (x2[i] * c[i] + x1[i] * sn[i]) * sc; }
            u32x2 a, b; a.x = cvt_pk_bf16(o1[0], o1[1]); a.y = cvt_pk_bf16(o1[2], o1[3]); b.x = cvt_pk_bf16(o2[0], o2[1]); b.y = cvt_pk_bf16(o2[2], o2[3]);
            bf16_t* d = B.RQK + (size_t)s * 512 + tensor * 256 + head * 64 + j0; *(u32x2*)d = a; *(u32x2*)(d + 32) = b; }
        { float f[8]; unpack8(*(const u32x4*)(pr + PC_CQ + lane * 8), f); float ssq = 0.f;
#pragma unroll
            for (int i = 0; i < 8; ++i) ssq += f[i] * f[i];
            ssq = wave_sum(ssq); const float rstd = rsqrtf(ssq * (1.f / 512.f) + EPS_);
#pragma unroll
            for (int i = 0; i < 8; ++i) f[i] = f[i] * rstd * gq[lane * 8 + i];
            *(u32x4*)(B.CQN + (size_t)s * 512 + lane * 8) = pack8(f); }
        { const u32x2 w = *(const u32x2*)(pr + PC_CKV + lane * 4); float f[4] = {bflo(w.x), bfhi(w.x), bflo(w.y), bfhi(w.y)};
            float ssq = f[0] * f[0] + f[1] * f[1] + f[2] * f[2] + f[3] * f[3];
            ssq = wave_sum(ssq); const float rstd = rsqrtf(ssq * (1.f / 256.f) + EPS_);
#pragma unroll
            for (int i = 0; i < 4; ++i) f[i] = f[i] * rstd * gkv[lane * 4 + i];
            u32x2 o; o.x = cvt_pk_bf16(f[0], f[1]); o.y = cvt_pk_bf16(f[2], f[3]); *(u32x2*)(B.CKVN + (size_t)s * 256 + lane * 4) = o; }
        if (lane < 32) { const float x1 = bf2f(pr[PC_KR + lane]), x2 = bf2f(pr[PC_KR + 32 + lane]); const float c = B.RC[(size_t)s * 32 + lane], sn = B.RS[(size_t)s * 32 + lane];
            const unsigned w = cvt_pk_bf16(x1 * c - x2 * sn, x2 * c + x1 * sn);
#pragma unroll
            for (int h = 0; h < 8; ++h) *(unsigned*)(B.K + ((size_t)h * S_ + s) * 192 + 128 + 2 * lane) = w; }
        if (lane < 16) { float v = bf2f(pr[PC_GATE + lane]) + bg[lane];
            if ((lane >> 2) & 1) v = fminf(v, 0.f) - log1pf(__expf(-fabsf(v)));
            B.G[(size_t)s * 16 + lane] = v; }
    }
}

constexpr int NSUB = 8;
constexpr int NPHASE = 2 + NLAYER * NSUB;
__global__ void __launch_bounds__(512) mega_fwd(Params p) {
    extern __shared__ __attribute__((aligned(16))) unsigned char lds_raw[];
    LAS unsigned char* lds = (LAS unsigned char*)lds_raw;
    cg::grid_group grid = cg::this_grid();
    const int G = gridDim.x;
    volatile LAS unsigned* xst = (volatile LAS unsigned*)(lds + LDS_BYTES - 16);
    if (threadIdx.x == 0) { xst[0] = 0u; xst[1] = 0u; }
    if (blockIdx.x == 0) { unsigned* bw = (unsigned*)(p.ws + OFF_BAR); for (int i = threadIdx.x; i < XCD_BAR_WORDS; i += 512) bw[i] = 0u; __threadfence(); }
    __syncthreads();
    XcdBarrier xbar; xbar.bar = (unsigned*)(p.ws + OFF_BAR); xbar.x = 0; xbar.st = xst;
    for (int ph = p.ph_lo; ph < p.ph_hi; ++ph) {
        if (ph > p.ph_lo) { if (ph == p.ph_lo + 1) { grid.sync(); xbar = xcd_barrier_post((unsigned*)(p.ws + OFF_BAR), xst); } else xcd_barrier(xbar); }
        const int bx = lbid();
        unsigned char* ws = p.ws; asm volatile("" : "+s"(ws));
        Bufs B;
        B.H = (bf16_t*)(ws + OFF_H); B.Y = (bf16_t*)(ws + OFF_Y); B.QKML = (bf16_t*)(ws + OFF_QKML); B.RQK = (bf16_t*)(ws + OFF_RQK); B.CQN = (bf16_t*)(ws + OFF_CQN);
        B.CKVN = (bf16_t*)(ws + OFF_CKVN); B.CST = (bf16_t*)(ws + OFF_CST); B.RST = (bf16_t*)(ws + OFF_RST); B.PROJ = (bf16_t*)(ws + OFF_PROJ);
        B.Q = (bf16_t*)(ws + OFF_Q); B.K = (bf16_t*)(ws + OFF_K); B.V = (bf16_t*)(ws + OFF_V); B.ACT = (bf16_t*)(ws + OFF_ACT);
        B.X = (float*)(ws + OFF_X); B.RC = (float*)(ws + OFF_ROPE); B.RS = B.RC + S_ * 32; B.G = (float*)(ws + OFF_G); B.CLOC = (float*)(ws + OFF_CLOC);
        B.NLOC = (float*)(ws + OFF_NLOC); B.NST = (float*)(ws + OFF_NST); B.MLOC = (float*)(ws + OFF_MLOC); B.BLAST = (float*)(ws + OFF_BLAST); B.MST = (float*)(ws + OFF_MST);
        B.RLOC = (float*)(ws + OFF_RLOC); B.Wl = nullptr;
        unsigned long long* ssqa = (unsigned long long*)(ws + OFF_SSQA); unsigned long long* ssqb = (unsigned long long*)(ws + OFF_SSQB);
        if (ph == 0) { convert_phase(p, lds); continue; }
        if (ph == NPHASE - 1) { final_phase(B.H, p.g_final, p.out); continue; }
        const int l = (ph - 1) / NSUB, sub = (ph - 1) % NSUB;
        unsigned char* Wl = ws + OFF_W + (size_t)l * SZ_WL;
        pg8::StaticOrder so;
        switch (sub) {
        case 0: { so.init(S_, NPROJP - 512, G, bx, 6, 2); pg8::Gemm g{B.H, (const bf16_t*)(Wl + WO_IN), S_, NPROJP, DM}; pg8::EpiBf16<0> e{B.PROJ, NPROJP, ssqa}; pg8::gemm_phase(lds, g, so, e); } break;
        case 1: prep_phase(p, B, l); break;
        case 2: {
            if (bx < 192) { so.init(S_, 1536, 192, bx); pg8::Gemm g{B.CQN, (const bf16_t*)(Wl + WO_Q), S_, 1536, 512}; pg8::EpiQup e{B.Q, B.RC, B.RS}; pg8::gemm_phase(lds, g, so, e); }
            else { so.init(S_, 512, 64, bx - 192, 0, 6); pg8::Gemm g{B.H, (const bf16_t*)(Wl + WO_IN), S_, NPROJP, DM}; pg8::EpiBf16<0> e{B.PROJ, NPROJP, ssqa}; pg8::gemm_phase(lds, g, so, e); }
            { so.init(S_, 2048, G, bx); pg8::Gemm g{B.CKVN, (const bf16_t*)(Wl + WO_KV), S_, 2048, 256}; pg8::EpiKVup e{B.K, B.V}; pg8::gemm_phase(lds, g, so, e); }
            if (bx < 192) for (int it = bx; it < 1024; it += 192) { if (it < 512) mlstm_local(B, it, lds); else ret_local(B, it - 512, lds); }
        } break;
        case 3: { scan_phase(B);
            for (int i = bx * 512 + ltid(); i < S_; i += G * 512) { ssqa[i] = 0ull; ssqb[i] = 0ull; } } break;
        case 4: {
            for (int it = bx; it < 256; it += G) mlstm_out(B, p.g_ml_out + l * 512, it, lds);
            for (int it = bx; it < 256; it += G) ret_out(B, p.g_ret_out + l * 512, it, lds);
            for (int it = bx; it < 256; it += G) { const int h = it & 7, qb = it >> 3;
                att::attn_body(B.Q + ((size_t)h * S_ + qb * 256) * 192, B.K + (size_t)h * S_ * 192, B.V + (size_t)h * S_ * 128,
                               B.Y + (size_t)(qb * 256) * DM + 1024 + h * 128, S_, (char*)lds_raw); }
        } break;
        case 5: { so.init(S_, DM, G, bx); pg8::Gemm g{B.Y, (const bf16_t*)(Wl + WO_OUT), S_, DM, DM};
 pg8::EpiResid e{B.H, ssqb, DM}; pg8::gemm_phase(lds, g, so, e); } break;
        case 6: { so.init(S_, DFF, G, bx); pg8::Gemm g{B.H, (const bf16_t*)(Wl + WO_1), S_, DFF, DM}; pg8::EpiBf16<1> e{B.ACT, DFF, ssqb}; pg8::gemm_phase(lds, g, so, e); } break;
        case 7: { so.init(S_, DM, G, bx); pg8::Gemm g{B.ACT, (const bf16_t*)(Wl + WO_2), S_, DM, DFF};
            pg8::EpiResid e{B.H, ssqa, DM}; pg8::gemm_phase(lds, g, so, e); } break;
        }
    }
}

#ifndef MK_MULTI
#define MK_MULTI 0
#endif
extern "C" void kernel_launch(void* const* d_in, const int* in_sizes, int n_in, void* d_out, int out_size, void* d_ws, size_t ws_size, hipStream_t stream) {
    static int grid = 0;
    if (grid == 0) {
        if (n_in != 17 || out_size != S_ * DM || ws_size < WS_END) { fprintf(stderr, "kernel_launch: unexpected shapes: n_in %d out %d ws %zu (need %zu)\n", n_in, out_size, ws_size, (size_t)WS_END); grid = -1; return; }
        int dev = 0, cus = 0, per_cu = 0;
        hipGetDevice(&dev); hipDeviceGetAttribute(&cus, hipDeviceAttributeMultiprocessorCount, dev);
        if (hipFuncSetAttribute((const void*)mega_fwd, hipFuncAttributeMaxDynamicSharedMemorySize, LDS_BYTES) != hipSuccess) { fprintf(stderr, "kernel_launch: hipFuncSetAttribute failed\n"); grid = -1; return; }
        if (hipOccupancyMaxActiveBlocksPerMultiprocessor(&per_cu, (const void*)mega_fwd, 512, LDS_BYTES) != hipSuccess || per_cu < 1) { fprintf(stderr, "kernel_launch: occupancy query says %d\n", per_cu); per_cu = 1; }
        (void)hipGetLastError();
        grid = cus * 1;
        fprintf(stderr, "kernel_launch: cus %d per_cu %d grid %d\n", cus, per_cu, grid);
    }
    if (grid < 0) return;
    Params p{};
    p.x = (const float*)d_in[0]; p.pos = (const int*)d_in[1]; p.g_mix = (const float*)d_in[2]; p.w_in = (const float*)d_in[3]; p.b_gates = (const float*)d_in[4];
    p.w_conv = (const float*)d_in[5]; p.g_ml_out = (const float*)d_in[6]; p.g_ret_out = (const float*)d_in[7]; p.g_q_norm = (const float*)d_in[8]; p.w_q_up = (const float*)d_in[9];
    p.g_kv_norm = (const float*)d_in[10]; p.w_kv_up = (const float*)d_in[11]; p.w_out = (const float*)d_in[12]; p.g_ffn = (const float*)d_in[13]; p.w_ff1 = (const float*)d_in[14];
    p.w_ff2 = (const float*)d_in[15]; p.g_final = (const float*)d_in[16]; p.out = (float*)d_out; p.ws = (unsigned char*)d_ws;
#if MK_MULTI
    for (int ph = 0; ph < NPHASE; ++ph) { p.ph_lo = ph; p.ph_hi = ph + 1; hipLaunchKernelGGL(mega_fwd, dim3(grid), dim3(512), LDS_BYTES, stream, p); }
#else
    p.ph_lo = 0; p.ph_hi = NPHASE;
    void* args[] = {&p};
    hipError_t e = hipLaunchCooperativeKernel((const void*)mega_fwd, dim3(grid), dim3(512), args, LDS_BYTES, stream);
    if (e != hipSuccess) fprintf(stderr, "kernel_launch: cooperative launch failed: %s (grid %d)\n", hipGetErrorString(e), grid);
#endif
}
```

```cpp
#include <hip/hip_runtime.h>
#include <hip/hip_cooperative_groups.h>
#include <cstdio>
#include <cstdint>
namespace cg = cooperative_groups;

typedef unsigned short bf16_t;
typedef short bf16x8 __attribute__((ext_vector_type(8)));
typedef short s16x4 __attribute__((ext_vector_type(4)));
typedef float f32x4 __attribute__((ext_vector_type(4)));
typedef float f32x16 __attribute__((ext_vector_type(16)));
typedef unsigned u32x4 __attribute__((ext_vector_type(4)));
typedef unsigned u32x2 __attribute__((ext_vector_type(2)));
#define LAS __attribute__((address_space(3)))

constexpr int S_ = 8192, DM = 2048, NPROJ = 4432, NPROJP = 4608, DFF = 8192, NLAYER = 4;
constexpr float EPS_ = 1e-6f;
constexpr int LDS_BYTES = 147456;

constexpr int PC_MLQ = 0, PC_MLK = 512, PC_MLV = 1024, PC_MLO = 1536, PC_GATE = 2048, PC_RQ = 2064, PC_RK = 2320, PC_RV = 2576, PC_RG = 3088,
              PC_CQ = 3600, PC_CKV = 4112, PC_KR = 4368;

constexpr size_t SZ_WIN = (size_t)NPROJP * DM * 2, SZ_WQ = (size_t)1536 * 512 * 2, SZ_WKV = (size_t)2048 * 256 * 2, SZ_WOUT = (size_t)DM * DM * 2,
                 SZ_W1 = (size_t)DFF * DM * 2, SZ_W2 = (size_t)DM * DFF * 2;
constexpr size_t WO_IN = 0, WO_Q = WO_IN + SZ_WIN, WO_KV = WO_Q + SZ_WQ, WO_OUT = WO_KV + SZ_WKV, WO_1 = WO_OUT + SZ_WOUT, WO_2 = WO_1 + SZ_W1, SZ_WL = WO_2 + SZ_W2;
constexpr size_t OFF_W = 0;
constexpr size_t OFF_X = OFF_W + NLAYER * SZ_WL;
constexpr size_t OFF_H = OFF_X + (size_t)S_ * DM * 4;
constexpr size_t OFF_Y = OFF_H + (size_t)S_ * DM * 2;
constexpr size_t OFF_ROPE = OFF_Y + (size_t)S_ * DM * 2;
constexpr size_t OFF_G = OFF_ROPE + (size_t)S_ * 32 * 4 * 2;
constexpr size_t OFF_QKML = OFF_G + (size_t)S_ * 16 * 4;
constexpr size_t OFF_RQK = OFF_QKML + (size_t)S_ * 1024 * 2;
constexpr size_t OFF_CQN = OFF_RQK + (size_t)S_ * 512 * 2;
constexpr size_t OFF_CKVN = OFF_CQN + (size_t)S_ * 512 * 2;
constexpr size_t OFF_CLOC = OFF_CKVN + (size_t)S_ * 256 * 2;
constexpr size_t OFF_CST = OFF_CLOC + (size_t)512 * 16384 * 4;
constexpr size_t OFF_NLOC = OFF_CST + (size_t)512 * 16384 * 2;
constexpr size_t OFF_NST = OFF_NLOC + (size_t)512 * 128 * 4;
constexpr size_t OFF_MLOC = OFF_NST + (size_t)512 * 128 * 4;
constexpr size_t OFF_BLAST = OFF_MLOC + 2048;
constexpr size_t OFF_MST = OFF_BLAST + 2048;
constexpr size_t OFF_RLOC = OFF_MST + 2048;
constexpr size_t OFF_RST = OFF_RLOC + (size_t)512 * 8192 * 4;
constexpr size_t OFF_BAR = OFF_RST + (size_t)512 * 8192 * 2;
constexpr size_t OFF_SSQA = OFF_BAR + 16384;
constexpr size_t OFF_SSQB = OFF_SSQA + (size_t)S_ * 8;
constexpr size_t OFF_MIX = OFF_SSQB + (size_t)S_ * 8;
constexpr size_t OFF_PROJ = OFF_MIX;
constexpr size_t OFF_Q = OFF_PROJ + (size_t)S_ * NPROJP * 2;
constexpr size_t OFF_K = OFF_Q + (size_t)8 * S_ * 192 * 2;
constexpr size_t OFF_V = OFF_K + (size_t)8 * S_ * 192 * 2;
constexpr size_t OFF_END0 = OFF_V + (size_t)8 * S_ * 128 * 2;
constexpr size_t OFF_ACT = OFF_MIX;
constexpr size_t OFF_END1 = OFF_ACT + (size_t)S_ * DFF * 2;
constexpr size_t WS_END = OFF_END0 > OFF_END1 ? OFF_END0 : OFF_END1;

struct Params {
    const float* x; const int* pos; const float* g_mix; const float* w_in; const float* b_gates; const float* w_conv;
    const float* g_ml_out; const float* g_ret_out; const float* g_q_norm; const float* w_q_up; const float* g_kv_norm; const float* w_kv_up;
    const float* w_out; const float* g_ffn; const float* w_ff1; const float* w_ff2; const float* g_final;
    float* out; unsigned char* ws;
    int ph_lo, ph_hi;
};

__device__ __forceinline__ unsigned cvt_pk_bf16(float lo, float hi) { unsigned r; asm volatile("v_cvt_pk_bf16_f32 %0, %1, %2" : "=v"(r) : "v"(lo), "v"(hi)); return r; }
__device__ __forceinline__ int ltid() { int t = threadIdx.x; asm volatile("" : "+v"(t)); return t; }
__device__ __forceinline__ int lbid() { int t = blockIdx.x; asm volatile("" : "+s"(t)); return t; }
__device__ __forceinline__ float bf2f(bf16_t b) { return __uint_as_float(((unsigned)b) << 16); }
__device__ __forceinline__ float bflo(unsigned w) { return __uint_as_float(w << 16); }
__device__ __forceinline__ float bfhi(unsigned w) { return __uint_as_float(w & 0xffff0000u); }
__device__ __forceinline__ bf16_t f2bf(float f) { return (bf16_t)(cvt_pk_bf16(f, 0.f) & 0xffffu); }
__device__ __forceinline__ float wave_sum(float v) { for (int o = 32; o > 0; o >>= 1) v += __shfl_xor(v, o); return v; }
__device__ __forceinline__ float wave_max(float v) { for (int o = 32; o > 0; o >>= 1) v = fmaxf(v, __shfl_xor(v, o)); return v; }
__device__ __forceinline__ void unpack8(u32x4 w, float* f) { f[0] = bflo(w.x); f[1] = bfhi(w.x); f[2] = bflo(w.y); f[3] = bfhi(w.y); f[4] = bflo(w.z); f[5] = bfhi(w.z); f[6] = bflo(w.w); f[7] = bfhi(w.w); }
__device__ __forceinline__ u32x4 pack8(const float* f) { u32x4 w; w.x = cvt_pk_bf16(f[0], f[1]); w.y = cvt_pk_bf16(f[2], f[3]); w.z = cvt_pk_bf16(f[4], f[5]); w.w = cvt_pk_bf16(f[6], f[7]); return w; }


#define XB_TMO      128
#define XB_XCNT(j)  (256  + 64 * (j))
#define XB_XSUB(j)  (1280 + 64 * (j))
#define XB_XGEN(j)  (2304 + 64 * (j))
#define XB_TOP      3328
#define XB_TOPGEN   3392
#define XCD_BAR_WORDS 3456
#define XB_SPIN_CAP (1u << 18)

__device__ __forceinline__ unsigned xb_ld(unsigned* p)              { return __hip_atomic_load(p, __ATOMIC_RELAXED, __HIP_MEMORY_SCOPE_AGENT); }
__device__ __forceinline__ unsigned xb_add(unsigned* p, unsigned v) { return __hip_atomic_fetch_add(p, v, __ATOMIC_RELAXED, __HIP_MEMORY_SCOPE_AGENT); }
__device__ __forceinline__ unsigned xb_xcc_id() { return (unsigned)__builtin_amdgcn_s_getreg((3 << 11) | 20) & 0xFu; }
#define XB_SPIN(cond, bar) do { unsigned _sp = 0; while (cond) { __builtin_amdgcn_s_sleep(1); \
    if ((++_sp & 255u) == 0u) { if (xb_ld(&(bar)[XB_TMO])) break; if (_sp > XB_SPIN_CAP) { atomicAdd(&(bar)[XB_TMO], 1u); break; } } } } while (0)

struct XcdBarrier {
    unsigned* bar; unsigned x;
    volatile LAS unsigned* st;
};

__device__ __forceinline__ XcdBarrier xcd_barrier_post(unsigned* bar, volatile LAS unsigned* st) {
    XcdBarrier b; b.bar = bar; b.x = xb_xcc_id(); b.st = st;
    if (threadIdx.x == 0) (void)xb_add(&bar[XB_XCNT(b.x)], 1u);
    return b;
}
__device__ __forceinline__ void xcd_barrier_complete(unsigned* bar, unsigned x, unsigned& nloc, unsigned& nx) {
    const unsigned G = gridDim.x * gridDim.y * gridDim.z;
    unsigned sum, cnt, mine, sp = 0u;
    for (;;) {
        sum = 0u; cnt = 0u; mine = 0u;
#pragma unroll
        for (unsigned j = 0; j < 16; ++j) { const unsigned c = xb_ld(&bar[XB_XCNT(j)]); sum += c; cnt += (c > 0u) ? 1u : 0u; mine = (j == x) ? c : mine; }
        if (sum == G) break;
        __builtin_amdgcn_s_sleep(1);
        if ((++sp & 255u) == 0u) { if (xb_ld(&bar[XB_TMO])) break; if (sp > XB_SPIN_CAP) { atomicAdd(&bar[XB_TMO], 1u); break; } }
    }
    nloc = mine > 0u ? mine : 1u; nx = cnt > 0u ? cnt : 1u;
}

__device__ __forceinline__ void xcd_barrier(const XcdBarrier& b) {
    asm volatile("s_waitcnt vmcnt(0)" ::: "memory");
    __syncthreads();
    if (threadIdx.x == 0) {
        unsigned* bar = b.bar;
        __builtin_amdgcn_s_waitcnt(0);
        unsigned nloc = b.st[0], nx = b.st[1];
        if (nloc == 0u) { xcd_barrier_complete(bar, b.x, nloc, nx); b.st[0] = nloc; b.st[1] = nx; }
        const unsigned old = xb_add(&bar[XB_XSUB(b.x)], 1u);
        const unsigned gen = old / nloc;
        if (old + 1u == (gen + 1u) * nloc) {
            __builtin_amdgcn_fence(__ATOMIC_RELEASE, "agent");
            asm volatile("s_waitcnt vmcnt(0)" ::: "memory");
            const unsigned og = xb_add(&bar[XB_TOP], 1u);
            const unsigned tg = og / nx;
            if (og + 1u == (tg + 1u) * nx) xb_add(&bar[XB_TOPGEN], 1u);
            else XB_SPIN(xb_ld(&bar[XB_TOPGEN]) == tg, bar);
            __builtin_amdgcn_fence(__ATOMIC_ACQUIRE, "agent");
            xb_add(&bar[XB_XGEN(b.x)], 1u);
            asm volatile("s_waitcnt vmcnt(0)" ::: "memory");
        } else {
            XB_SPIN(xb_ld(&bar[XB_XGEN(b.x)]) == gen, bar);
            __builtin_amdgcn_fence(__ATOMIC_ACQUIRE, "agent");
            asm volatile("s_waitcnt vmcnt(0)" ::: "memory");
        }
    }
    __syncthreads();
}

namespace pg8 {
constexpr int BM = 256, BK = 64, HALF = 128, HTB = HALF * BK * 2, STAGE_BYTES = 8 * HTB, NXCD = 8, WGM = 8;
__host__ __device__ __forceinline__ int lds_byte(int r, int c) { const int st = (r >> 4) * 2 + (c >> 5), rr = r & 15, cc = c & 31, ob = rr * 64 + cc * 2; return st * 1024 + (ob ^ (((ob >> 9) & 1) << 5)); }
__host__ __device__ __forceinline__ void stage_rc(int b, int& R, int& C) { const int st = b / 1024, sb = b % 1024, swz = sb ^ (((sb >> 9) & 1) << 5); R = (st >> 1) * 16 + swz / 64; C = (st & 1) * 32 + (swz % 64) / 2; }
__host__ __device__ __forceinline__ int perm32(int rho) { const int n = rho >> 4, i = rho & 15; return 8 * (i >> 2) + 4 * n + (i & 3); }
struct Unit { int pm, pn; };
struct Gemm { const bf16_t* A; const bf16_t* Bt; int M, N, K; };
struct StaticOrder {
    int nM, nN, nwg, G, c, skip_lo, skip_n, ioff = 0, icnt = 1 << 20;
    __device__ void init(int M, int N, int G_, int c_, int slo = 1 << 20, int sn = 0) { nM = M / BM; nN = N / BM; nwg = nM * nN; G = G_; c = c_; skip_lo = slo; skip_n = sn; }
    __device__ bool next(int i, Unit& u) const {
        if (i >= icnt) return false; const long L = (long)(i + ioff) * G + c; if (L >= nwg) return false;
        int wgid = (int)L; { const int q = nwg / NXCD, r = nwg % NXCD, xcd = wgid % NXCD, off = wgid / NXCD; wgid = (xcd < r ? xcd * (q + 1) : r * (q + 1) + (xcd - r) * q) + off; }
        const int nig = WGM * nN, gid = wgid / nig, fm = gid * WGM, gsz = (nM - fm) < WGM ? (nM - fm) : WGM;
        u.pm = fm + ((wgid % nig) % gsz); u.pn = (wgid % nig) / gsz; if (u.pn >= skip_lo) u.pn += skip_n; return true;
    }
};
template <class Epi>
__device__ __forceinline__ void gemm_phase(LAS unsigned char* lds, const Gemm g, const StaticOrder& S, const Epi& E) {
    const int tid = ltid(), wid = __builtin_amdgcn_readfirstlane(tid >> 6), lane = tid & 63, wr = wid >> 2, wc = wid & 3, fr = lane & 15, fq = lane >> 4;
    int K = g.K; asm volatile("" : "+s"(K)); const int nt = K / BK;
    unsigned voffA[2], voffB[2];
#pragma unroll
    for (int i = 0; i < 2; ++i) { int R, C; stage_rc(tid * 16 + i * 8192, R, C); const int Rb = Epi::PERM ? ((R & ~31) + perm32(R & 31)) : R;
        voffA[i] = (unsigned)(R * K + C) * 2u; voffB[i] = (unsigned)(Rb * K + C) * 2u; }
    const size_t kstep = (size_t)(BK * 2);
    const size_t hstep = (size_t)HALF * K * 2;
    const size_t tstep = 2 * hstep;
    const unsigned ldsw = (unsigned)wid * 1024u;
    const int aoff = lds_byte(wr * 64 + fr, fq * 8), boff = lds_byte(wc * 32 + fr, fq * 8);
#define PG8_SA(b, h) (((b) * 2 + (h)) * HTB)
#define PG8_SB(b, h) ((4 + (b) * 2 + (h)) * HTB)
#define PG8_STAGE(bufoff, gbase, voff) do { _Pragma("unroll") for (int _i = 0; _i < 2; ++_i) \
        __builtin_amdgcn_global_load_lds((const unsigned*)((const char*)(gbase) + (voff)[_i]), (LAS unsigned*)(lds + (bufoff) + ldsw + _i * 8192), 16, 0, 0); } while (0)
#define PG8_LDA(dst, b, h) do { _Pragma("unroll") for (int m = 0; m < 4; ++m) _Pragma("unroll") for (int k = 0; k < 2; ++k) dst[m][k] = *(const LAS bf16x8*)(lds + PG8_SA(b, h) + aoff + m * 2048 + k * 1024); } while (0)
#define PG8_LDB(dst, b, h) do { _Pragma("unroll") for (int n = 0; n < 2; ++n) _Pragma("unroll") for (int k = 0; k < 2; ++k) dst[n][k] = *(const LAS bf16x8*)(lds + PG8_SB(b, h) + boff + n * 2048 + k * 1024); } while (0)
#define PG8_MMA(ai, bj, At, Bt) do { __builtin_amdgcn_s_setprio(1); _Pragma("unroll") for (int m = 0; m < 4; ++m) _Pragma("unroll") for (int n = 0; n < 2; ++n) _Pragma("unroll") for (int k = 0; k < 2; ++k) \
        acc[ai][bj][m][n] = __builtin_amdgcn_mfma_f32_16x16x32_bf16(Bt[n][k], At[m][k], acc[ai][bj][m][n], 0, 0, 0); __builtin_amdgcn_s_setprio(0); } while (0)
#define PG8_WAIT_V(n) asm volatile("s_waitcnt vmcnt(" #n ")" ::: "memory")
#define PG8_WAIT_L(n) asm volatile("s_waitcnt lgkmcnt(" #n ")" ::: "memory")
#define PG8_BAR __builtin_amdgcn_s_barrier()
#define PG8_SCHED __builtin_amdgcn_sched_barrier(0)
    Unit cur, nxt; int ui = 0;
    if (!S.next(0, cur)) return;
    f32x4 acc[2][2][4][2];
#pragma unroll
    for (int a = 0; a < 2; ++a)
#pragma unroll
        for (int b = 0; b < 2; ++b)
#pragma unroll
            for (int m = 0; m < 4; ++m)
#pragma unroll
                for (int n = 0; n < 2; ++n) acc[a][b][m][n] = (f32x4){0.f, 0.f, 0.f, 0.f};
    bf16x8 At[4][2], B0[2][2], B1[2][2];
    const char* cA = (const char*)g.A + (size_t)cur.pm * tstep; const char* cB = (const char*)g.Bt + (size_t)cur.pn * tstep;
    if (Epi::PRE) E.stash(E.prefetch(cur.pm, tid), lds, 0, tid);
    PG8_STAGE(PG8_SB(0, 0), cB, voffB); PG8_STAGE(PG8_SA(0, 0), cA, voffA); PG8_STAGE(PG8_SB(0, 1), cB + hstep, voffB); PG8_STAGE(PG8_SA(0, 1), cA + hstep, voffA);
    if (wr == 1) PG8_BAR;
    PG8_WAIT_V(4); PG8_BAR;
    PG8_STAGE(PG8_SB(1, 0), cB + kstep, voffB); PG8_STAGE(PG8_SA(1, 0), cA + kstep, voffA); PG8_STAGE(PG8_SB(1, 1), cB + hstep + kstep, voffB);
    PG8_WAIT_V(6); PG8_BAR;
    for (;;) {
        const bool has_next = S.next(ui + 1, nxt);
        const char* nA = has_next ? (const char*)g.A + (size_t)nxt.pm * tstep : cA; const char* nB = has_next ? (const char*)g.Bt + (size_t)nxt.pn * tstep : cB;
        for (int t = 0; t < nt; t += 2) {
            const bool last = (t == nt - 2);
            const char* a1 = cA + (size_t)(t + 1) * kstep;
            const char* a2 = last ? nA : cA + (size_t)(t + 2) * kstep; const char* b2 = last ? nB : cB + (size_t)(t + 2) * kstep;
            const char* a3 = a2 + kstep; const char* b3 = b2 + kstep;
            PG8_LDB(B0, 0, 0); PG8_SCHED; PG8_LDA(At, 0, 0); PG8_STAGE(PG8_SA(1, 1), a1 + hstep, voffA);
            PG8_WAIT_L(8); PG8_BAR; PG8_WAIT_L(0); PG8_MMA(0, 0, At, B0); PG8_BAR; PG8_SCHED;
            PG8_LDB(B1, 0, 1); PG8_STAGE(PG8_SB(0, 0), b2, voffB);
            PG8_BAR; PG8_WAIT_L(0); PG8_MMA(0, 1, At, B1); PG8_BAR;
            PG8_LDA(At, 0, 1); PG8_STAGE(PG8_SA(0, 0), a2, voffA);
            PG8_BAR; PG8_WAIT_L(0); PG8_MMA(1, 0, At, B0); PG8_BAR; PG8_SCHED;
            PG8_STAGE(PG8_SB(0, 1), b2 + hstep, voffB);
            PG8_WAIT_V(6); PG8_BAR; PG8_MMA(1, 1, At, B1); PG8_BAR;
            PG8_LDB(B0, 1, 0); PG8_SCHED; PG8_LDA(At, 1, 0); PG8_STAGE(PG8_SA(0, 1), a2 + hstep, voffA);
            PG8_WAIT_L(8); PG8_BAR; PG8_WAIT_L(0); PG8_MMA(0, 0, At, B0); PG8_BAR; PG8_SCHED;
            PG8_LDB(B1, 1, 1); PG8_STAGE(PG8_SB(1, 0), b3, voffB);
            PG8_BAR; PG8_WAIT_L(0); PG8_MMA(0, 1, At, B1); PG8_BAR;
            PG8_LDA(At, 1, 1); PG8_STAGE(PG8_SA(1, 0), a3, voffA);
            PG8_BAR; PG8_WAIT_L(0); PG8_MMA(1, 0, At, B0); PG8_BAR; PG8_SCHED;
            PG8_STAGE(PG8_SB(1, 1), b3 + hstep, voffB);
            PG8_WAIT_V(6); PG8_BAR; PG8_MMA(1, 1, At, B1); PG8_BAR;
        }
        E(acc, cur, wr, wc, fr, fq, lds, ui & 1, has_next ? nxt.pm : -1, tid);
        if (!has_next) break;
#pragma unroll
        for (int a = 0; a < 2; ++a)
#pragma unroll
            for (int b = 0; b < 2; ++b)
#pragma unroll
                for (int m = 0; m < 4; ++m)
#pragma unroll
                    for (int n = 0; n < 2; ++n) acc[a][b][m][n] = (f32x4){0.f, 0.f, 0.f, 0.f};
        cur = nxt; cA = nA; cB = nB; ++ui;
    }
    PG8_WAIT_V(0);
    if (wr == 0) PG8_BAR;
    PG8_BAR;
#undef PG8_SA
#undef PG8_SB
#undef PG8_STAGE
#undef PG8_LDA
#undef PG8_LDB
#undef PG8_MMA
#undef PG8_WAIT_V
#undef PG8_WAIT_L
#undef PG8_BAR
#undef PG8_SCHED
}

template <int ACT> struct EpiBf16 {
    static constexpr bool PERM = true, PRE = true;
    bf16_t* O; int ldc; const unsigned long long* ssq;
    __device__ __forceinline__ unsigned long long prefetch(int pm, int tid) const { return tid < 256 ? ssq[pm * BM + tid] : 0ull; }
    __device__ __forceinline__ void stash(unsigned long long v, LAS unsigned char* lds, int par, int tid) const { if (tid < 256) *(LAS float*)(lds + 131072 + par * 1024 + tid * 4) = rsqrtf((float)v * (1.f / (1048576.f * DM)) + EPS_); }
    __device__ __forceinline__ void operator()(const f32x4 (&acc)[2][2][4][2], const Unit& u, int wr, int wc, int fr, int fq, LAS unsigned char* lds, int par, int npm, int tid) const {
        const int row0 = u.pm * BM + wr * 64 + fr, col0 = u.pn * BM + wc * 32 + 8 * fq;
        unsigned long long nx = 0ull; if (npm >= 0) nx = prefetch(npm, tid);
#pragma unroll
        for (int ai = 0; ai < 2; ++ai)
#pragma unroll
            for (int m = 0; m < 4; ++m) { const int row = row0 + ai * HALF + m * 16; bf16_t* rowp = O + (size_t)row * ldc + col0;
                const float rstd = *(const LAS float*)(lds + 131072 + par * 1024 + (wr * 64 + fr + ai * HALF + m * 16) * 4);
#pragma unroll
                for (int bj = 0; bj < 2; ++bj) { f32x4 v0 = acc[ai][bj][m][0] * rstd, v1 = acc[ai][bj][m][1] * rstd;
                    if (ACT == 1) {
#pragma unroll
                        for (int j = 0; j < 4; ++j) { const float a = fmaxf(v0[j], 0.f), b = fmaxf(v1[j], 0.f); v0[j] = a * a; v1[j] = b * b; } }
                    u32x4 w; w.x = cvt_pk_bf16(v0[0], v0[1]); w.y = cvt_pk_bf16(v0[2], v0[3]); w.z = cvt_pk_bf16(v1[0], v1[1]); w.w = cvt_pk_bf16(v1[2], v1[3]);
                    *(u32x4*)(rowp + bj * HALF) = w; } }
        if (npm >= 0) stash(nx, lds, par ^ 1, tid);
    }
};
struct EpiResid {
    static constexpr bool PERM = true, PRE = false;
    __device__ __forceinline__ unsigned long long prefetch(int, int) const { return 0ull; }
    __device__ __forceinline__ void stash(unsigned long long, LAS unsigned char*, int, int) const {}
    bf16_t* Hb; unsigned long long* ssq; int ldc;
    __device__ __forceinline__ void operator()(const f32x4 (&acc)[2][2][4][2], const Unit& u, int wr, int wc, int fr, int fq, LAS unsigned char* lds, int par, int npm, int tid) const {
        const int row0 = u.pm * BM + wr * 64 + fr, col0 = u.pn * BM + wc * 32 + 8 * fq;
#pragma unroll
        for (int ai = 0; ai < 2; ++ai)
#pragma unroll
            for (int m = 0; m < 4; ++m) { const int row = row0 + ai * HALF + m * 16; bf16_t* hp = Hb + (size_t)row * ldc + col0;
                float part = 0.f;
#pragma unroll
                for (int bj = 0; bj < 2; ++bj) { u32x4* p = (u32x4*)(hp + bj * HALF); float o[8]; unpack8(*p, o);
                    const f32x4 a0 = acc[ai][bj][m][0], a1 = acc[ai][bj][m][1];
                    float v[8] = {o[0] + a0[0], o[1] + a0[1], o[2] + a0[2], o[3] + a0[3], o[4] + a1[0], o[5] + a1[1], o[6] + a1[2], o[7] + a1[3]};
#pragma unroll
                    for (int k = 0; k < 8; ++k) part += v[k] * v[k];
                    *p = pack8(v); }
                part += __shfl_xor(part, 16); part += __shfl_xor(part, 32);
                if (fq == 0) atomicAdd(ssq + row, (unsigned long long)(part * 1048576.f)); }
    }
};
struct EpiQup {
    static constexpr bool PERM = true, PRE = false;
    __device__ __forceinline__ unsigned long long prefetch(int, int) const { return 0ull; }
    __device__ __forceinline__ void stash(unsigned long long, LAS unsigned char*, int, int) const {}
    bf16_t* Q; const float* rc; const float* rs;
    __device__ __forceinline__ void operator()(const f32x4 (&acc)[2][2][4][2], const Unit& u, int wr, int wc, int fr, int fq, LAS unsigned char* lds, int par, int npm, int tid) const {
        const int row0 = u.pm * BM + wr * 64 + fr;
        if (u.pn < 4) {
            bf16_t* d0 = Q + ((size_t)(u.pn * 2) * S_ + row0) * 192 + wc * 32 + 8 * fq;
#pragma unroll
            for (int ai = 0; ai < 2; ++ai)
#pragma unroll
                for (int m = 0; m < 4; ++m) {
#pragma unroll
                    for (int bj = 0; bj < 2; ++bj) { const f32x4 v0 = acc[ai][bj][m][0], v1 = acc[ai][bj][m][1];
                        u32x4 w; w.x = cvt_pk_bf16(v0[0], v0[1]); w.y = cvt_pk_bf16(v0[2], v0[3]); w.z = cvt_pk_bf16(v1[0], v1[1]); w.w = cvt_pk_bf16(v1[2], v1[3]);
                        *(u32x4*)(d0 + (size_t)(ai * HALF + m * 16) * 192 + (size_t)bj * S_ * 192) = w; }
                    asm volatile("" ::: "memory"); }
        } else {
            const int jj0 = (wc & 1) * 32 + 8 * fq, j0 = jj0 >> 1;
            bf16_t* d0 = Q + ((size_t)((u.pn - 4) * 4 + (wc >> 1)) * S_ + row0) * 192 + 128 + jj0;
            const float* c0 = rc + (size_t)row0 * 32 + j0; const float* s0 = rs + (size_t)row0 * 32 + j0;
#pragma unroll
            for (int ai = 0; ai < 2; ++ai)
#pragma unroll
                for (int m = 0; m < 4; ++m) { const int ro = ai * HALF + m * 16;
                    const f32x4 c = *(const f32x4*)(c0 + ro * 32), s = *(const f32x4*)(s0 + ro * 32);
#pragma unroll
                    for (int bj = 0; bj < 2; ++bj) { const f32x4 v0 = acc[ai][bj][m][0], v1 = acc[ai][bj][m][1];
                        u32x4 w;
                        w.x = cvt_pk_bf16(v0[0] * c[0] - v0[1] * s[0], v0[1] * c[0] + v0[0] * s[0]);
                        w.y = cvt_pk_bf16(v0[2] * c[1] - v0[3] * s[1], v0[3] * c[1] + v0[2] * s[1]);
                        w.z = cvt_pk_bf16(v1[0] * c[2] - v1[1] * s[2], v1[1] * c[2] + v1[0] * s[2]);
                        w.w = cvt_pk_bf16(v1[2] * c[3] - v1[3] * s[3], v1[3] * c[3] + v1[2] * s[3]);
                        *(u32x4*)(d0 + (size_t)ro * 192 + (size_t)bj * 2 * S_ * 192) = w; }
                    asm volatile("" ::: "memory"); }
        }
    }
};
struct EpiKVup {
    static constexpr bool PERM = true, PRE = false;
    __device__ __forceinline__ unsigned long long prefetch(int, int) const { return 0ull; }
    __device__ __forceinline__ void stash(unsigned long long, LAS unsigned char*, int, int) const {}
    bf16_t* Kb; bf16_t* Vb;
    template <int LD> __device__ __forceinline__ void put(const f32x4 (&acc)[2][2][4][2], bf16_t* d0) const {
#pragma unroll
        for (int ai = 0; ai < 2; ++ai)
#pragma unroll
            for (int m = 0; m < 4; ++m)
#pragma unroll
                for (int bj = 0; bj < 2; ++bj) { const f32x4 v0 = acc[ai][bj][m][0], v1 = acc[ai][bj][m][1];
                    u32x4 w; w.x = cvt_pk_bf16(v0[0], v0[1]); w.y = cvt_pk_bf16(v0[2], v0[3]); w.z = cvt_pk_bf16(v1[0], v1[1]); w.w = cvt_pk_bf16(v1[2], v1[3]);
                    *(u32x4*)(d0 + (size_t)(ai * HALF + m * 16) * LD + (size_t)bj * S_ * LD) = w; }
    }
    __device__ __forceinline__ void operator()(const f32x4 (&acc)[2][2][4][2], const Unit& u, int wr, int wc, int fr, int fq, LAS unsigned char* lds, int par, int npm, int tid) const {
        const int row0 = u.pm * BM + wr * 64 + fr;
        if (u.pn < 4) put<192>(acc, Kb + ((size_t)(u.pn * 2) * S_ + row0) * 192 + wc * 32 + 8 * fq);
        else put<128>(acc, Vb + ((size_t)((u.pn - 4) * 2) * S_ + row0) * 128 + wc * 32 + 8 * fq);
    }
};
}

namespace att {
constexpr int DQ = 192, DV = 128, NW = 8, QBLK = 32, KVBLK = 64;
constexpr float SCALE = 0.07216878364870322f;
constexpr float THR = 8.f;
#ifndef ATT_SDEPTH
#define ATT_SDEPTH 1
#endif
constexpr int SDEPTH = ATT_SDEPTH;
#ifndef ATT_NQREG
#define ATT_NQREG 12
#endif
constexpr int NQREG = ATT_NQREG;
constexpr int LDQ = 192, LDKK = 192, LDVV = 128, LDO = 2048;
constexpr int SHM_V = KVBLK * DV * 2, SHM_K = KVBLK * 400, SHM_QR = 2 * SHM_V + 2 * SHM_K + NW * 64 * 4, SHM_ATTN = SHM_QR + NW * (12 - NQREG) * 64 * 16;
#define KSWZ(row, colB) ((row) * 400 + (colB))
#define SBAR() __builtin_amdgcn_sched_barrier(0)
__device__ __forceinline__ int crow(int r, int hi) { return (r & 3) + 8 * (r >> 2) + 4 * hi; }
__device__ __forceinline__ void partialSM(f32x16& p0, f32x16& p1, float& m_reg, float& mn, float& alpha) {
  constexpr float C = SCALE * 1.4426950408889634f;
  float pmax = p0[0]; for (int r = 1; r < 16; ++r) pmax = fmaxf(pmax, p0[r]); for (int r = 0; r < 16; ++r) pmax = fmaxf(pmax, p1[r]);
  { auto rr = __builtin_amdgcn_permlane32_swap(__float_as_uint(pmax), __float_as_uint(pmax), false, false);
    pmax = fmaxf(__uint_as_float(rr[0]), __uint_as_float(rr[1])); }
  if (__builtin_expect(__all(pmax - m_reg <= THR / SCALE), 1)) { mn = m_reg; alpha = 1.f; }
  else { mn = fmaxf(m_reg, pmax); alpha = __builtin_amdgcn_exp2f((m_reg - mn) * C); m_reg = mn; }
  float mnC = -mn * C;
  for (int r = 0; r < 16; ++r) p0[r] = fmaf(p0[r], C, mnC); for (int r = 0; r < 16; ++r) p1[r] = fmaf(p1[r], C, mnC);
  for (int r = 0; r < 16; ++r) p0[r] = __builtin_amdgcn_exp2f(p0[r]);
}
__device__ __forceinline__ void finishSM(f32x16& p0, f32x16& p1, float alpha, float& l_reg, bf16x8& pa0, bf16x8& pa1, bf16x8& pa2, bf16x8& pa3) {
  for (int r = 0; r < 16; ++r) p1[r] = __builtin_amdgcn_exp2f(p1[r]);
  float ps = 0; for (int r = 0; r < 16; ++r) ps += p0[r]; for (int r = 0; r < 16; ++r) ps += p1[r];
  { auto rr = __builtin_amdgcn_permlane32_swap(__float_as_uint(ps), __float_as_uint(ps), false, false);
    ps = __uint_as_float(rr[0]) + __uint_as_float(rr[1]); }
  l_reg = l_reg * alpha + ps;
#define PK4(P, BASE, OUT) do { unsigned a0 = cvt_pk_bf16(P[BASE + 0], P[BASE + 1]), a1 = cvt_pk_bf16(P[BASE + 2], P[BASE + 3]);   \
    unsigned b0 = cvt_pk_bf16(P[BASE + 4], P[BASE + 5]), b1 = cvt_pk_bf16(P[BASE + 6], P[BASE + 7]);                              \
    auto r0 = __builtin_amdgcn_permlane32_swap(a0, b0, false, false); auto r1 = __builtin_amdgcn_permlane32_swap(a1, b1, false, false); \
    u32x4 w = {r0[0], r1[0], r0[1], r1[1]}; OUT = *reinterpret_cast<bf16x8*>(&w); } while (0)
  PK4(p0, 0, pa0); PK4(p0, 8, pa1); PK4(p1, 0, pa2); PK4(p1, 8, pa3);
#undef PK4
}
__device__ __forceinline__ void qkt(f32x16& p0, f32x16& p1, const bf16_t* Ks, const bf16x8* qr, const bf16x8* qrl, int r32, int hi) {
  p0 = f32x16{}; p1 = f32x16{};
#pragma unroll
  for (int d0 = 0; d0 < 12; ++d0) { int cb = (d0 * 16 + hi * 8) * 2;
    bf16x8 b0 = *reinterpret_cast<const bf16x8*>((const char*)Ks + KSWZ(r32, cb));
    bf16x8 b1 = *reinterpret_cast<const bf16x8*>((const char*)Ks + KSWZ(32 + r32, cb));
    const bf16x8 qv = d0 < NQREG ? qr[d0 < NQREG ? d0 : 0] : qrl[(d0 - NQREG) * 64];
    p0 = __builtin_amdgcn_mfma_f32_32x32x16_bf16(b0, qv, p0, 0, 0, 0);
    p1 = __builtin_amdgcn_mfma_f32_32x32x16_bf16(b1, qv, p1, 0, 0, 0); }
}
__device__ __forceinline__ int v_st(int k, int c) { const int kk = (k & ~0xC) | ((k & 4) << 1) | ((k & 8) >> 1); return ((kk >> 3) * 4 + (c >> 5)) * 512 + ((kk & 7) * 32 + (c & 31)) * 2; }
__device__ __forceinline__ int v_rd_base(int lane) { return ((lane & 3) << 3) | (((lane >> 2) & 3) << 6) | (((lane >> 4) & 1) << 5) | (((lane >> 5) & 1) << 8); }
constexpr int v_rd_off(int d0, int ks, int half) { return d0 * 512 + ks * 4096 + half * 2048; }
template <int OFF> __device__ __forceinline__ s16x4 tr_read(int vb) {
  s16x4 r; asm volatile("ds_read_b64_tr_b16 %0, %1 offset:%2" : "=&v"(r) : "v"(vb), "i"(OFF) : "memory"); return r;
}
template <int D0> __device__ __forceinline__ void pv_one(f32x16& od, int vb, bf16x8 pa0, bf16x8 pa1, bf16x8 pa2, bf16x8 pa3) {
  const s16x4 l0 = tr_read<v_rd_off(D0, 0, 0)>(vb), h0 = tr_read<v_rd_off(D0, 0, 1)>(vb), l1 = tr_read<v_rd_off(D0, 1, 0)>(vb), h1 = tr_read<v_rd_off(D0, 1, 1)>(vb);
  const s16x4 l2 = tr_read<v_rd_off(D0, 2, 0)>(vb), h2 = tr_read<v_rd_off(D0, 2, 1)>(vb), l3 = tr_read<v_rd_off(D0, 3, 0)>(vb), h3 = tr_read<v_rd_off(D0, 3, 1)>(vb);
  asm volatile("s_waitcnt lgkmcnt(0)" ::: "memory"); SBAR();
#define PK(L, H) (bf16x8){L[0], L[1], L[2], L[3], H[0], H[1], H[2], H[3]}
  od = __builtin_amdgcn_mfma_f32_32x32x16_bf16(pa0, PK(l0, h0), od, 0, 0, 0);
  od = __builtin_amdgcn_mfma_f32_32x32x16_bf16(pa1, PK(l1, h1), od, 0, 0, 0);
  od = __builtin_amdgcn_mfma_f32_32x32x16_bf16(pa2, PK(l2, h2), od, 0, 0, 0);
  od = __builtin_amdgcn_mfma_f32_32x32x16_bf16(pa3, PK(l3, h3), od, 0, 0, 0);
#undef PK
}
__device__ __forceinline__ void pv_d0(f32x16* o, int vb, bf16x8 pa0, bf16x8 pa1, bf16x8 pa2, bf16x8 pa3) {
  pv_one<0>(o[0], vb, pa0, pa1, pa2, pa3); pv_one<1>(o[1], vb, pa0, pa1, pa2, pa3); pv_one<2>(o[2], vb, pa0, pa1, pa2, pa3); pv_one<3>(o[3], vb, pa0, pa1, pa2, pa3);
}
__device__ __forceinline__ void attn_body(const bf16_t* __restrict__ Qb, const bf16_t* __restrict__ Kh, const bf16_t* __restrict__ Vh,
                                          bf16_t* __restrict__ Ob, int seq, char* lds) {
  const int tid = ltid(), wid = tid >> 6, lane = tid & 63, r32 = lane & 31, hi = lane >> 5;
  bf16_t* V_lds = (bf16_t*)lds; bf16_t* K_lds = (bf16_t*)(lds + 2 * SHM_V);
  float* ws = (float*)(lds + 2 * SHM_V + 2 * SHM_K) + wid * 64; float* li_l = ws; float* al_l = ws + 32;
  float m_reg = -1e30f, l_reg = 0; f32x16 o[4] = {}; bf16x8 qr[NQREG];
  const bf16_t* Qw = Qb + (long)(wid * QBLK + r32) * LDQ + hi * 8;
  bf16x8* qrl = (bf16x8*)(lds + SHM_QR) + wid * ((12 - NQREG) * 64) + lane;
#pragma unroll
  for (int d0 = 0; d0 < NQREG; ++d0) qr[d0] = *reinterpret_cast<const bf16x8*>(Qw + d0 * 16);
#pragma unroll
  for (int d0 = NQREG; d0 < 12; ++d0) qrl[(d0 - NQREG) * 64] = *reinterpret_cast<const bf16x8*>(Qw + d0 * 16);
  const int sr = tid >> 4, sc = (tid & 15) * 8, vst0 = v_st(sr, sc), vst1 = v_st(32 + sr, sc);
  const int kc0 = tid, kc1 = tid + 512, kc2 = tid + 1024;
  const int kr0 = kc0 / 24, kr1 = kc1 / 24, kr2 = kc2 / 24, ke0 = (kc0 % 24) * 8, ke1 = (kc1 % 24) * 8, ke2 = (kc2 % 24) * 8;
  const int kw0 = KSWZ(kr0, ke0 * 2), kw1 = KSWZ(kr1, ke1 * 2), kw2 = KSWZ(kr2, ke2 * 2);
  const int vb0 = (int)(uintptr_t)V_lds + v_rd_base(lane);
  struct { bf16x8 vs0, vs1, ks0, ks1, ks2; } sr_[SDEPTH];
#define SLOAD(i, k0) do { sr_[i].vs0 = *(const bf16x8*)(&Vh[(long)((k0) + sr) * LDVV + sc]); sr_[i].vs1 = *(const bf16x8*)(&Vh[(long)((k0) + 32 + sr) * LDVV + sc]); \
    { const char* kt_ = (const char*)Kh + (size_t)(k0) * 384; sr_[i].ks0 = *(const bf16x8*)(kt_ + tid * 16); sr_[i].ks1 = *(const bf16x8*)(kt_ + 8192 + tid * 16); \
    sr_[i].ks2 = *(const bf16x8*)(kt_ + 16384 + tid * 16); } } while (0)
#define SWRITE(b, i) do { *(bf16x8*)((char*)V_lds + (b) * SHM_V + vst0) = sr_[i].vs0;          \
    *(bf16x8*)((char*)V_lds + (b) * SHM_V + vst1) = sr_[i].vs1;               \
    *(bf16x8*)((char*)K_lds + (b) * SHM_K + kw0) = sr_[i].ks0;                       \
    *(bf16x8*)((char*)K_lds + (b) * SHM_K + kw1) = sr_[i].ks1;                       \
    *(bf16x8*)((char*)K_lds + (b) * SHM_K + kw2) = sr_[i].ks2; } while (0)
#define SWAIT() do { if constexpr (SDEPTH == 2) asm volatile("s_waitcnt vmcnt(5)" ::: "memory"); else asm volatile("s_waitcnt vmcnt(0)" ::: "memory"); } while (0)
#define RESC(a) do { if (__any((a) < 1.f)) { if (hi == 0) al_l[r32] = (a); asm volatile("s_waitcnt lgkmcnt(0)" ::: "memory"); \
    for (int d = 0; d < 4; ++d) for (int r = 0; r < 16; ++r) o[d][r] *= al_l[crow(r, hi)]; } } while (0)
  f32x16 pA0, pA1, pB0, pB1; float mnA, mnB, alA, alB; bf16x8 pa0, pa1, pa2, pa3; const int NT = seq / KVBLK;
  constexpr int SE = 0, SO = SDEPTH - 1;
  SLOAD(SE, 0); asm volatile("s_waitcnt vmcnt(0)" ::: "memory"); SWRITE(0, SE); __syncthreads();
  qkt(pA0, pA1, K_lds, qr, qrl, r32, hi); partialSM(pA0, pA1, m_reg, mnA, alA);
  SLOAD(SO, KVBLK); if constexpr (SDEPTH == 2) { if (2 < NT) SLOAD(SE, 2 * KVBLK); }
  SWAIT(); SWRITE(1, SO); __syncthreads();
  for (int j = 1; j + 1 < NT; j += 2) {
    SBAR(); qkt(pB0, pB1, (bf16_t*)((char*)K_lds + SHM_K), qr, qrl, r32, hi);
    finishSM(pA0, pA1, alA, l_reg, pa0, pa1, pa2, pa3); SBAR();
    SLOAD(SO, (j + SDEPTH) * KVBLK); SBAR();
    pv_d0(o, vb0, pa0, pa1, pa2, pa3); partialSM(pB0, pB1, m_reg, mnB, alB);
    __syncthreads(); SWAIT(); SWRITE(0, SE);
    RESC(alB); __syncthreads();
    SBAR(); qkt(pA0, pA1, K_lds, qr, qrl, r32, hi);
    finishSM(pB0, pB1, alB, l_reg, pa0, pa1, pa2, pa3); SBAR();
    if (SDEPTH == 1 || j + 3 < NT) SLOAD(SE, (j + 1 + SDEPTH) * KVBLK); SBAR();
    pv_d0(o, vb0 + (int)SHM_V, pa0, pa1, pa2, pa3); partialSM(pA0, pA1, m_reg, mnA, alA);
    __syncthreads(); SWAIT(); SWRITE(1, SO);
    RESC(alA); __syncthreads();
  }
  SBAR(); qkt(pB0, pB1, (bf16_t*)((char*)K_lds + SHM_K), qr, qrl, r32, hi);
  finishSM(pA0, pA1, alA, l_reg, pa0, pa1, pa2, pa3); SBAR();
  pv_d0(o, vb0, pa0, pa1, pa2, pa3); partialSM(pB0, pB1, m_reg, mnB, alB);
  __syncthreads(); RESC(alB);
  finishSM(pB0, pB1, alB, l_reg, pa0, pa1, pa2, pa3); SBAR();
  pv_d0(o, vb0 + (int)SHM_V, pa0, pa1, pa2, pa3);
  if (hi == 0) li_l[r32] = l_reg; asm volatile("s_waitcnt lgkmcnt(0)" ::: "memory");
  float rli[16];
#pragma unroll
  for (int r = 0; r < 16; ++r) rli[r] = __builtin_amdgcn_rcpf(li_l[crow(r, hi)]);
  bf16_t* Ow = Ob + (long)(wid * QBLK) * LDO;
#pragma unroll
  for (int r = 0; r < 16; ++r) { int orow = crow(r, hi);
    for (int d0 = 0; d0 < 4; ++d0) Ow[(long)orow * LDO + d0 * 32 + r32] = f2bf(o[d0][r] * rli[r]); }
  asm volatile("s_waitcnt vmcnt(0)" ::: "memory");
  __syncthreads();
#undef SLOAD
#undef SWRITE
#undef SWAIT
#undef RESC
}
}

template <int K, int NT>
__device__ __forceinline__ void mma_tile(f32x4 (&acc)[4][NT], const LAS bf16_t* A, int lda, const LAS bf16_t* Bt, int ldb, int wr, int wc, int fr, int fq) {
#pragma unroll 1
    for (int k0 = 0; k0 < K; k0 += 32) {
        bf16x8 a[4], b[NT];
#pragma unroll
        for (int m = 0; m < 4; ++m) a[m] = *(const LAS bf16x8*)(A + (64 * wr + 16 * m + fr) * lda + k0 + fq * 8);
#pragma unroll
        for (int n = 0; n < NT; ++n) b[n] = *(const LAS bf16x8*)(Bt + (16 * NT * wc + 16 * n + fr) * ldb + k0 + fq * 8);
#pragma unroll
        for (int m = 0; m < 4; ++m)
#pragma unroll
            for (int n = 0; n < NT; ++n) acc[m][n] = __builtin_amdgcn_mfma_f32_16x16x32_bf16(a[m], b[n], acc[m][n], 0, 0, 0);
    }
}
template <int NT> __device__ __forceinline__ void zero_acc(f32x4 (&acc)[4][NT]) {
#pragma unroll
    for (int m = 0; m < 4; ++m)
#pragma unroll
        for (int n = 0; n < NT; ++n) acc[m][n] = (f32x4){0.f, 0.f, 0.f, 0.f};
}
template <int R, int C> __device__ __forceinline__ void stage_N(LAS bf16_t* dst, int ld, const bf16_t* __restrict__ src, size_t ldg) {
    constexpr int CH = C / 8;
    for (int idx = ltid(); idx < R * CH; idx += 512) { const int r = idx / CH, c = (idx % CH) * 8;
        *(LAS u32x4*)(dst + r * ld + c) = *(const u32x4*)(src + (size_t)r * ldg + c); }
}
template <int C, bool SCL> __device__ __forceinline__ void stage_T(LAS bf16_t* dst, int ld, const bf16_t* __restrict__ src, size_t ldg, const LAS float* sc) {
    for (int idx = ltid(); idx < 128 * (C / 8); idx += 512) { const int r = idx & 127, c0 = (idx >> 7) * 8;
        const u32x4 w = *(const u32x4*)(src + (size_t)r * ldg + c0); float f[8]; unpack8(w, f);
        float s = 1.f; if (SCL) s = sc[r];
#pragma unroll
        for (int i = 0; i < 8; ++i) dst[(c0 + i) * ld + r] = f2bf(f[i] * s); }
}
template <int R, int C> __device__ __forceinline__ void ld_N(u32x4 (&r)[R * C / 8 / 512], const bf16_t* __restrict__ src, size_t ldg, int tid) {
    constexpr int CH = C / 8;
#pragma unroll
    for (int i = 0; i < R * CH / 512; ++i) { const int idx = tid + 512 * i, rr = idx / CH, c = (idx % CH) * 8; r[i] = *(const u32x4*)(src + (size_t)rr * ldg + c); }
}
template <int R, int C> __device__ __forceinline__ void st_N(LAS bf16_t* dst, int ld, const u32x4 (&r)[R * C / 8 / 512], int tid) {
    constexpr int CH = C / 8;
#pragma unroll
    for (int i = 0; i < R * CH / 512; ++i) { const int idx = tid + 512 * i, rr = idx / CH, c = (idx % CH) * 8; *(LAS u32x4*)(dst + rr * ld + c) = r[i]; }
}
template <int C> __device__ __forceinline__ void ld_T(u32x4 (&r)[128 * C / 8 / 512], const bf16_t* __restrict__ src, size_t ldg, int tid) {
#pragma unroll
    for (int i = 0; i < 128 * C / 8 / 512; ++i) { const int idx = tid + 512 * i, rr = idx & 127, c0 = (idx >> 7) * 8; r[i] = *(const u32x4*)(src + (size_t)rr * ldg + c0); }
}
template <int C, bool SCL> __device__ __forceinline__ void st_T(LAS bf16_t* dst, int ld, const u32x4 (&r)[128 * C / 8 / 512], const LAS float* sc, int tid) {
#pragma unroll
    for (int i = 0; i < 128 * C / 8 / 512; ++i) { const int idx = tid + 512 * i, rr = idx & 127, c0 = (idx >> 7) * 8;
        if (SCL) { float f[8]; unpack8(r[i], f); const float sv = sc[rr];
#pragma unroll
            for (int k = 0; k < 8; ++k) dst[(c0 + k) * ld + rr] = f2bf(f[k] * sv); }
        else { const unsigned w[4] = {r[i].x, r[i].y, r[i].z, r[i].w};
#pragma unroll
            for (int k = 0; k < 4; ++k) { dst[(c0 + 2 * k) * ld + rr] = (bf16_t)(w[k] & 0xffffu); dst[(c0 + 2 * k + 1) * ld + rr] = (bf16_t)(w[k] >> 16); } } }
}
__device__ __forceinline__ float scan_add64(float v, int lane) {
#pragma unroll
    for (int o = 1; o < 64; o <<= 1) { const float t = __shfl_up(v, o); if (lane >= o) v += t; } return v; }
__device__ __forceinline__ float scan_max64(float v, int lane) {
#pragma unroll
    for (int o = 1; o < 64; o <<= 1) { const float t = __shfl_up(v, o); if (lane >= o) v = fmaxf(v, t); } return v; }

constexpr int CB0 = 0, CB1 = 34816, CB2 = 69632, CB3 = 104448, CVEC = 139264;
constexpr int RQB = 0, RKB = 18432, RST_ = 36864, RVT = 71680, RRT = 106496;

struct Bufs {
    bf16_t *Wl, *H, *Y, *QKML, *RQK, *CQN, *CKVN, *CST, *RST, *PROJ, *Q, *K, *V, *ACT;
    float *X, *RC, *RS, *G, *CLOC, *NLOC, *NST, *MLOC, *BLAST, *MST, *RLOC;
};

__device__ __forceinline__ void mlstm_local(const Bufs& B, int item, LAS unsigned char* lds) {
    const int tid = ltid(), wid = tid >> 6, lane = tid & 63, wr = wid >> 2, wc = wid & 3, fr = lane & 15, fq = lane >> 4;
    const int c = item & 63, h = (item >> 6) & 3, dir = item >> 8, s0 = c * 128;
    LAS bf16_t* T0 = (LAS bf16_t*)(lds + CB0); LAS bf16_t* T1 = (LAS bf16_t*)(lds + CB1); LAS float* ve = (LAS float*)(lds + CVEC);
    u32x4 rk[4], rv[4];
    ld_T<128>(rk, B.QKML + (size_t)s0 * 1024 + 512 + h * 128, 1024, tid);
    ld_T<128>(rv, B.PROJ + (size_t)s0 * NPROJP + PC_MLV + h * 128, NPROJP, tid);
    if (wid == 0) {
        const int l0 = 2 * lane, l1 = l0 + 1, p0 = dir ? 127 - l0 : l0, p1 = dir ? 127 - l1 : l1, gi = 8 * dir + h, gf = gi + 4;
        const float li0 = B.G[(size_t)(s0 + p0) * 16 + gi], lf0 = B.G[(size_t)(s0 + p0) * 16 + gf], li1 = B.G[(size_t)(s0 + p1) * 16 + gi], lf1 = B.G[(size_t)(s0 + p1) * 16 + gf];
        const float t = lf0 + lf1, incl = scan_add64(t, lane), b0 = incl - t + lf0, b1 = incl, btot = __shfl(incl, 63);
        const float w0 = btot - b0 + li0, w1 = btot - b1 + li1, mloc = wave_max(fmaxf(w0, w1));
        ve[p0] = __expf(w0 - mloc); ve[p1] = __expf(w1 - mloc);
        if (lane == 0) { B.MLOC[item] = mloc; B.BLAST[item] = btot; }
    }
    st_T<128, false>(T0, 136, rk, ve, tid);
    __syncthreads();
    st_T<128, true>(T1, 136, rv, ve, tid);
    __syncthreads();
    f32x4 acc[4][2]; zero_acc<2>(acc);
    mma_tile<128, 2>(acc, T1, 136, T0, 136, wr, wc, fr, fq);
    float* dst = B.CLOC + (size_t)item * 16384;
#pragma unroll
    for (int m = 0; m < 4; ++m)
#pragma unroll
        for (int n = 0; n < 2; ++n)
#pragma unroll
            for (int j = 0; j < 4; ++j) dst[(64 * wr + 16 * m + 4 * fq + j) * 128 + 32 * wc + 16 * n + fr] = acc[m][n][j];
    { const int dk = tid >> 2, qd = tid & 3; float s = 0.f;
#pragma unroll
        for (int i = 0; i < 4; ++i) { float kv[8]; unpack8(*(const LAS u32x4*)(T0 + dk * 136 + qd * 32 + i * 8), kv);
#pragma unroll
            for (int k = 0; k < 8; ++k) s += kv[k] * ve[qd * 32 + i * 8 + k]; }
        s += __shfl_xor(s, 1); s += __shfl_xor(s, 2);
        if (qd == 0) B.NLOC[(size_t)item * 128 + dk] = s; }
    __syncthreads();
}

__device__ __forceinline__ void ret_local(const Bufs& B, int item, LAS unsigned char* lds) {
    const int tid = ltid(), wid = tid >> 6, lane = tid & 63, wr = wid >> 2, wc = wid & 3, fr = lane & 15, fq = lane >> 4;
    const int c = item & 63, h = (item >> 6) & 3, dir = item >> 8, s0 = c * 128, hd = dir ? 3 - h : h;
    const float lg = log1pf(-exp2f(-5.f - (float)hd));
    LAS bf16_t* T0 = (LAS bf16_t*)(lds + CB0); LAS bf16_t* T1 = (LAS bf16_t*)(lds + CB1); LAS float* vz = (LAS float*)(lds + CVEC);
    u32x4 rk[2], rv[4];
    ld_T<64>(rk, B.RQK + (size_t)s0 * 512 + 256 + h * 64, 512, tid);
    ld_T<128>(rv, B.PROJ + (size_t)s0 * NPROJP + PC_RV + h * 128, NPROJP, tid);
    if (tid < 128) { const int lp = dir ? 127 - tid : tid; vz[tid] = __expf((float)(127 - lp) * lg); }
    st_T<64, false>(T0, 136, rk, vz, tid);
    __syncthreads();
    st_T<128, true>(T1, 136, rv, vz, tid);
    __syncthreads();
    f32x4 acc[4][1]; zero_acc<1>(acc);
    mma_tile<128, 1>(acc, T1, 136, T0, 136, wr, wc, fr, fq);
    float* dst = B.RLOC + (size_t)item * 8192;
#pragma unroll
    for (int m = 0; m < 4; ++m)
#pragma unroll
        for (int j = 0; j < 4; ++j) dst[(64 * wr + 16 * m + 4 * fq + j) * 64 + 16 * wc + fr] = acc[m][0][j];
    __syncthreads();
}

__device__ __forceinline__ void scan_phase(const Bufs& B) {
    const int gt = lbid() * 512 + ltid();
    if (gt < 131072) {
        const int dh = gt >> 14, idx = gt & 16383, dir = dh >> 2;
        float cst = 0.f, nst = 0.f, m = -1e30f;
#pragma unroll 1
        for (int s0 = 0; s0 < 64; s0 += 16) {
            float cl[16], ml[16], bl[16], nl[16];
#pragma unroll
            for (int u = 0; u < 16; ++u) { const int ch = dir ? 63 - (s0 + u) : s0 + u, it = dh * 64 + ch;
                cl[u] = B.CLOC[(size_t)it * 16384 + idx]; ml[u] = B.MLOC[it]; bl[u] = B.BLAST[it]; nl[u] = idx < 128 ? B.NLOC[(size_t)it * 128 + idx] : 0.f; }
#pragma unroll
            for (int u = 0; u < 16; ++u) { const int ch = dir ? 63 - (s0 + u) : s0 + u, it = dh * 64 + ch;
                B.CST[(size_t)it * 16384 + idx] = f2bf(cst);
                if (idx < 128) { B.NST[(size_t)it * 128 + idx] = nst; if (idx == 0) B.MST[it] = m; }
                const float mnew = fmaxf(bl[u] + m, ml[u]), a = __expf(bl[u] + m - mnew), g = __expf(ml[u] - mnew);
                cst = a * cst + g * cl[u]; nst = a * nst + g * nl[u]; m = mnew; }
        }
    }
    if (gt < 65536) {
        const int dh = gt >> 13, idx = gt & 8191, dir = dh >> 2, h = dh & 3, hd = dir ? 3 - h : h;
        const float cd = __expf(128.f * log1pf(-exp2f(-5.f - (float)hd)));
        float r = 0.f;
#pragma unroll 1
        for (int s0 = 0; s0 < 64; s0 += 16) {
            float rl[16];
#pragma unroll
            for (int u = 0; u < 16; ++u) { const int ch = dir ? 63 - (s0 + u) : s0 + u; rl[u] = B.RLOC[(size_t)(dh * 64 + ch) * 8192 + idx]; }
#pragma unroll
            for (int u = 0; u < 16; ++u) { const int ch = dir ? 63 - (s0 + u) : s0 + u; B.RST[(size_t)(dh * 64 + ch) * 8192 + idx] = f2bf(r); r = cd * r + rl[u]; }
        }
    }
}

__device__ __forceinline__ void mlstm_out(const Bufs& B, const float* __restrict__ g_out, int item, LAS unsigned char* lds) {
    const int tid = ltid(), wid = tid >> 6, lane = tid & 63, wr = wid >> 2, wc = wid & 3, fr = lane & 15, fq = lane >> 4;
    const int c = item >> 2, h = item & 3, s0 = c * 128;
    constexpr float SC = 0.08838834764831845f;
    LAS bf16_t* T0 = (LAS bf16_t*)(lds + CB0); LAS bf16_t* T1 = (LAS bf16_t*)(lds + CB1); LAS bf16_t* T2 = (LAS bf16_t*)(lds + CB2); LAS bf16_t* T3 = (LAS bf16_t*)(lds + CB3);
    LAS float* vea = (LAS float*)(lds + CVEC); LAS float* veM = vea + 256; LAS float* vedn = vea + 512; LAS float* vn = vea + 768; LAS float* vqn = vea + 1024;
    LAS float* vrs = vea + 1280; LAS float* vf = vea + 1408; LAS float* vsc = vea + 1536;
    LAS float* HT = (LAS float*)(lds + CB1);
    const float mst0 = B.MST[(0 * 4 + h) * 64 + c], mst1 = B.MST[(1 * 4 + h) * 64 + c];
    { u32x4 rq[4], rk[4], rv[4], rc[4];
        ld_N<128, 128>(rq, B.QKML + (size_t)s0 * 1024 + h * 128, 1024, tid);
        ld_N<128, 128>(rk, B.QKML + (size_t)s0 * 1024 + 512 + h * 128, 1024, tid);
        ld_T<128>(rv, B.PROJ + (size_t)s0 * NPROJP + PC_MLV + h * 128, NPROJP, tid);
        ld_N<128, 128>(rc, B.CST + (size_t)((0 * 4 + h) * 64 + c) * 16384, 128, tid);
        st_N<128, 128>(T0, 136, rq, tid); st_N<128, 128>(T1, 136, rk, tid); st_T<128, false>(T2, 136, rv, vea, tid); st_N<128, 128>(T3, 136, rc, tid); }
    if (wid < 2) {
        const int dir = wid; const float mst = dir ? mst1 : mst0;
        const int l0 = 2 * lane, l1 = l0 + 1, p0 = dir ? 127 - l0 : l0, p1 = dir ? 127 - l1 : l1, gi = 8 * dir + h, gf = gi + 4;
        const float li0 = B.G[(size_t)(s0 + p0) * 16 + gi], lf0 = B.G[(size_t)(s0 + p0) * 16 + gf], li1 = B.G[(size_t)(s0 + p1) * 16 + gi], lf1 = B.G[(size_t)(s0 + p1) * 16 + gf];
        const float t = lf0 + lf1, incl = scan_add64(t, lane), b0 = incl - t + lf0, b1 = incl;
        const float a0 = li0 - b0, a1 = li1 - b1, inm = scan_max64(fmaxf(a0, a1), lane);
        float exm = __shfl_up(inm, 1); if (lane == 0) exm = -3.0e38f;
        const float A0 = fmaxf(exm, a0), A1 = inm, amax = __shfl(inm, 63), cc = fmaxf(amax, mst);
        const float M0 = fmaxf(A0, mst), M1 = fmaxf(A1, mst);
        vea[dir * 128 + p0] = __expf(a0 - cc); vea[dir * 128 + p1] = __expf(a1 - cc);
        veM[dir * 128 + p0] = __expf(cc - M0) * SC; veM[dir * 128 + p1] = __expf(cc - M1) * SC;
        vedn[dir * 128 + p0] = __expf(-(b0 + M0)); vedn[dir * 128 + p1] = __expf(-(b1 + M1));
        if (lane == 0) vsc[dir] = __expf(mst - cc);
    }
    if (tid < 256) { const int dir = tid >> 7, d = tid & 127; vn[tid] = B.NST[(size_t)((dir * 4 + h) * 64 + c) * 128 + d]; }
    __syncthreads();
    f32x4 accS[4][2]; zero_acc<2>(accS);
    mma_tile<128, 2>(accS, T1, 136, T0, 136, wr, wc, fr, fq);
    { const int row = tid >> 2, qd = tid & 3; float q0 = 0.f, q1 = 0.f;
#pragma unroll
        for (int i = 0; i < 4; ++i) { float qv[8]; unpack8(*(const LAS u32x4*)(T0 + row * 136 + qd * 32 + i * 8), qv);
            const f32x4 n0a = *(const LAS f32x4*)(vn + qd * 32 + i * 8), n0b = *(const LAS f32x4*)(vn + qd * 32 + i * 8 + 4);
            const f32x4 n1a = *(const LAS f32x4*)(vn + 128 + qd * 32 + i * 8), n1b = *(const LAS f32x4*)(vn + 128 + qd * 32 + i * 8 + 4);
#pragma unroll
            for (int k = 0; k < 4; ++k) { q0 += qv[k] * n0a[k] + qv[4 + k] * n0b[k]; q1 += qv[k] * n1a[k] + qv[4 + k] * n1b[k]; } }
        q0 += __shfl_xor(q0, 1); q0 += __shfl_xor(q0, 2); q1 += __shfl_xor(q1, 1); q1 += __shfl_xor(q1, 2);
        if (qd == 0) { vqn[row] = q0; vqn[128 + row] = q1; } }
    __syncthreads();
    f32x4 hacc[4][2]; zero_acc<2>(hacc);
    u32x4 rc1[4]; ld_N<128, 128>(rc1, B.CST + (size_t)((1 * 4 + h) * 64 + c) * 16384, 128, tid);
#pragma unroll 1
    for (int dir = 0; dir < 2; ++dir) {
        if (dir == 1) st_N<128, 128>(T3, 136, rc1, tid);
        const float r = vsc[dir];
#pragma unroll
        for (int m = 0; m < 4; ++m)
#pragma unroll
            for (int n = 0; n < 2; ++n) { const int l = 32 * wc + 16 * n + fr, sb = 64 * wr + 16 * m + 4 * fq;
                const f32x4 e4 = *(const LAS f32x4*)(vea + dir * 128 + sb); float v[4];
#pragma unroll
                for (int j = 0; j < 4; ++j) { const int s = sb + j; const bool ok = dir ? (s >= l) : (s <= l); v[j] = ok ? accS[m][n][j] * e4[j] : 0.f; }
                u32x2 w; w.x = cvt_pk_bf16(v[0], v[1]); w.y = cvt_pk_bf16(v[2], v[3]);
                *(LAS u32x2*)(T1 + l * 136 + sb) = w; }
        __syncthreads();
        { const int row = tid >> 2, qd = tid & 3; float s = 0.f;
#pragma unroll
            for (int i = 0; i < 4; ++i) { float sv[8]; unpack8(*(const LAS u32x4*)(T1 + row * 136 + qd * 32 + i * 8), sv);
#pragma unroll
                for (int k = 0; k < 8; ++k) s += sv[k]; }
            s += __shfl_xor(s, 1); s += __shfl_xor(s, 2);
            if (qd == 0) { const float eM = veM[dir * 128 + row], den = eM * (s + r * vqn[dir * 128 + row]);
                vf[row] = eM / fmaxf(fabsf(den), vedn[dir * 128 + row]); } }
        f32x4 accN[4][2]; zero_acc<2>(accN);
        mma_tile<128, 2>(accN, T0, 136, T3, 136, wr, wc, fr, fq);
#pragma unroll
        for (int m = 0; m < 4; ++m)
#pragma unroll
            for (int n = 0; n < 2; ++n) accN[m][n] *= r;
        mma_tile<128, 2>(accN, T1, 136, T2, 136, wr, wc, fr, fq);
        __syncthreads();
#pragma unroll
        for (int m = 0; m < 4; ++m) { const f32x4 f4 = *(const LAS f32x4*)(vf + 64 * wr + 16 * m + 4 * fq);
#pragma unroll
            for (int n = 0; n < 2; ++n) hacc[m][n] += accN[m][n] * f4; }
        __syncthreads();
    }
    const int erow = tid >> 2, eqd = tid & 3, es = s0 + erow;
    u32x4 og4[4]; f32x4 gp4[8];
    { const bf16_t* og = B.PROJ + (size_t)es * NPROJP + PC_MLO + h * 128 + eqd * 32; const float* gp = g_out + h * 128 + eqd * 32;
#pragma unroll
        for (int i = 0; i < 4; ++i) og4[i] = *(const u32x4*)(og + i * 8);
#pragma unroll
        for (int i = 0; i < 8; ++i) gp4[i] = *(const f32x4*)(gp + i * 4); }
#pragma unroll
    for (int m = 0; m < 4; ++m)
#pragma unroll
        for (int n = 0; n < 2; ++n)
#pragma unroll
            for (int j = 0; j < 4; ++j) HT[(64 * wr + 16 * m + 4 * fq + j) * 132 + 32 * wc + 16 * n + fr] = hacc[m][n][j];
    __syncthreads();
    { float ssq = 0.f; f32x4 x4[8];
#pragma unroll
        for (int i = 0; i < 8; ++i) { x4[i] = *(const LAS f32x4*)(HT + erow * 132 + eqd * 32 + i * 4);
            ssq += x4[i][0] * x4[i][0] + x4[i][1] * x4[i][1] + x4[i][2] * x4[i][2] + x4[i][3] * x4[i][3]; }
        ssq += __shfl_xor(ssq, 1); ssq += __shfl_xor(ssq, 2);
        const float rstd = rsqrtf(ssq * (1.f / 128.f) + EPS_);
        bf16_t* yo = B.Y + (size_t)es * DM + h * 128 + eqd * 32;
#pragma unroll
        for (int i = 0; i < 4; ++i) { float o8[8]; unpack8(og4[i], o8); float r8[8];
#pragma unroll
            for (int k = 0; k < 8; ++k) { const float sg = __builtin_amdgcn_rcpf(1.f + __expf(-o8[k])); r8[k] = sg * x4[2 * i + (k >> 2)][k & 3] * rstd * gp4[2 * i + (k >> 2)][k & 3]; }
            *(u32x4*)(yo + i * 8) = pack8(r8); } }
    __syncthreads();
}

__device__ __forceinline__ void ret_out(const Bufs& B, const float* __restrict__ g_out, int item, LAS unsigned char* lds) {
    const int tid = ltid(), wid = tid >> 6, lane = tid & 63, wr = wid >> 2, wc = wid & 3, fr = lane & 15, fq = lane >> 4;
    const int c = item >> 2, h = item & 3, s0 = c * 128;
    LAS bf16_t* QB = (LAS bf16_t*)(lds + RQB); LAS bf16_t* KB = (LAS bf16_t*)(lds + RKB); LAS bf16_t* ST = (LAS bf16_t*)(lds + RST_); LAS bf16_t* VT = (LAS bf16_t*)(lds + RVT); LAS bf16_t* RT = (LAS bf16_t*)(lds + RRT);
    LAS float* HT = (LAS float*)(lds + RST_); LAS float* vcs = (LAS float*)(lds + CVEC); LAS float* vrw = vcs + 256;
    u32x4 rr1[2];
    { u32x4 rq[2], rk[2], rv[4], rr0[2];
        ld_N<128, 64>(rq, B.RQK + (size_t)s0 * 512 + h * 64, 512, tid);
        ld_N<128, 64>(rk, B.RQK + (size_t)s0 * 512 + 256 + h * 64, 512, tid);
        ld_T<128>(rv, B.PROJ + (size_t)s0 * NPROJP + PC_RV + h * 128, NPROJP, tid);
        ld_N<128, 64>(rr0, B.RST + (size_t)((0 * 4 + h) * 64 + c) * 8192, 64, tid);
        ld_N<128, 64>(rr1, B.RST + (size_t)((1 * 4 + h) * 64 + c) * 8192, 64, tid);
        st_N<128, 64>(QB, 72, rq, tid); st_N<128, 64>(KB, 72, rk, tid); st_T<128, false>(VT, 136, rv, HT, tid); st_N<128, 64>(RT, 72, rr0, tid); }
    if (tid < 256) { const int dir = tid >> 7, p = tid & 127, lp = dir ? 127 - p : p, hd = dir ? 3 - h : h; const float lg = log1pf(-exp2f(-5.f - (float)hd));
        vcs[tid] = __expf(-(float)lp * lg); vrw[tid] = __expf((float)lp * lg); }
    __syncthreads();
    f32x4 accS[4][2]; zero_acc<2>(accS);
    mma_tile<64, 2>(accS, KB, 72, QB, 72, wr, wc, fr, fq);
    f32x4 yacc[4][2]; zero_acc<2>(yacc);
#pragma unroll 1
    for (int dir = 0; dir < 2; ++dir) {
        const int hd = dir ? 3 - h : h; const float gam = 1.f - exp2f(-5.f - (float)hd);
        if (dir == 1) st_N<128, 64>(RT, 72, rr1, tid);
#pragma unroll
        for (int m = 0; m < 4; ++m)
#pragma unroll
            for (int n = 0; n < 2; ++n) { const int l = 32 * wc + 16 * n + fr, sb = 64 * wr + 16 * m + 4 * fq;
                const f32x4 c4 = *(const LAS f32x4*)(vcs + dir * 128 + sb); float v[4];
#pragma unroll
                for (int j = 0; j < 4; ++j) { const int s = sb + j; const bool ok = dir ? (s >= l) : (s <= l); v[j] = ok ? accS[m][n][j] * c4[j] : 0.f; }
                u32x2 w; w.x = cvt_pk_bf16(v[0], v[1]); w.y = cvt_pk_bf16(v[2], v[3]);
                *(LAS u32x2*)(ST + l * 136 + sb) = w; }
        __syncthreads();
        f32x4 accR[4][2]; zero_acc<2>(accR);
        mma_tile<64, 2>(accR, QB, 72, RT, 72, wr, wc, fr, fq);
#pragma unroll
        for (int m = 0; m < 4; ++m)
#pragma unroll
            for (int n = 0; n < 2; ++n) accR[m][n] *= gam;
        mma_tile<128, 2>(accR, ST, 136, VT, 136, wr, wc, fr, fq);
        __syncthreads();
#pragma unroll
        for (int m = 0; m < 4; ++m) { const f32x4 r4 = *(const LAS f32x4*)(vrw + dir * 128 + 64 * wr + 16 * m + 4 * fq);
#pragma unroll
            for (int n = 0; n < 2; ++n) yacc[m][n] += accR[m][n] * r4; }
    }
    const int erow = tid >> 2, eqd = tid & 3, es = s0 + erow;
    u32x4 og4[4]; f32x4 gp4[8];
    { const bf16_t* gg = B.PROJ + (size_t)es * NPROJP + PC_RG + h * 128 + eqd * 32; const float* gp = g_out + h * 128 + eqd * 32;
#pragma unroll
        for (int i = 0; i < 4; ++i) og4[i] = *(const u32x4*)(gg + i * 8);
#pragma unroll
        for (int i = 0; i < 8; ++i) gp4[i] = *(const f32x4*)(gp + i * 4); }
#pragma unroll
    for (int m = 0; m < 4; ++m)
#pragma unroll
        for (int n = 0; n < 2; ++n)
#pragma unroll
            for (int j = 0; j < 4; ++j) HT[(64 * wr + 16 * m + 4 * fq + j) * 132 + 32 * wc + 16 * n + fr] = yacc[m][n][j];
    __syncthreads();
    { float ssq = 0.f; f32x4 x4[8];
#pragma unroll
        for (int i = 0; i < 8; ++i) { x4[i] = *(const LAS f32x4*)(HT + erow * 132 + eqd * 32 + i * 4);
            ssq += x4[i][0] * x4[i][0] + x4[i][1] * x4[i][1] + x4[i][2] * x4[i][2] + x4[i][3] * x4[i][3]; }
        ssq += __shfl_xor(ssq, 1); ssq += __shfl_xor(ssq, 2);
        const float rstd = rsqrtf(ssq * (1.f / 128.f) + EPS_);
        bf16_t* yo = B.Y + (size_t)es * DM + 512 + h * 128 + eqd * 32;
#pragma unroll
        for (int i = 0; i < 4; ++i) { float o8[8]; unpack8(og4[i], o8); float r8[8];
#pragma unroll
            for (int k = 0; k < 8; ++k) { const float sl = o8[k] * __builtin_amdgcn_rcpf(1.f + __expf(-o8[k])); r8[k] = sl * x4[2 * i + (k >> 2)][k & 3] * rstd * gp4[2 * i + (k >> 2)][k & 3]; }
            *(u32x4*)(yo + i * 8) = pack8(r8); } }
    __syncthreads();
}

__device__ __forceinline__ int map_col(int n, int mode) {
    if (mode == 1) { const int h = n / 192, d = n % 192; if (d < 128) return h * 128 + d; const int jj = d - 128; return 1024 + h * 64 + 2 * (jj & 31) + (jj >> 5); }
    if (mode == 2) { const int h = n >> 8, d = n & 255; return d < 128 ? h * 128 + d : 1024 + h * 128 + (d - 128); }
    return n;
}
struct CvtTile { const float* W; bf16_t* dst; const float* gk; int K, N, kt, nt, mode; };
constexpr int TILES_L = 576 + 48 + 32 + 256 + 1024 + 1024;
__device__ __forceinline__ CvtTile cvt_get(const Params& p, int t) {
    const int l = t / TILES_L; int r = t % TILES_L; unsigned char* Wl = p.ws + OFF_W + (size_t)l * SZ_WL; CvtTile c; int nT; c.mode = 0; c.gk = nullptr;
    if (r < 576) { c.W = p.w_in + (size_t)l * DM * NPROJ; c.K = DM; c.N = NPROJ; nT = 18; c.dst = (bf16_t*)(Wl + WO_IN); c.gk = p.g_mix + l * DM; }
    else if ((r -= 576) < 48) { c.W = p.w_q_up + (size_t)l * 512 * 1536; c.K = 512; c.N = 1536; nT = 6; c.mode = 1; c.dst = (bf16_t*)(Wl + WO_Q); }
    else if ((r -= 48) < 32) { c.W = p.w_kv_up + (size_t)l * 256 * 2048; c.K = 256; c.N = 2048; nT = 8; c.mode = 2; c.dst = (bf16_t*)(Wl + WO_KV); }
    else if ((r -= 32) < 256) { c.W = p.w_out + (size_t)l * DM * DM; c.K = DM; c.N = DM; nT = 8; c.dst = (bf16_t*)(Wl + WO_OUT); }
    else if ((r -= 256) < 1024) { c.W = p.w_ff1 + (size_t)l * DM * DFF; c.K = DM; c.N = DFF; nT = 32; c.dst = (bf16_t*)(Wl + WO_1); c.gk = p.g_ffn + l * DM; }
    else { r -= 1024; c.W = p.w_ff2 + (size_t)l * DFF * DM; c.K = DFF; c.N = DM; nT = 8; c.dst = (bf16_t*)(Wl + WO_2); }
    c.kt = r / nT; c.nt = r % nT; return c;
}
__device__ __forceinline__ void cvt_load(const CvtTile& c, f32x4 (&v)[8], int tid) {
#pragma unroll
    for (int i = 0; i < 8; ++i) { const int k = (tid >> 6) + 8 * i, gn = c.nt * 256 + (tid & 63) * 4;
        v[i] = (f32x4){0.f, 0.f, 0.f, 0.f};
        if (gn < c.N) { v[i] = __builtin_nontemporal_load((const f32x4*)(c.W + (size_t)(c.kt * 64 + k) * c.N + gn)); if (c.gk) v[i] = v[i] * c.gk[c.kt * 64 + k]; } }
}
__device__ __forceinline__ void convert_phase(const Params& p, LAS unsigned char* lds) {
    LAS float* T = (LAS float*)lds;
    const int tid = ltid(), G = gridDim.x;
    int t = lbid();
    f32x4 v[8]; CvtTile c;
    if (t < NLAYER * TILES_L) { c = cvt_get(p, t); cvt_load(c, v, tid); }
    while (t < NLAYER * TILES_L) {
#pragma unroll
        for (int i = 0; i < 8; ++i) { const int k = (tid >> 6) + 8 * i, n4 = (tid & 63) * 4;
            T[k * 257 + n4] = v[i][0]; T[k * 257 + n4 + 1] = v[i][1]; T[k * 257 + n4 + 2] = v[i][2]; T[k * 257 + n4 + 3] = v[i][3]; }
        __syncthreads();
        const CvtTile cur = c; const int tn = t + G;
        if (tn < NLAYER * TILES_L) { c = cvt_get(p, tn); cvt_load(c, v, tid); }
#pragma unroll
        for (int i = 0; i < 4; ++i) { const int ch = tid + 512 * i, n = ch >> 3, k8 = (ch & 7) * 8, gn = cur.nt * 256 + n;
            if (gn < cur.N) { float f[8];
#pragma unroll
                for (int j = 0; j < 8; ++j) f[j] = T[(k8 + j) * 257 + n];
                *(u32x4*)(cur.dst + (size_t)map_col(gn, cur.mode) * cur.K + cur.kt * 64 + k8) = pack8(f); } }
        __syncthreads();
        t = tn;
    }
    constexpr int PADV = (NPROJP - NPROJ) * DM * 2 / 16;
    for (int i = lbid() * 512 + tid; i < NLAYER * PADV; i += G * 512) { const int l = i / PADV, j = i % PADV;
        ((u32x4*)(p.ws + OFF_W + (size_t)l * SZ_WL + WO_IN + (size_t)NPROJ * DM * 2))[j] = (u32x4){0u, 0u, 0u, 0u}; }
    for (int i = lbid() * 512 + tid; i < S_ * 32; i += G * 512) { const int s = i >> 5, j = i & 31;
        const float inv = powf(10000.f, -(float)j * (1.f / 32.f)); const float ang = (float)p.pos[s] * inv;
        const double a = (double)ang, tw = 6.283185307179586476925; const double r = a - tw * rint(a / tw); const float rf = (float)r;
        ((float*)(p.ws + OFF_ROPE))[i] = __cosf(rf); ((float*)(p.ws + OFF_ROPE))[S_ * 32 + i] = __sinf(rf); }
    { const int wid = tid >> 6, lane = tid & 63; bf16_t* H = (bf16_t*)(p.ws + OFF_H); unsigned long long* ssqa = (unsigned long long*)(p.ws + OFF_SSQA);
        for (int row = lbid() * 8 + wid; row < S_; row += G * 8) { const float* xr = p.x + (size_t)row * DM; float ssq = 0.f;
#pragma unroll
            for (int i = 0; i < 8; ++i) { const int col = (i * 64 + lane) * 4; const f32x4 x = *(const f32x4*)(xr + col);
                ssq += x[0] * x[0] + x[1] * x[1] + x[2] * x[2] + x[3] * x[3];
                u32x2 w; w.x = cvt_pk_bf16(x[0], x[1]); w.y = cvt_pk_bf16(x[2], x[3]); *(u32x2*)(H + (size_t)row * DM + col) = w; }
            ssq = wave_sum(ssq); if (lane == 0) ssqa[row] = (unsigned long long)(ssq * 1048576.f); } }
}

template <int MODE>
__device__ __forceinline__ void rms_phase(const float* __restrict__ src, const float* __restrict__ g, bf16_t* __restrict__ H, float* __restrict__ Xcopy, float* __restrict__ outf) {
    const int wid = ltid() >> 6, lane = ltid() & 63;
    for (int row = lbid() * 8 + wid; row < S_; row += gridDim.x * 8) {
        const float* xr = src + (size_t)row * DM; f32x4 v[8]; float ssq = 0.f;
#pragma unroll
        for (int i = 0; i < 8; ++i) { v[i] = *(const f32x4*)(xr + (i * 64 + lane) * 4); ssq += v[i][0] * v[i][0] + v[i][1] * v[i][1] + v[i][2] * v[i][2] + v[i][3] * v[i][3]; }
        ssq = wave_sum(ssq);
        const float rstd = rsqrtf(ssq * (1.f / DM) + EPS_);
#pragma unroll
        for (int i = 0; i < 8; ++i) { const int col = (i * 64 + lane) * 4; const f32x4 gv = *(const f32x4*)(g + col);
            const f32x4 y = v[i] * rstd * gv;
            if (MODE == 0) { u32x2 w; w.x = cvt_pk_bf16(y[0], y[1]); w.y = cvt_pk_bf16(y[2], y[3]); *(u32x2*)(H + (size_t)row * DM + col) = w;
                if (Xcopy) *(f32x4*)(Xcopy + (size_t)row * DM + col) = v[i]; }
            else *(f32x4*)(outf + (size_t)row * DM + col) = y; }
    }
}

__device__ __forceinline__ void final_phase(const bf16_t* __restrict__ H, const float* __restrict__ g, float* __restrict__ outf) {
    const int tid = ltid(), wid = tid >> 6, lane = tid & 63;
    for (int row = lbid() * 8 + wid; row < S_; row += gridDim.x * 8) {
        float v[32]; float ssq = 0.f;
#pragma unroll
        for (int i = 0; i < 4; ++i) { float f[8]; unpack8(*(const u32x4*)(H + (size_t)row * DM + (i * 64 + lane) * 8), f);
#pragma unroll
            for (int k = 0; k < 8; ++k) { v[i * 8 + k] = f[k]; ssq += f[k] * f[k]; } }
        ssq = wave_sum(ssq);
        const float rstd = rsqrtf(ssq * (1.f / DM) + EPS_);
#pragma unroll
        for (int i = 0; i < 4; ++i) { const int col = (i * 64 + lane) * 8;
#pragma unroll
            for (int q = 0; q < 2; ++q) { const f32x4 gv = *(const f32x4*)(g + col + q * 4); f32x4 y;
#pragma unroll
                for (int k = 0; k < 4; ++k) y[k] = v[i * 8 + q * 4 + k] * rstd * gv[k];
                *(f32x4*)(outf + (size_t)row * DM + col + q * 4) = y; } }
    }
}

__device__ __forceinline__ void prep_phase(const Params& p, const Bufs& B, int l) {
    const int wid = ltid() >> 6, lane = ltid() & 63;
    const float* wconv = p.w_conv + (size_t)l * 3 * 1024; const float* bg = p.b_gates + l * 16;
    const float* gq = p.g_q_norm + l * 512; const float* gkv = p.g_kv_norm + l * 256;
    for (int s = lbid() * 8 + wid; s < S_; s += gridDim.x * 8) {
        const bf16_t* pr = B.PROJ + (size_t)s * NPROJP;
        const u32x4 z4 = (u32x4){0u, 0u, 0u, 0u};
        u32x4 cm[2], cc[2], cp[2];
#pragma unroll
        for (int hf = 0; hf < 2; ++hf) { const int c0 = lane * 16 + hf * 8;
            cm[hf] = s > 0 ? *(const u32x4*)(pr - NPROJP + c0) : z4; cc[hf] = *(const u32x4*)(pr + c0); cp[hf] = s < S_ - 1 ? *(const u32x4*)(pr + NPROJP + c0) : z4; }
        const int tensor = lane >> 5, head = (lane & 31) >> 3, j0 = (lane & 7) * 4, base = PC_RQ + tensor * 256 + head * 64;
        const u32x2 w1 = *(const u32x2*)(pr + base + j0), w2 = *(const u32x2*)(pr + base + 32 + j0);
        const f32x4 rc4 = *(const f32x4*)(B.RC + (size_t)s * 32 + j0), rs4 = *(const f32x4*)(B.RS + (size_t)s * 32 + j0);
        const u32x4 cqv = *(const u32x4*)(pr + PC_CQ + lane * 8); const u32x2 ckvv = *(const u32x2*)(pr + PC_CKV + lane * 4);
        const int l32 = lane & 31, l16 = lane & 15;
        const bf16_t kr1 = pr[PC_KR + l32], kr2 = pr[PC_KR + 32 + l32]; const float krc = B.RC[(size_t)s * 32 + l32], krs = B.RS[(size_t)s * 32 + l32];
        const bf16_t gt = pr[PC_GATE + l16]; const float bgl = bg[l16];
#pragma unroll
        for (int hf = 0; hf < 2; ++hf) { const int c0 = lane * 16 + hf * 8; float xm[8], x0[8], xp[8], r[8];
            unpack8(cm[hf], xm); unpack8(cc[hf], x0); unpack8(cp[hf], xp);
#pragma unroll
            for (int i = 0; i < 8; ++i) { const float v = xm[i] * wconv[c0 + i] + x0[i] * wconv[1024 + c0 + i] + xp[i] * wconv[2048 + c0 + i]; r[i] = v * __builtin_amdgcn_rcpf(1.f + __expf(-v)); }
            *(u32x4*)(B.QKML + (size_t)s * 1024 + c0) = pack8(r); }
        { const float x1[4] = {bflo(w1.x), bfhi(w1.x), bflo(w1.y), bfhi(w1.y)}, x2[4] = {bflo(w2.x), bfhi(w2.x), bflo(w2.y), bfhi(w2.y)};
            const float sc = tensor ? 0.125f : 1.f; float o1[4], o2[4];
#pragma unroll
            for (int i = 0; i < 4; ++i) { o1[i] = (x1[i] * rc4[i] - x2[i] * rs4[i]) * sc; o2[i] = (x2[i] * rc4[i] + x1[i] * rs4[i]) * sc; }
            u32x2 a, b2; a.x = cvt_pk_bf16(o1[0], o1[1]); a.y = cvt_pk_bf16(o1[2], o1[3]); b2.x = cvt_pk_bf16(o2[0], o2[1]); b2.y = cvt_pk_bf16(o2[2], o2[3]);
            bf16_t* d = B.RQK + (size_t)s * 512 + tensor * 256 + head * 64 + j0; *(u32x2*)d = a; *(u32x2*)(d + 32) = b2; }
        { float f[8]; unpack8(cqv, f); float g4[4] = {bflo(ckvv.x), bfhi(ckvv.x), bflo(ckvv.y), bfhi(ckvv.y)};
            float ssq = 0.f, ssk = g4[0] * g4[0] + g4[1] * g4[1] + g4[2] * g4[2] + g4[3] * g4[3];
#pragma unroll
            for (int i = 0; i < 8; ++i) ssq += f[i] * f[i];
#pragma unroll
            for (int o = 32; o > 0; o >>= 1) { ssq += __shfl_xor(ssq, o); ssk += __shfl_xor(ssk, o); }
            const float rstd = rsqrtf(ssq * (1.f / 512.f) + EPS_), rstk = rsqrtf(ssk * (1.f / 256.f) + EPS_);
#pragma unroll
            for (int i = 0; i < 8; ++i) f[i] = f[i] * rstd * gq[lane * 8 + i];
            *(u32x4*)(B.CQN + (size_t)s * 512 + lane * 8) = pack8(f);
#pragma unroll
            for (int i = 0; i < 4; ++i) g4[i] = g4[i] * rstk * gkv[lane * 4 + i];
            u32x2 o; o.x = cvt_pk_bf16(g4[0], g4[1]); o.y = cvt_pk_bf16(g4[2], g4[3]); *(u32x2*)(B.CKVN + (size_t)s * 256 + lane * 4) = o; }
        if (lane < 32) { const float x1 = bf2f(kr1), x2 = bf2f(kr2);
            const unsigned w = cvt_pk_bf16(x1 * krc - x2 * krs, x2 * krc + x1 * krs);
#pragma unroll
            for (int h = 0; h < 8; ++h) *(unsigned*)(B.K + ((size_t)h * S_ + s) * 192 + 128 + 2 * lane) = w; }
        if (lane < 16) { float v = bf2f(gt) + bgl;
            if ((lane >> 2) & 1) v = fminf(v, 0.f) - log1pf(__expf(-fabsf(v)));
            B.G[(size_t)s * 16 + lane] = v; }
    }
}

constexpr int NSUB = 8;
constexpr int NPHASE = 2 + NLAYER * NSUB;
__global__ void __launch_bounds__(512) mega_fwd(Params p) {
    extern __shared__ __attribute__((aligned(16))) unsigned char lds_raw[];
    LAS unsigned char* lds = (LAS unsigned char*)lds_raw;
    cg::grid_group grid = cg::this_grid();
    const int G = gridDim.x;
    volatile LAS unsigned* xst = (volatile LAS unsigned*)(lds + LDS_BYTES - 16);
    if (threadIdx.x == 0) { xst[0] = 0u; xst[1] = 0u; }
    if (blockIdx.x == 0) { unsigned* bw = (unsigned*)(p.ws + OFF_BAR); for (int i = threadIdx.x; i < XCD_BAR_WORDS; i += 512) bw[i] = 0u; __threadfence(); }
    __syncthreads();
    XcdBarrier xbar; xbar.bar = (unsigned*)(p.ws + OFF_BAR); xbar.x = 0; xbar.st = xst;
    for (int ph = p.ph_lo; ph < p.ph_hi; ++ph) {
        if (ph > p.ph_lo) { if (ph == p.ph_lo + 1) { grid.sync(); xbar = xcd_barrier_post((unsigned*)(p.ws + OFF_BAR), xst); } else xcd_barrier(xbar); }
        const int bx = lbid();
        unsigned char* ws = p.ws; asm volatile("" : "+s"(ws));
        Bufs B;
        B.H = (bf16_t*)(ws + OFF_H); B.Y = (bf16_t*)(ws + OFF_Y); B.QKML = (bf16_t*)(ws + OFF_QKML); B.RQK = (bf16_t*)(ws + OFF_RQK); B.CQN = (bf16_t*)(ws + OFF_CQN);
        B.CKVN = (bf16_t*)(ws + OFF_CKVN); B.CST = (bf16_t*)(ws + OFF_CST); B.RST = (bf16_t*)(ws + OFF_RST); B.PROJ = (bf16_t*)(ws + OFF_PROJ);
        B.Q = (bf16_t*)(ws + OFF_Q); B.K = (bf16_t*)(ws + OFF_K); B.V = (bf16_t*)(ws + OFF_V); B.ACT = (bf16_t*)(ws + OFF_ACT);
        B.X = (float*)(ws + OFF_X); B.RC = (float*)(ws + OFF_ROPE); B.RS = B.RC + S_ * 32; B.G = (float*)(ws + OFF_G); B.CLOC = (float*)(ws + OFF_CLOC);
        B.NLOC = (float*)(ws + OFF_NLOC); B.NST = (float*)(ws + OFF_NST); B.MLOC = (float*)(ws + OFF_MLOC); B.BLAST = (float*)(ws + OFF_BLAST); B.MST = (float*)(ws + OFF_MST);
        B.RLOC = (float*)(ws + OFF_RLOC); B.Wl = nullptr;
        unsigned long long* ssqa = (unsigned long long*)(ws + OFF_SSQA); unsigned long long* ssqb = (unsigned long long*)(ws + OFF_SSQB);
        if (ph == 0) { convert_phase(p, lds); continue; }
        if (ph == NPHASE - 1) { final_phase(B.H, p.g_final, p.out); continue; }
        const int l = (ph - 1) / NSUB, sub = (ph - 1) % NSUB;
        unsigned char* Wl = ws + OFF_W + (size_t)l * SZ_WL;
        pg8::StaticOrder so;
        switch (sub) {
        case 0: { so.init(S_, NPROJP - 512, G, bx, 6, 2); pg8::Gemm g{B.H, (const bf16_t*)(Wl + WO_IN), S_, NPROJP, DM}; pg8::EpiBf16<0> e{B.PROJ, NPROJP, ssqa}; pg8::gemm_phase(lds, g, so, e); } break;
        case 1: prep_phase(p, B, l); break;
        case 2: {
            if (bx < 192) { so.init(S_, 1536, 192, bx); pg8::Gemm g{B.CQN, (const bf16_t*)(Wl + WO_Q), S_, 1536, 512}; pg8::EpiQup e{B.Q, B.RC, B.RS}; pg8::gemm_phase(lds, g, so, e); }
            else { so.init(S_, 512, 64, bx - 192, 0, 6); pg8::Gemm g{B.H, (const bf16_t*)(Wl + WO_IN), S_, NPROJP, DM}; pg8::EpiBf16<0> e{B.PROJ, NPROJP, ssqa}; pg8::gemm_phase(lds, g, so, e); }
            { so.init(S_, 2048, G, bx); pg8::Gemm g{B.CKVN, (const bf16_t*)(Wl + WO_KV), S_, 2048, 256}; pg8::EpiKVup e{B.K, B.V}; pg8::gemm_phase(lds, g, so, e); }
            if (bx < 192) for (int it = bx; it < 1024; it += 192) { if (it < 512) mlstm_local(B, it, lds); else ret_local(B, it - 512, lds); }
        } break;
        case 3: { scan_phase(B);
            for (int i = bx * 512 + ltid(); i < S_; i += G * 512) { ssqa[i] = 0ull; ssqb[i] = 0ull; } } break;
        case 4: {
            for (int it = bx; it < 256; it += G) mlstm_out(B, p.g_ml_out + l * 512, it, lds);
            for (int it = bx; it < 256; it += G) ret_out(B, p.g_ret_out + l * 512, it, lds);
            for (int it = bx; it < 256; it += G) { const int h = it & 7, qb = it >> 3;
                att::attn_body(B.Q + ((size_t)h * S_ + qb * 256) * 192, B.K + (size_t)h * S_ * 192, B.V + (size_t)h * S_ * 128,
                               B.Y + (size_t)(qb * 256) * DM + 1024 + h * 128, S_, (char*)lds_raw); }
        } break;
        case 5: { so.init(S_, DM, G, bx); pg8::Gemm g{B.Y, (const bf16_t*)(Wl + WO_OUT), S_, DM, DM};
 pg8::EpiResid e{B.H, ssqb, DM}; pg8::gemm_phase(lds, g, so, e); } break;
        case 6: { so.init(S_, DFF, G, bx); pg8::Gemm g{B.H, (const bf16_t*)(Wl + WO_1), S_, DFF, DM}; pg8::EpiBf16<1> e{B.ACT, DFF, ssqb}; pg8::gemm_phase(lds, g, so, e); } break;
        case 7: { so.init(S_, DM, G, bx); pg8::Gemm g{B.ACT, (const bf16_t*)(Wl + WO_2), S_, DM, DFF};
            pg8::EpiResid e{B.H, ssqa, DM}; pg8::gemm_phase(lds, g, so, e); } break;
        }
    }
}

#ifndef MK_MULTI
#define MK_MULTI 0
#endif
extern "C" void kernel_launch(void* const* d_in, const int* in_sizes, int n_in, void* d_out, int out_size, void* d_ws, size_t ws_size, hipStream_t stream) {
    static int grid = 0;
    if (grid == 0) {
        if (n_in != 17 || out_size != S_ * DM || ws_size < WS_END) { fprintf(stderr, "kernel_launch: unexpected shapes: n_in %d out %d ws %zu (need %zu)\n", n_in, out_size, ws_size, (size_t)WS_END); grid = -1; return; }
        int dev = 0, cus = 0, per_cu = 0;
        hipGetDevice(&dev); hipDeviceGetAttribute(&cus, hipDeviceAttributeMultiprocessorCount, dev);
        if (hipFuncSetAttribute((const void*)mega_fwd, hipFuncAttributeMaxDynamicSharedMemorySize, LDS_BYTES) != hipSuccess) { fprintf(stderr, "kernel_launch: hipFuncSetAttribute failed\n"); grid = -1; return; }
        if (hipOccupancyMaxActiveBlocksPerMultiprocessor(&per_cu, (const void*)mega_fwd, 512, LDS_BYTES) != hipSuccess || per_cu < 1) { fprintf(stderr, "kernel_launch: occupancy query says %d\n", per_cu); per_cu = 1; }
        (void)hipGetLastError();
        grid = cus * 1;
        fprintf(stderr, "kernel_launch: cus %d per_cu %d grid %d\n", cus, per_cu, grid);
    }
    if (grid < 0) return;
    Params p{};
    p.x = (const float*)d_in[0]; p.pos = (const int*)d_in[1]; p.g_mix = (const float*)d_in[2]; p.w_in = (const float*)d_in[3]; p.b_gates = (const float*)d_in[4];
    p.w_conv = (const float*)d_in[5]; p.g_ml_out = (const float*)d_in[6]; p.g_ret_out = (const float*)d_in[7]; p.g_q_norm = (const float*)d_in[8]; p.w_q_up = (const float*)d_in[9];
    p.g_kv_norm = (const float*)d_in[10]; p.w_kv_up = (const float*)d_in[11]; p.w_out = (const float*)d_in[12]; p.g_ffn = (const float*)d_in[13]; p.w_ff1 = (const float*)d_in[14];
    p.w_ff2 = (const float*)d_in[15]; p.g_final = (const float*)d_in[16]; p.out = (float*)d_out; p.ws = (unsigned char*)d_ws;
#if MK_MULTI
    for (int ph = 0; ph < NPHASE; ++ph) { p.ph_lo = ph; p.ph_hi = ph + 1; hipLaunchKernelGGL(mega_fwd, dim3(grid), dim3(512), LDS_BYTES, stream, p); }
#else
    p.ph_lo = 0; p.ph_hi = NPHASE;
    void* args[] = {&p};
    hipError_t e = hipLaunchCooperativeKernel((const void*)mega_fwd, dim3(grid), dim3(512), args, LDS_BYTES, stream);
    if (e != hipSuccess) fprintf(stderr, "kernel_launch: cooperative launch failed: %s (grid %d)\n", hipGetErrorString(e), grid);
#endif
}
```

```cpp
#include <hip/hip_runtime.h>
#include <hip/hip_cooperative_groups.h>
#include <cstdio>
#include <cstdint>
namespace cg = cooperative_groups;

typedef unsigned short bf16_t;
typedef short bf16x8 __attribute__((ext_vector_type(8)));
typedef short s16x4 __attribute__((ext_vector_type(4)));
typedef float f32x4 __attribute__((ext_vector_type(4)));
typedef float f32x16 __attribute__((ext_vector_type(16)));
typedef unsigned u32x4 __attribute__((ext_vector_type(4)));
typedef unsigned u32x2 __attribute__((ext_vector_type(2)));
#define LAS __attribute__((address_space(3)))

constexpr int S_ = 8192, DM = 2048, NPROJ = 4432, NPROJP = 4608, DFF = 8192, NLAYER = 4;
constexpr float EPS_ = 1e-6f;
constexpr int LDS_BYTES = 147456;

constexpr int PC_MLQ = 0, PC_MLK = 512, PC_MLV = 1024, PC_MLO = 1536, PC_GATE = 2048, PC_RQ = 2064, PC_RK = 2320, PC_RV = 2576, PC_RG = 3088,
              PC_CQ = 3600, PC_CKV = 4112, PC_KR = 4368;

constexpr size_t SZ_WIN = (size_t)NPROJP * DM * 2, SZ_WQ = (size_t)1536 * 512 * 2, SZ_WKV = (size_t)2048 * 256 * 2, SZ_WOUT = (size_t)DM * DM * 2,
                 SZ_W1 = (size_t)DFF * DM * 2, SZ_W2 = (size_t)DM * DFF * 2;
constexpr size_t WO_IN = 0, WO_Q = WO_IN + SZ_WIN, WO_KV = WO_Q + SZ_WQ, WO_OUT = WO_KV + SZ_WKV, WO_1 = WO_OUT + SZ_WOUT, WO_2 = WO_1 + SZ_W1, SZ_WL = WO_2 + SZ_W2;
constexpr size_t OFF_W = 0;
constexpr size_t OFF_X = OFF_W + NLAYER * SZ_WL;
constexpr size_t OFF_H = OFF_X + (size_t)S_ * DM * 4;
constexpr size_t OFF_Y = OFF_H + (size_t)S_ * DM * 2;
constexpr size_t OFF_ROPE = OFF_Y + (size_t)S_ * DM * 2;
constexpr size_t OFF_G = OFF_ROPE + (size_t)S_ * 32 * 4 * 2;
constexpr size_t OFF_QKML = OFF_G + (size_t)S_ * 16 * 4;
constexpr size_t OFF_RQK = OFF_QKML + (size_t)S_ * 1024 * 2;
constexpr size_t OFF_CQN = OFF_RQK + (size_t)S_ * 512 * 2;
constexpr size_t OFF_CKVN = OFF_CQN + (size_t)S_ * 512 * 2;
constexpr size_t OFF_CLOC = OFF_CKVN + (size_t)S_ * 256 * 2;
constexpr size_t OFF_CST = OFF_CLOC + (size_t)512 * 16384 * 4;
constexpr size_t OFF_NLOC = OFF_CST + (size_t)512 * 16384 * 2;
constexpr size_t OFF_NST = OFF_NLOC + (size_t)512 * 128 * 4;
constexpr size_t OFF_MLOC = OFF_NST + (size_t)512 * 128 * 4;
constexpr size_t OFF_BLAST = OFF_MLOC + 2048;
constexpr size_t OFF_MST = OFF_BLAST + 2048;
constexpr size_t OFF_RLOC = OFF_MST + 2048;
constexpr size_t OFF_RST = OFF_RLOC + (size_t)512 * 8192 * 4;
constexpr size_t OFF_BAR = OFF_RST + (size_t)512 * 8192 * 2;
constexpr size_t OFF_SSQA = OFF_BAR + 16384;
constexpr size_t OFF_SSQB = OFF_SSQA + (size_t)S_ * 8;
constexpr size_t OFF_MIX = OFF_SSQB + (size_t)S_ * 8;
constexpr size_t OFF_PROJ = OFF_MIX;
constexpr size_t OFF_Q = OFF_PROJ + (size_t)S_ * NPROJP * 2;
constexpr size_t OFF_K = OFF_Q + (size_t)8 * S_ * 192 * 2;
constexpr size_t OFF_V = OFF_K + (size_t)8 * S_ * 192 * 2;
constexpr size_t OFF_END0 = OFF_V + (size_t)8 * S_ * 128 * 2;
constexpr size_t OFF_ACT = OFF_MIX;
constexpr size_t OFF_END1 = OFF_ACT + (size_t)S_ * DFF * 2;
constexpr size_t WS_END = OFF_END0 > OFF_END1 ? OFF_END0 : OFF_END1;

struct Params {
    const float* x; const int* pos; const float* g_mix; const float* w_in; const float* b_gates; const float* w_conv;
    const float* g_ml_out; const float* g_ret_out; const float* g_q_norm; const float* w_q_up; const float* g_kv_norm; const float* w_kv_up;
    const float* w_out; const float* g_ffn; const float* w_ff1; const float* w_ff2; const float* g_final;
    float* out; unsigned char* ws;
    int ph_lo, ph_hi;
};

__device__ __forceinline__ unsigned cvt_pk_bf16(float lo, float hi) { unsigned r; asm volatile("v_cvt_pk_bf16_f32 %0, %1, %2" : "=v"(r) : "v"(lo), "v"(hi)); return r; }
__device__ __forceinline__ int ltid() { int t = threadIdx.x; asm volatile("" : "+v"(t)); return t; }
__device__ __forceinline__ int lbid() { int t = blockIdx.x; asm volatile("" : "+s"(t)); return t; }
__device__ __forceinline__ float bf2f(bf16_t b) { return __uint_as_float(((unsigned)b) << 16); }
__device__ __forceinline__ float bflo(unsigned w) { return __uint_as_float(w << 16); }
__device__ __forceinline__ float bfhi(unsigned w) { return __uint_as_float(w & 0xffff0000u); }
__device__ __forceinline__ bf16_t f2bf(float f) { return (bf16_t)(cvt_pk_bf16(f, 0.f) & 0xffffu); }
__device__ __forceinline__ float wave_sum(float v) { for (int o = 32; o > 0; o >>= 1) v += __shfl_xor(v, o); return v; }
__device__ __forceinline__ float wave_max(float v) { for (int o = 32; o > 0; o >>= 1) v = fmaxf(v, __shfl_xor(v, o)); return v; }
__device__ __forceinline__ void unpack8(u32x4 w, float* f) { f[0] = bflo(w.x); f[1] = bfhi(w.x); f[2] = bflo(w.y); f[3] = bfhi(w.y); f[4] = bflo(w.z); f[5] = bfhi(w.z); f[6] = bflo(w.w); f[7] = bfhi(w.w); }
__device__ __forceinline__ u32x4 pack8(const float* f) { u32x4 w; w.x = cvt_pk_bf16(f[0], f[1]); w.y = cvt_pk_bf16(f[2], f[3]); w.z = cvt_pk_bf16(f[4], f[5]); w.w = cvt_pk_bf16(f[6], f[7]); return w; }


#define XB_TMO      128
#define XB_XCNT(j)  (256  + 64 * (j))
#define XB_XSUB(j)  (1280 + 64 * (j))
#define XB_XGEN(j)  (2304 + 64 * (j))
#define XB_TOP      3328
#define XB_TOPGEN   3392
#define XCD_BAR_WORDS 3456
#define XB_SPIN_CAP (1u << 18)

__device__ __forceinline__ unsigned xb_ld(unsigned* p)              { return __hip_atomic_load(p, __ATOMIC_RELAXED, __HIP_MEMORY_SCOPE_AGENT); }
__device__ __forceinline__ unsigned xb_add(unsigned* p, unsigned v) { return __hip_atomic_fetch_add(p, v, __ATOMIC_RELAXED, __HIP_MEMORY_SCOPE_AGENT); }
__device__ __forceinline__ unsigned xb_xcc_id() { return (unsigned)__builtin_amdgcn_s_getreg((3 << 11) | 20) & 0xFu; }
#define XB_SPIN(cond, bar) do { unsigned _sp = 0; while (cond) { __builtin_amdgcn_s_sleep(1); \
    if ((++_sp & 255u) == 0u) { if (xb_ld(&(bar)[XB_TMO])) break; if (_sp > XB_SPIN_CAP) { atomicAdd(&(bar)[XB_TMO], 1u); break; } } } } while (0)

struct XcdBarrier {
    unsigned* bar; unsigned x;
    volatile LAS unsigned* st;
};

__device__ __forceinline__ XcdBarrier xcd_barrier_post(unsigned* bar, volatile LAS unsigned* st) {
    XcdBarrier b; b.bar = bar; b.x = xb_xcc_id(); b.st = st;
    if (threadIdx.x == 0) (void)xb_add(&bar[XB_XCNT(b.x)], 1u);
    return b;
}
__device__ __forceinline__ void xcd_barrier_complete(unsigned* bar, unsigned x, unsigned& nloc, unsigned& nx) {
    const unsigned G = gridDim.x * gridDim.y * gridDim.z;
    unsigned sum, cnt, mine, sp = 0u;
    for (;;) {
        sum = 0u; cnt = 0u; mine = 0u;
#pragma unroll
        for (unsigned j = 0; j < 16; ++j) { const unsigned c = xb_ld(&bar[XB_XCNT(j)]); sum += c; cnt += (c > 0u) ? 1u : 0u; mine = (j == x) ? c : mine; }
        if (sum == G) break;
        __builtin_amdgcn_s_sleep(1);
        if ((++sp & 255u) == 0u) { if (xb_ld(&bar[XB_TMO])) break; if (sp > XB_SPIN_CAP) { atomicAdd(&bar[XB_TMO], 1u); break; } }
    }
    nloc = mine > 0u ? mine : 1u; nx = cnt > 0u ? cnt : 1u;
}

__device__ __forceinline__ void xcd_barrier(const XcdBarrier& b) {
    asm volatile("s_waitcnt vmcnt(0)" ::: "memory");
    __syncthreads();
    if (threadIdx.x == 0) {
        unsigned* bar = b.bar;
        __builtin_amdgcn_s_waitcnt(0);
        unsigned nloc = b.st[0], nx = b.st[1];
        if (nloc == 0u) { xcd_barrier_complete(bar, b.x, nloc, nx); b.st[0] = nloc; b.st[1] = nx; }
        const unsigned old = xb_add(&bar[XB_XSUB(b.x)], 1u);
        const unsigned gen = old / nloc;
        if (old + 1u == (gen + 1u) * nloc) {
            __builtin_amdgcn_fence(__ATOMIC_RELEASE, "agent");
            asm volatile("s_waitcnt vmcnt(0)" ::: "memory");
            const unsigned og = xb_add(&bar[XB_TOP], 1u);
            const unsigned tg = og / nx;
            if (og + 1u == (tg + 1u) * nx) xb_add(&bar[XB_TOPGEN], 1u);
            else XB_SPIN(xb_ld(&bar[XB_TOPGEN]) == tg, bar);
            __builtin_amdgcn_fence(__ATOMIC_ACQUIRE, "agent");
            xb_add(&bar[XB_XGEN(b.x)], 1u);
            asm volatile("s_waitcnt vmcnt(0)" ::: "memory");
        } else {
            XB_SPIN(xb_ld(&bar[XB_XGEN(b.x)]) == gen, bar);
            __builtin_amdgcn_fence(__ATOMIC_ACQUIRE, "agent");
            asm volatile("s_waitcnt vmcnt(0)" ::: "memory");
        }
    }
    __syncthreads();
}

namespace pg8 {
constexpr int BM = 256, BK = 64, HALF = 128, HTB = HALF * BK * 2, STAGE_BYTES = 8 * HTB, NXCD = 8, WGM = 8;
__host__ __device__ __forceinline__ int lds_byte(int r, int c) { const int st = (r >> 4) * 2 + (c >> 5), rr = r & 15, cc = c & 31, ob = rr * 64 + cc * 2; return st * 1024 + (ob ^ (((ob >> 9) & 1) << 5)); }
__host__ __device__ __forceinline__ void stage_rc(int b, int& R, int& C) { const int st = b / 1024, sb = b % 1024, swz = sb ^ (((sb >> 9) & 1) << 5); R = (st >> 1) * 16 + swz / 64; C = (st & 1) * 32 + (swz % 64) / 2; }
__host__ __device__ __forceinline__ int perm32(int rho) { const int n = rho >> 4, i = rho & 15; return 8 * (i >> 2) + 4 * n + (i & 3); }
struct Unit { int pm, pn; };
struct Gemm { const bf16_t* A; const bf16_t* Bt; int M, N, K; };
struct StaticOrder {
    int nM, nN, nwg, G, c, skip_lo, skip_n, ioff = 0, icnt = 1 << 20;
    __device__ void init(int M, int N, int G_, int c_, int slo = 1 << 20, int sn = 0) { nM = M / BM; nN = N / BM; nwg = nM * nN; G = G_; c = c_; skip_lo = slo; skip_n = sn; }
    __device__ bool next(int i, Unit& u) const {
        if (i >= icnt) return false; const long L = (long)(i + ioff) * G + c; if (L >= nwg) return false;
        int wgid = (int)L; { const int q = nwg / NXCD, r = nwg % NXCD, xcd = wgid % NXCD, off = wgid / NXCD; wgid = (xcd < r ? xcd * (q + 1) : r * (q + 1) + (xcd - r) * q) + off; }
        const int nig = WGM * nN, gid = wgid / nig, fm = gid * WGM, gsz = (nM - fm) < WGM ? (nM - fm) : WGM;
        u.pm = fm + ((wgid % nig) % gsz); u.pn = (wgid % nig) / gsz; if (u.pn >= skip_lo) u.pn += skip_n; return true;
    }
};
template <class Epi>
__device__ __forceinline__ void gemm_phase(LAS unsigned char* lds, const Gemm g, const StaticOrder& S, const Epi& E) {
    const int tid = ltid(), wid = __builtin_amdgcn_readfirstlane(tid >> 6), lane = tid & 63, wr = wid >> 2, wc = wid & 3, fr = lane & 15, fq = lane >> 4;
    int K = g.K; asm volatile("" : "+s"(K)); const int nt = K / BK;
    unsigned voffA[2], voffB[2];
#pragma unroll
    for (int i = 0; i < 2; ++i) { int R, C; stage_rc(tid * 16 + i * 8192, R, C); const int Rb = Epi::PERM ? ((R & ~31) + perm32(R & 31)) : R;
        voffA[i] = (unsigned)(R * K + C) * 2u; voffB[i] = (unsigned)(Rb * K + C) * 2u; }
    const size_t kstep = (size_t)(BK * 2);
    const size_t hstep = (size_t)HALF * K * 2;
    const size_t tstep = 2 * hstep;
    const unsigned ldsw = (unsigned)wid * 1024u;
    const int aoff = lds_byte(wr * 64 + fr, fq * 8), boff = lds_byte(wc * 32 + fr, fq * 8);
#define PG8_SA(b, h) (((b) * 2 + (h)) * HTB)
#define PG8_SB(b, h) ((4 + (b) * 2 + (h)) * HTB)
#define PG8_STAGE(bufoff, gbase, voff) do { _Pragma("unroll") for (int _i = 0; _i < 2; ++_i) \
        __builtin_amdgcn_global_load_lds((const unsigned*)((const char*)(gbase) + (voff)[_i]), (LAS unsigned*)(lds + (bufoff) + ldsw + _i * 8192), 16, 0, 0); } while (0)
#define PG8_LDA(dst, b, h) do { _Pragma("unroll") for (int m = 0; m < 4; ++m) _Pragma("unroll") for (int k = 0; k < 2; ++k) dst[m][k] = *(const LAS bf16x8*)(lds + PG8_SA(b, h) + aoff + m * 2048 + k * 1024); } while (0)
#define PG8_LDB(dst, b, h) do { _Pragma("unroll") for (int n = 0; n < 2; ++n) _Pragma("unroll") for (int k = 0; k < 2; ++k) dst[n][k] = *(const LAS bf16x8*)(lds + PG8_SB(b, h) + boff + n * 2048 + k * 1024); } while (0)
#define PG8_MMA(ai, bj, At, Bt) do { __builtin_amdgcn_s_setprio(1); _Pragma("unroll") for (int m = 0; m < 4; ++m) _Pragma("unroll") for (int n = 0; n < 2; ++n) _Pragma("unroll") for (int k = 0; k < 2; ++k) \
        acc[ai][bj][m][n] = __builtin_amdgcn_mfma_f32_16x16x32_bf16(Bt[n][k], At[m][k], acc[ai][bj][m][n], 0, 0, 0); __builtin_amdgcn_s_setprio(0); } while (0)
#define PG8_WAIT_V(n) asm volatile("s_waitcnt vmcnt(" #n ")" ::: "memory")
#define PG8_WAIT_L(n) asm volatile("s_waitcnt lgkmcnt(" #n ")" ::: "memory")
#define PG8_BAR __builtin_amdgcn_s_barrier()
#define PG8_SCHED __builtin_amdgcn_sched_barrier(0)
    Unit cur, nxt; int ui = 0;
    if (!S.next(0, cur)) return;
    f32x4 acc[2][2][4][2];
#pragma unroll
    for (int a = 0; a < 2; ++a)
#pragma unroll
        for (int b = 0; b < 2; ++b)
#pragma unroll
            for (int m = 0; m < 4; ++m)
#pragma unroll
                for (int n = 0; n < 2; ++n) acc[a][b][m][n] = (f32x4){0.f, 0.f, 0.f, 0.f};
    bf16x8 At[4][2], B0[2][2], B1[2][2];
    const char* cA = (const char*)g.A + (size_t)cur.pm * tstep; const char* cB = (const char*)g.Bt + (size_t)cur.pn * tstep;
    if (Epi::PRE) E.stash(E.prefetch(cur.pm, tid), lds, 0, tid);
    PG8_STAGE(PG8_SB(0, 0), cB, voffB); PG8_STAGE(PG8_SA(0, 0), cA, voffA); PG8_STAGE(PG8_SB(0, 1), cB + hstep, voffB); PG8_STAGE(PG8_SA(0, 1), cA + hstep, voffA);
    if (wr == 1) PG8_BAR;
    PG8_WAIT_V(4); PG8_BAR;
    PG8_STAGE(PG8_SB(1, 0), cB + kstep, voffB); PG8_STAGE(PG8_SA(1, 0), cA + kstep, voffA); PG8_STAGE(PG8_SB(1, 1), cB + hstep + kstep, voffB);
    PG8_WAIT_V(6); PG8_BAR;
    for (;;) {
        const bool has_next = S.next(ui + 1, nxt);
        const char* nA = has_next ? (const char*)g.A + (size_t)nxt.pm * tstep : cA; const char* nB = has_next ? (const char*)g.Bt + (size_t)nxt.pn * tstep : cB;
        for (int t = 0; t < nt; t += 2) {
            const bool last = (t == nt - 2);
            const char* a1 = cA + (size_t)(t + 1) * kstep;
            const char* a2 = last ? nA : cA + (size_t)(t + 2) * kstep; const char* b2 = last ? nB : cB + (size_t)(t + 2) * kstep;
            const char* a3 = a2 + kstep; const char* b3 = b2 + kstep;
            PG8_LDB(B0, 0, 0); PG8_SCHED; PG8_LDA(At, 0, 0); PG8_STAGE(PG8_SA(1, 1), a1 + hstep, voffA);
            PG8_WAIT_L(8); PG8_BAR; PG8_WAIT_L(0); PG8_MMA(0, 0, At, B0); PG8_BAR; PG8_SCHED;
            PG8_LDB(B1, 0, 1); PG8_STAGE(PG8_SB(0, 0), b2, voffB);
            PG8_BAR; PG8_WAIT_L(0); PG8_MMA(0, 1, At, B1); PG8_BAR;
            PG8_LDA(At, 0, 1); PG8_STAGE(PG8_SA(0, 0), a2, voffA);
            PG8_BAR; PG8_WAIT_L(0); PG8_MMA(1, 0, At, B0); PG8_BAR; PG8_SCHED;
            PG8_STAGE(PG8_SB(0, 1), b2 + hstep, voffB);
            PG8_WAIT_V(6); PG8_BAR; PG8_MMA(1, 1, At, B1); PG8_BAR;
            PG8_LDB(B0, 1, 0); PG8_SCHED; PG8_LDA(At, 1, 0); PG8_STAGE(PG8_SA(0, 1), a2 + hstep, voffA);
            PG8_WAIT_L(8); PG8_BAR; PG8_WAIT_L(0); PG8_MMA(0, 0, At, B0); PG8_BAR; PG8_SCHED;
            PG8_LDB(B1, 1, 1); PG8_STAGE(PG8_SB(1, 0), b3, voffB);
            PG8_BAR; PG8_WAIT_L(0); PG8_MMA(0, 1, At, B1); PG8_BAR;
            PG8_LDA(At, 1, 1); PG8_STAGE(PG8_SA(1, 0), a3, voffA);
            PG8_BAR; PG8_WAIT_L(0); PG8_MMA(1, 0, At, B0); PG8_BAR; PG8_SCHED;
            PG8_STAGE(PG8_SB(1, 1), b3 + hstep, voffB);
            PG8_WAIT_V(6); PG8_BAR; PG8_MMA(1, 1, At, B1); PG8_BAR;
        }
        E(acc, cur, wr, wc, fr, fq, lds, ui & 1, has_next ? nxt.pm : -1, tid);
        if (!has_next) break;
#pragma unroll
        for (int a = 0; a < 2; ++a)
#pragma unroll
            for (int b = 0; b < 2; ++b)
#pragma unroll
                for (int m = 0; m < 4; ++m)
#pragma unroll
                    for (int n = 0; n < 2; ++n) acc[a][b][m][n] = (f32x4){0.f, 0.f, 0.f, 0.f};
        cur = nxt; cA = nA; cB = nB; ++ui;
    }
    PG8_WAIT_V(0);
    if (wr == 0) PG8_BAR;
    PG8_BAR;
#undef PG8_SA
#undef PG8_SB
#undef PG8_STAGE
#undef PG8_LDA
#undef PG8_LDB
#undef PG8_MMA
#undef PG8_WAIT_V
#undef PG8_WAIT_L
#undef PG8_BAR
#undef PG8_SCHED
}

template <int ACT> struct EpiBf16 {
    static constexpr bool PERM = true, PRE = true;
    bf16_t* O; int ldc; const unsigned long long* ssq;
    __device__ __forceinline__ unsigned long long prefetch(int pm, int tid) const { return tid < 256 ? ssq[pm * BM + tid] : 0ull; }
    __device__ __forceinline__ void stash(unsigned long long v, LAS unsigned char* lds, int par, int tid) const { if (tid < 256) *(LAS float*)(lds + 131072 + par * 1024 + tid * 4) = rsqrtf((float)v * (1.f / (1048576.f * DM)) + EPS_); }
    __device__ __forceinline__ void operator()(const f32x4 (&acc)[2][2][4][2], const Unit& u, int wr, int wc, int fr, int fq, LAS unsigned char* lds, int par, int npm, int tid) const {
        const int row0 = u.pm * BM + wr * 64 + fr, col0 = u.pn * BM + wc * 32 + 8 * fq;
        unsigned long long nx = 0ull; if (npm >= 0) nx = prefetch(npm, tid);
#pragma unroll
        for (int ai = 0; ai < 2; ++ai)
#pragma unroll
            for (int m = 0; m < 4; ++m) { const int row = row0 + ai * HALF + m * 16; bf16_t* rowp = O + (size_t)row * ldc + col0;
                const float rstd = *(const LAS float*)(lds + 131072 + par * 1024 + (wr * 64 + fr + ai * HALF + m * 16) * 4);
#pragma unroll
                for (int bj = 0; bj < 2; ++bj) { f32x4 v0 = acc[ai][bj][m][0] * rstd, v1 = acc[ai][bj][m][1] * rstd;
                    if (ACT == 1) {
#pragma unroll
                        for (int j = 0; j < 4; ++j) { const float a = fmaxf(v0[j], 0.f), b = fmaxf(v1[j], 0.f); v0[j] = a * a; v1[j] = b * b; } }
                    u32x4 w; w.x = cvt_pk_bf16(v0[0], v0[1]); w.y = cvt_pk_bf16(v0[2], v0[3]); w.z = cvt_pk_bf16(v1[0], v1[1]); w.w = cvt_pk_bf16(v1[2], v1[3]);
                    *(u32x4*)(rowp + bj * HALF) = w; } }
        if (npm >= 0) stash(nx, lds, par ^ 1, tid);
    }
};
struct EpiResid {
    static constexpr bool PERM = true, PRE = false;
    __device__ __forceinline__ unsigned long long prefetch(int, int) const { return 0ull; }
    __device__ __forceinline__ void stash(unsigned long long, LAS unsigned char*, int, int) const {}
    bf16_t* Hb; unsigned long long* ssq; int ldc;
    __device__ __forceinline__ void operator()(const f32x4 (&acc)[2][2][4][2], const Unit& u, int wr, int wc, int fr, int fq, LAS unsigned char* lds, int par, int npm, int tid) const {
        const int row0 = u.pm * BM + wr * 64 + fr, col0 = u.pn * BM + wc * 32 + 8 * fq;
        u32x4 old[2][4][2];
#pragma unroll
        for (int ai = 0; ai < 2; ++ai)
#pragma unroll
            for (int m = 0; m < 4; ++m)
#pragma unroll
                for (int bj = 0; bj < 2; ++bj) old[ai][m][bj] = *(const u32x4*)(Hb + (size_t)(row0 + ai * HALF + m * 16) * ldc + col0 + bj * HALF);
#pragma unroll
        for (int ai = 0; ai < 2; ++ai)
#pragma unroll
            for (int m = 0; m < 4; ++m) { const int row = row0 + ai * HALF + m * 16; bf16_t* hp = Hb + (size_t)row * ldc + col0;
                float part = 0.f;
#pragma unroll
                for (int bj = 0; bj < 2; ++bj) { float o[8]; unpack8(old[ai][m][bj], o);
                    const f32x4 a0 = acc[ai][bj][m][0], a1 = acc[ai][bj][m][1];
                    float v[8] = {o[0] + a0[0], o[1] + a0[1], o[2] + a0[2], o[3] + a0[3], o[4] + a1[0], o[5] + a1[1], o[6] + a1[2], o[7] + a1[3]};
#pragma unroll
                    for (int k = 0; k < 8; ++k) part += v[k] * v[k];
                    *(u32x4*)(hp + bj * HALF) = pack8(v); }
                part += __shfl_xor(part, 16); part += __shfl_xor(part, 32);
                if (fq == 0) atomicAdd(ssq + row, (unsigned long long)(part * 1048576.f)); }
    }
};
struct EpiQup {
    static constexpr bool PERM = true, PRE = false;
    __device__ __forceinline__ unsigned long long prefetch(int, int) const { return 0ull; }
    __device__ __forceinline__ void stash(unsigned long long, LAS unsigned char*, int, int) const {}
    bf16_t* Q; const float* rc; const float* rs;
    __device__ __forceinline__ void operator()(const f32x4 (&acc)[2][2][4][2], const Unit& u, int wr, int wc, int fr, int fq, LAS unsigned char* lds, int par, int npm, int tid) const {
        const int row0 = u.pm * BM + wr * 64 + fr;
        if (u.pn < 4) {
            bf16_t* d0 = Q + ((size_t)(u.pn * 2) * S_ + row0) * 192 + wc * 32 + 8 * fq;
#pragma unroll
            for (int ai = 0; ai < 2; ++ai)
#pragma unroll
                for (int m = 0; m < 4; ++m) {
#pragma unroll
                    for (int bj = 0; bj < 2; ++bj) { const f32x4 v0 = acc[ai][bj][m][0], v1 = acc[ai][bj][m][1];
                        u32x4 w; w.x = cvt_pk_bf16(v0[0], v0[1]); w.y = cvt_pk_bf16(v0[2], v0[3]); w.z = cvt_pk_bf16(v1[0], v1[1]); w.w = cvt_pk_bf16(v1[2], v1[3]);
                        *(u32x4*)(d0 + (size_t)(ai * HALF + m * 16) * 192 + (size_t)bj * S_ * 192) = w; }
                    asm volatile("" ::: "memory"); }
        } else {
            const int jj0 = (wc & 1) * 32 + 8 * fq, j0 = jj0 >> 1;
            bf16_t* d0 = Q + ((size_t)((u.pn - 4) * 4 + (wc >> 1)) * S_ + row0) * 192 + 128 + jj0;
            const float* c0 = rc + (size_t)row0 * 32 + j0; const float* s0 = rs + (size_t)row0 * 32 + j0;
#pragma unroll
            for (int ai = 0; ai < 2; ++ai)
#pragma unroll
                for (int m = 0; m < 4; ++m) { const int ro = ai * HALF + m * 16;
                    const f32x4 c = *(const f32x4*)(c0 + ro * 32), s = *(const f32x4*)(s0 + ro * 32);
#pragma unroll
                    for (int bj = 0; bj < 2; ++bj) { const f32x4 v0 = acc[ai][bj][m][0], v1 = acc[ai][bj][m][1];
                        u32x4 w;
                        w.x = cvt_pk_bf16(v0[0] * c[0] - v0[1] * s[0], v0[1] * c[0] + v0[0] * s[0]);
                        w.y = cvt_pk_bf16(v0[2] * c[1] - v0[3] * s[1], v0[3] * c[1] + v0[2] * s[1]);
                        w.z = cvt_pk_bf16(v1[0] * c[2] - v1[1] * s[2], v1[1] * c[2] + v1[0] * s[2]);
                        w.w = cvt_pk_bf16(v1[2] * c[3] - v1[3] * s[3], v1[3] * c[3] + v1[2] * s[3]);
                        *(u32x4*)(d0 + (size_t)ro * 192 + (size_t)bj * 2 * S_ * 192) = w; }
                    asm volatile("" ::: "memory"); }
        }
    }
};
struct EpiKVup {
    static constexpr bool PERM = true, PRE = false;
    __device__ __forceinline__ unsigned long long prefetch(int, int) const { return 0ull; }
    __device__ __forceinline__ void stash(unsigned long long, LAS unsigned char*, int, int) const {}
    bf16_t* Kb; bf16_t* Vb;
    template <int LD> __device__ __forceinline__ void put(const f32x4 (&acc)[2][2][4][2], bf16_t* d0) const {
#pragma unroll
        for (int ai = 0; ai < 2; ++ai)
#pragma unroll
            for (int m = 0; m < 4; ++m)
#pragma unroll
                for (int bj = 0; bj < 2; ++bj) { const f32x4 v0 = acc[ai][bj][m][0], v1 = acc[ai][bj][m][1];
                    u32x4 w; w.x = cvt_pk_bf16(v0[0], v0[1]); w.y = cvt_pk_bf16(v0[2], v0[3]); w.z = cvt_pk_bf16(v1[0], v1[1]); w.w = cvt_pk_bf16(v1[2], v1[3]);
                    *(u32x4*)(d0 + (size_t)(ai * HALF + m * 16) * LD + (size_t)bj * S_ * LD) = w; }
    }
    __device__ __forceinline__ void operator()(const f32x4 (&acc)[2][2][4][2], const Unit& u, int wr, int wc, int fr, int fq, LAS unsigned char* lds, int par, int npm, int tid) const {
        const int row0 = u.pm * BM + wr * 64 + fr;
        if (u.pn < 4) put<192>(acc, Kb + ((size_t)(u.pn * 2) * S_ + row0) * 192 + wc * 32 + 8 * fq);
        else put<128>(acc, Vb + ((size_t)((u.pn - 4) * 2) * S_ + row0) * 128 + wc * 32 + 8 * fq);
    }
};
}

namespace att {
constexpr int DQ = 192, DV = 128, NW = 8, QBLK = 32, KVBLK = 64;
constexpr float SCALE = 0.07216878364870322f;
constexpr float THR = 8.f;
#ifndef ATT_SDEPTH
#define ATT_SDEPTH 1
#endif
constexpr int SDEPTH = ATT_SDEPTH;
#ifndef ATT_NQREG
#define ATT_NQREG 12
#endif
constexpr int NQREG = ATT_NQREG;
constexpr int LDQ = 192, LDKK = 192, LDVV = 128, LDO = 2048;
constexpr int SHM_V = KVBLK * DV * 2, SHM_K = KVBLK * 400, SHM_QR = 2 * SHM_V + 2 * SHM_K + NW * 64 * 4, SHM_ATTN = SHM_QR + NW * (12 - NQREG) * 64 * 16;
#define KSWZ(row, colB) ((row) * 400 + (colB))
#define SBAR() __builtin_amdgcn_sched_barrier(0)
__device__ __forceinline__ int crow(int r, int hi) { return (r & 3) + 8 * (r >> 2) + 4 * hi; }
__device__ __forceinline__ void partialSM(f32x16& p0, f32x16& p1, float& m_reg, float& mn, float& alpha) {
  constexpr float C = SCALE * 1.4426950408889634f;
  float pmax = p0[0]; for (int r = 1; r < 16; ++r) pmax = fmaxf(pmax, p0[r]); for (int r = 0; r < 16; ++r) pmax = fmaxf(pmax, p1[r]);
  { auto rr = __builtin_amdgcn_permlane32_swap(__float_as_uint(pmax), __float_as_uint(pmax), false, false);
    pmax = fmaxf(__uint_as_float(rr[0]), __uint_as_float(rr[1])); }
  if (__builtin_expect(__all(pmax - m_reg <= THR / SCALE), 1)) { mn = m_reg; alpha = 1.f; }
  else { mn = fmaxf(m_reg, pmax); alpha = __builtin_amdgcn_exp2f((m_reg - mn) * C); m_reg = mn; }
  float mnC = -mn * C;
  for (int r = 0; r < 16; ++r) p0[r] = fmaf(p0[r], C, mnC); for (int r = 0; r < 16; ++r) p1[r] = fmaf(p1[r], C, mnC);
  for (int r = 0; r < 16; ++r) p0[r] = __builtin_amdgcn_exp2f(p0[r]);
}
__device__ __forceinline__ void finishSM(f32x16& p0, f32x16& p1, float alpha, float& l_reg, bf16x8& pa0, bf16x8& pa1, bf16x8& pa2, bf16x8& pa3) {
  for (int r = 0; r < 16; ++r) p1[r] = __builtin_amdgcn_exp2f(p1[r]);
  float ps = 0; for (int r = 0; r < 16; ++r) ps += p0[r]; for (int r = 0; r < 16; ++r) ps += p1[r];
  { auto rr = __builtin_amdgcn_permlane32_swap(__float_as_uint(ps), __float_as_uint(ps), false, false);
    ps = __uint_as_float(rr[0]) + __uint_as_float(rr[1]); }
  l_reg = l_reg * alpha + ps;
#define PK4(P, BASE, OUT) do { unsigned a0 = cvt_pk_bf16(P[BASE + 0], P[BASE + 1]), a1 = cvt_pk_bf16(P[BASE + 2], P[BASE + 3]);   \
    unsigned b0 = cvt_pk_bf16(P[BASE + 4], P[BASE + 5]), b1 = cvt_pk_bf16(P[BASE + 6], P[BASE + 7]);                              \
    auto r0 = __builtin_amdgcn_permlane32_swap(a0, b0, false, false); auto r1 = __builtin_amdgcn_permlane32_swap(a1, b1, false, false); \
    u32x4 w = {r0[0], r1[0], r0[1], r1[1]}; OUT = *reinterpret_cast<bf16x8*>(&w); } while (0)
  PK4(p0, 0, pa0); PK4(p0, 8, pa1); PK4(p1, 0, pa2); PK4(p1, 8, pa3);
#undef PK4
}
__device__ __forceinline__ void qkt(f32x16& p0, f32x16& p1, const bf16_t* Ks, const bf16x8* qr, const bf16x8* qrl, int r32, int hi) {
  p0 = f32x16{}; p1 = f32x16{};
#pragma unroll
  for (int d0 = 0; d0 < 12; ++d0) { int cb = (d0 * 16 + hi * 8) * 2;
    bf16x8 b0 = *reinterpret_cast<const bf16x8*>((const char*)Ks + KSWZ(r32, cb));
    bf16x8 b1 = *reinterpret_cast<const bf16x8*>((const char*)Ks + KSWZ(32 + r32, cb));
    const bf16x8 qv = d0 < NQREG ? qr[d0 < NQREG ? d0 : 0] : qrl[(d0 - NQREG) * 64];
    p0 = __builtin_amdgcn_mfma_f32_32x32x16_bf16(b0, qv, p0, 0, 0, 0);
    p1 = __builtin_amdgcn_mfma_f32_32x32x16_bf16(b1, qv, p1, 0, 0, 0); }
}
__device__ __forceinline__ int v_st(int k, int c) { const int kk = (k & ~0xC) | ((k & 4) << 1) | ((k & 8) >> 1); return ((kk >> 3) * 4 + (c >> 5)) * 512 + ((kk & 7) * 32 + (c & 31)) * 2; }
__device__ __forceinline__ int v_rd_base(int lane) { return ((lane & 3) << 3) | (((lane >> 2) & 3) << 6) | (((lane >> 4) & 1) << 5) | (((lane >> 5) & 1) << 8); }
constexpr int v_rd_off(int d0, int ks, int half) { return d0 * 512 + ks * 4096 + half * 2048; }
template <int OFF> __device__ __forceinline__ s16x4 tr_read(int vb) {
  s16x4 r; asm volatile("ds_read_b64_tr_b16 %0, %1 offset:%2" : "=&v"(r) : "v"(vb), "i"(OFF) : "memory"); return r;
}
template <int D0> __device__ __forceinline__ void pv_one(f32x16& od, int vb, bf16x8 pa0, bf16x8 pa1, bf16x8 pa2, bf16x8 pa3) {
  const s16x4 l0 = tr_read<v_rd_off(D0, 0, 0)>(vb), h0 = tr_read<v_rd_off(D0, 0, 1)>(vb), l1 = tr_read<v_rd_off(D0, 1, 0)>(vb), h1 = tr_read<v_rd_off(D0, 1, 1)>(vb);
  const s16x4 l2 = tr_read<v_rd_off(D0, 2, 0)>(vb), h2 = tr_read<v_rd_off(D0, 2, 1)>(vb), l3 = tr_read<v_rd_off(D0, 3, 0)>(vb), h3 = tr_read<v_rd_off(D0, 3, 1)>(vb);
  asm volatile("s_waitcnt lgkmcnt(0)" ::: "memory"); SBAR();
#define PK(L, H) (bf16x8){L[0], L[1], L[2], L[3], H[0], H[1], H[2], H[3]}
  od = __builtin_amdgcn_mfma_f32_32x32x16_bf16(pa0, PK(l0, h0), od, 0, 0, 0);
  od = __builtin_amdgcn_mfma_f32_32x32x16_bf16(pa1, PK(l1, h1), od, 0, 0, 0);
  od = __builtin_amdgcn_mfma_f32_32x32x16_bf16(pa2, PK(l2, h2), od, 0, 0, 0);
  od = __builtin_amdgcn_mfma_f32_32x32x16_bf16(pa3, PK(l3, h3), od, 0, 0, 0);
#undef PK
}
__device__ __forceinline__ void pv_d0(f32x16* o, int vb, bf16x8 pa0, bf16x8 pa1, bf16x8 pa2, bf16x8 pa3) {
  pv_one<0>(o[0], vb, pa0, pa1, pa2, pa3); pv_one<1>(o[1], vb, pa0, pa1, pa2, pa3); pv_one<2>(o[2], vb, pa0, pa1, pa2, pa3); pv_one<3>(o[3], vb, pa0, pa1, pa2, pa3);
}
__device__ __forceinline__ void attn_body(const bf16_t* __restrict__ Qb, const bf16_t* __restrict__ Kh, const bf16_t* __restrict__ Vh,
                                          bf16_t* __restrict__ Ob, int seq, char* lds) {
  const int tid = ltid(), wid = tid >> 6, lane = tid & 63, r32 = lane & 31, hi = lane >> 5;
  bf16_t* V_lds = (bf16_t*)lds; bf16_t* K_lds = (bf16_t*)(lds + 2 * SHM_V);
  float* ws = (float*)(lds + 2 * SHM_V + 2 * SHM_K) + wid * 64; float* li_l = ws; float* al_l = ws + 32;
  float m_reg = -1e30f, l_reg = 0; f32x16 o[4] = {}; bf16x8 qr[NQREG];
  const bf16_t* Qw = Qb + (long)(wid * QBLK + r32) * LDQ + hi * 8;
  bf16x8* qrl = (bf16x8*)(lds + SHM_QR) + wid * ((12 - NQREG) * 64) + lane;
#pragma unroll
  for (int d0 = 0; d0 < NQREG; ++d0) qr[d0] = *reinterpret_cast<const bf16x8*>(Qw + d0 * 16);
#pragma unroll
  for (int d0 = NQREG; d0 < 12; ++d0) qrl[(d0 - NQREG) * 64] = *reinterpret_cast<const bf16x8*>(Qw + d0 * 16);
  const int sr = tid >> 4, sc = (tid & 15) * 8, vst0 = v_st(sr, sc), vst1 = v_st(32 + sr, sc);
  const int kc0 = tid, kc1 = tid + 512, kc2 = tid + 1024;
  const int kr0 = kc0 / 24, kr1 = kc1 / 24, kr2 = kc2 / 24, ke0 = (kc0 % 24) * 8, ke1 = (kc1 % 24) * 8, ke2 = (kc2 % 24) * 8;
  const int kw0 = KSWZ(kr0, ke0 * 2), kw1 = KSWZ(kr1, ke1 * 2), kw2 = KSWZ(kr2, ke2 * 2);
  const int vb0 = (int)(uintptr_t)V_lds + v_rd_base(lane);
  struct { bf16x8 vs0, vs1, ks0, ks1, ks2; } sr_[SDEPTH];
#define SLOAD(i, k0) do { sr_[i].vs0 = *(const bf16x8*)(&Vh[(long)((k0) + sr) * LDVV + sc]); sr_[i].vs1 = *(const bf16x8*)(&Vh[(long)((k0) + 32 + sr) * LDVV + sc]); \
    { const char* kt_ = (const char*)Kh + (size_t)(k0) * 384; sr_[i].ks0 = *(const bf16x8*)(kt_ + tid * 16); sr_[i].ks1 = *(const bf16x8*)(kt_ + 8192 + tid * 16); \
    sr_[i].ks2 = *(const bf16x8*)(kt_ + 16384 + tid * 16); } } while (0)
#define SWRITE(b, i) do { *(bf16x8*)((char*)V_lds + (b) * SHM_V + vst0) = sr_[i].vs0;          \
    *(bf16x8*)((char*)V_lds + (b) * SHM_V + vst1) = sr_[i].vs1;               \
    *(bf16x8*)((char*)K_lds + (b) * SHM_K + kw0) = sr_[i].ks0;                       \
    *(bf16x8*)((char*)K_lds + (b) * SHM_K + kw1) = sr_[i].ks1;                       \
    *(bf16x8*)((char*)K_lds + (b) * SHM_K + kw2) = sr_[i].ks2; } while (0)
#define SWAIT() do { if constexpr (SDEPTH == 2) asm volatile("s_waitcnt vmcnt(5)" ::: "memory"); else asm volatile("s_waitcnt vmcnt(0)" ::: "memory"); } while (0)
#define RESC(a) do { if (__any((a) < 1.f)) { if (hi == 0) al_l[r32] = (a); asm volatile("s_waitcnt lgkmcnt(0)" ::: "memory"); \
    for (int d = 0; d < 4; ++d) for (int r = 0; r < 16; ++r) o[d][r] *= al_l[crow(r, hi)]; } } while (0)
  f32x16 pA0, pA1, pB0, pB1; float mnA, mnB, alA, alB; bf16x8 pa0, pa1, pa2, pa3; const int NT = seq / KVBLK;
  constexpr int SE = 0, SO = SDEPTH - 1;
  SLOAD(SE, 0); asm volatile("s_waitcnt vmcnt(0)" ::: "memory"); SWRITE(0, SE); __syncthreads();
  qkt(pA0, pA1, K_lds, qr, qrl, r32, hi); partialSM(pA0, pA1, m_reg, mnA, alA);
  SLOAD(SO, KVBLK); if constexpr (SDEPTH == 2) { if (2 < NT) SLOAD(SE, 2 * KVBLK); }
  SWAIT(); SWRITE(1, SO); __syncthreads();
  for (int j = 1; j + 1 < NT; j += 2) {
    SBAR(); qkt(pB0, pB1, (bf16_t*)((char*)K_lds + SHM_K), qr, qrl, r32, hi);
    finishSM(pA0, pA1, alA, l_reg, pa0, pa1, pa2, pa3); SBAR();
    SLOAD(SO, (j + SDEPTH) * KVBLK); SBAR();
    pv_d0(o, vb0, pa0, pa1, pa2, pa3); partialSM(pB0, pB1, m_reg, mnB, alB);
    __syncthreads(); SWAIT(); SWRITE(0, SE);
    RESC(alB); __syncthreads();
    SBAR(); qkt(pA0, pA1, K_lds, qr, qrl, r32, hi);
    finishSM(pB0, pB1, alB, l_reg, pa0, pa1, pa2, pa3); SBAR();
    if (SDEPTH == 1 || j + 3 < NT) SLOAD(SE, (j + 1 + SDEPTH) * KVBLK); SBAR();
    pv_d0(o, vb0 + (int)SHM_V, pa0, pa1, pa2, pa3); partialSM(pA0, pA1, m_reg, mnA, alA);
    __syncthreads(); SWAIT(); SWRITE(1, SO);
    RESC(alA); __syncthreads();
  }
  SBAR(); qkt(pB0, pB1, (bf16_t*)((char*)K_lds + SHM_K), qr, qrl, r32, hi);
  finishSM(pA0, pA1, alA, l_reg, pa0, pa1, pa2, pa3); SBAR();
  pv_d0(o, vb0, pa0, pa1, pa2, pa3); partialSM(pB0, pB1, m_reg, mnB, alB);
  __syncthreads(); RESC(alB);
  finishSM(pB0, pB1, alB, l_reg, pa0, pa1, pa2, pa3); SBAR();
  pv_d0(o, vb0 + (int)SHM_V, pa0, pa1, pa2, pa3);
  if (hi == 0) li_l[r32] = l_reg; asm volatile("s_waitcnt lgkmcnt(0)" ::: "memory");
  float rli[16];
#pragma unroll
  for (int r = 0; r < 16; ++r) rli[r] = __builtin_amdgcn_rcpf(li_l[crow(r, hi)]);
  bf16_t* Ow = Ob + (long)(wid * QBLK) * LDO;
#pragma unroll
  for (int r = 0; r < 16; ++r) { int orow = crow(r, hi);
    for (int d0 = 0; d0 < 4; ++d0) Ow[(long)orow * LDO + d0 * 32 + r32] = f2bf(o[d0][r] * rli[r]); }
  asm volatile("s_waitcnt vmcnt(0)" ::: "memory");
  __syncthreads();
#undef SLOAD
#undef SWRITE
#undef SWAIT
#undef RESC
}
}

template <int K, int NT>
__device__ __forceinline__ void mma_tile(f32x4 (&acc)[4][NT], const LAS bf16_t* A, int lda, const LAS bf16_t* Bt, int ldb, int wr, int wc, int fr, int fq) {
#pragma unroll 1
    for (int k0 = 0; k0 < K; k0 += 32) {
        bf16x8 a[4], b[NT];
#pragma unroll
        for (int m = 0; m < 4; ++m) a[m] = *(const LAS bf16x8*)(A + (64 * wr + 16 * m + fr) * lda + k0 + fq * 8);
#pragma unroll
        for (int n = 0; n < NT; ++n) b[n] = *(const LAS bf16x8*)(Bt + (16 * NT * wc + 16 * n + fr) * ldb + k0 + fq * 8);
#pragma unroll
        for (int m = 0; m < 4; ++m)
#pragma unroll
            for (int n = 0; n < NT; ++n) acc[m][n] = __builtin_amdgcn_mfma_f32_16x16x32_bf16(a[m], b[n], acc[m][n], 0, 0, 0);
    }
}
template <int NT> __device__ __forceinline__ void zero_acc(f32x4 (&acc)[4][NT]) {
#pragma unroll
    for (int m = 0; m < 4; ++m)
#pragma unroll
        for (int n = 0; n < NT; ++n) acc[m][n] = (f32x4){0.f, 0.f, 0.f, 0.f};
}
template <int R, int C> __device__ __forceinline__ void stage_N(LAS bf16_t* dst, int ld, const bf16_t* __restrict__ src, size_t ldg) {
    constexpr int CH = C / 8;
    for (int idx = ltid(); idx < R * CH; idx += 512) { const int r = idx / CH, c = (idx % CH) * 8;
        *(LAS u32x4*)(dst + r * ld + c) = *(const u32x4*)(src + (size_t)r * ldg + c); }
}
template <int C, bool SCL> __device__ __forceinline__ void stage_T(LAS bf16_t* dst, int ld, const bf16_t* __restrict__ src, size_t ldg, const LAS float* sc) {
    for (int idx = ltid(); idx < 128 * (C / 8); idx += 512) { const int r = idx & 127, c0 = (idx >> 7) * 8;
        const u32x4 w = *(const u32x4*)(src + (size_t)r * ldg + c0); float f[8]; unpack8(w, f);
        float s = 1.f; if (SCL) s = sc[r];
#pragma unroll
        for (int i = 0; i < 8; ++i) dst[(c0 + i) * ld + r] = f2bf(f[i] * s); }
}
template <int R, int C> __device__ __forceinline__ void ld_N(u32x4 (&r)[R * C / 8 / 512], const bf16_t* __restrict__ src, size_t ldg, int tid) {
    constexpr int CH = C / 8;
#pragma unroll
    for (int i = 0; i < R * CH / 512; ++i) { const int idx = tid + 512 * i, rr = idx / CH, c = (idx % CH) * 8; r[i] = *(const u32x4*)(src + (size_t)rr * ldg + c); }
}
template <int R, int C> __device__ __forceinline__ void st_N(LAS bf16_t* dst, int ld, const u32x4 (&r)[R * C / 8 / 512], int tid) {
    constexpr int CH = C / 8;
#pragma unroll
    for (int i = 0; i < R * CH / 512; ++i) { const int idx = tid + 512 * i, rr = idx / CH, c = (idx % CH) * 8; *(LAS u32x4*)(dst + rr * ld + c) = r[i]; }
}
template <int C> __device__ __forceinline__ void ld_T(u32x4 (&r)[128 * C / 8 / 512], const bf16_t* __restrict__ src, size_t ldg, int tid) {
#pragma unroll
    for (int i = 0; i < 128 * C / 8 / 512; ++i) { const int idx = tid + 512 * i, rr = idx & 127, c0 = (idx >> 7) * 8; r[i] = *(const u32x4*)(src + (size_t)rr * ldg + c0); }
}
template <int C, bool SCL> __device__ __forceinline__ void st_T(LAS bf16_t* dst, int ld, const u32x4 (&r)[128 * C / 8 / 512], const LAS float* sc, int tid) {
#pragma unroll
    for (int i = 0; i < 128 * C / 8 / 512; ++i) { const int idx = tid + 512 * i, rr = idx & 127, c0 = (idx >> 7) * 8;
        if (SCL) { float f[8]; unpack8(r[i], f); const float sv = sc[rr];
#pragma unroll
            for (int k = 0; k < 8; ++k) dst[(c0 + k) * ld + rr] = f2bf(f[k] * sv); }
        else { const unsigned w[4] = {r[i].x, r[i].y, r[i].z, r[i].w};
#pragma unroll
            for (int k = 0; k < 4; ++k) { dst[(c0 + 2 * k) * ld + rr] = (bf16_t)(w[k] & 0xffffu); dst[(c0 + 2 * k + 1) * ld + rr] = (bf16_t)(w[k] >> 16); } } }
}
__device__ __forceinline__ float scan_add64(float v, int lane) {
#pragma unroll
    for (int o = 1; o < 64; o <<= 1) { const float t = __shfl_up(v, o); if (lane >= o) v += t; } return v; }
__device__ __forceinline__ float scan_max64(float v, int lane) {
#pragma unroll
    for (int o = 1; o < 64; o <<= 1) { const float t = __shfl_up(v, o); if (lane >= o) v = fmaxf(v, t); } return v; }

constexpr int CB0 = 0, CB1 = 34816, CB2 = 69632, CB3 = 104448, CVEC = 139264;
constexpr int RQB = 0, RKB = 18432, RST_ = 36864, RVT = 71680, RRT = 106496;

struct Bufs {
    bf16_t *Wl, *H, *Y, *QKML, *RQK, *CQN, *CKVN, *CST, *RST, *PROJ, *Q, *K, *V, *ACT;
    float *X, *RC, *RS, *G, *CLOC, *NLOC, *NST, *MLOC, *BLAST, *MST, *RLOC;
};

__device__ __forceinline__ void mlstm_local(const Bufs& B, int item, LAS unsigned char* lds) {
    const int tid = ltid(), wid = tid >> 6, lane = tid & 63, wr = wid >> 2, wc = wid & 3, fr = lane & 15, fq = lane >> 4;
    const int c = item & 63, h = (item >> 6) & 3, dir = item >> 8, s0 = c * 128;
    LAS bf16_t* T0 = (LAS bf16_t*)(lds + CB0); LAS bf16_t* T1 = (LAS bf16_t*)(lds + CB1); LAS float* ve = (LAS float*)(lds + CVEC);
    u32x4 rk[4], rv[4];
    ld_T<128>(rk, B.QKML + (size_t)s0 * 1024 + 512 + h * 128, 1024, tid);
    ld_T<128>(rv, B.PROJ + (size_t)s0 * NPROJP + PC_MLV + h * 128, NPROJP, tid);
    if (wid == 0) {
        const int l0 = 2 * lane, l1 = l0 + 1, p0 = dir ? 127 - l0 : l0, p1 = dir ? 127 - l1 : l1, gi = 8 * dir + h, gf = gi + 4;
        const float li0 = B.G[(size_t)(s0 + p0) * 16 + gi], lf0 = B.G[(size_t)(s0 + p0) * 16 + gf], li1 = B.G[(size_t)(s0 + p1) * 16 + gi], lf1 = B.G[(size_t)(s0 + p1) * 16 + gf];
        const float t = lf0 + lf1, incl = scan_add64(t, lane), b0 = incl - t + lf0, b1 = incl, btot = __shfl(incl, 63);
        const float w0 = btot - b0 + li0, w1 = btot - b1 + li1, mloc = wave_max(fmaxf(w0, w1));
        ve[p0] = __expf(w0 - mloc); ve[p1] = __expf(w1 - mloc);
        if (lane == 0) { B.MLOC[item] = mloc; B.BLAST[item] = btot; }
    }
    st_T<128, false>(T0, 136, rk, ve, tid);
    __syncthreads();
    st_T<128, true>(T1, 136, rv, ve, tid);
    __syncthreads();
    f32x4 acc[4][2]; zero_acc<2>(acc);
    mma_tile<128, 2>(acc, T1, 136, T0, 136, wr, wc, fr, fq);
    float* dst = B.CLOC + (size_t)item * 16384;
#pragma unroll
    for (int m = 0; m < 4; ++m)
#pragma unroll
        for (int n = 0; n < 2; ++n)
#pragma unroll
            for (int j = 0; j < 4; ++j) dst[(64 * wr + 16 * m + 4 * fq + j) * 128 + 32 * wc + 16 * n + fr] = acc[m][n][j];
    { const int dk = tid >> 2, qd = tid & 3; float s = 0.f;
#pragma unroll
        for (int i = 0; i < 4; ++i) { float kv[8]; unpack8(*(const LAS u32x4*)(T0 + dk * 136 + qd * 32 + i * 8), kv);
#pragma unroll
            for (int k = 0; k < 8; ++k) s += kv[k] * ve[qd * 32 + i * 8 + k]; }
        s += __shfl_xor(s, 1); s += __shfl_xor(s, 2);
        if (qd == 0) B.NLOC[(size_t)item * 128 + dk] = s; }
    __syncthreads();
}

__device__ __forceinline__ void ret_local(const Bufs& B, int item, LAS unsigned char* lds) {
    const int tid = ltid(), wid = tid >> 6, lane = tid & 63, wr = wid >> 2, wc = wid & 3, fr = lane & 15, fq = lane >> 4;
    const int c = item & 63, h = (item >> 6) & 3, dir = item >> 8, s0 = c * 128, hd = dir ? 3 - h : h;
    const float lg = log1pf(-exp2f(-5.f - (float)hd));
    LAS bf16_t* T0 = (LAS bf16_t*)(lds + CB0); LAS bf16_t* T1 = (LAS bf16_t*)(lds + CB1); LAS float* vz = (LAS float*)(lds + CVEC);
    u32x4 rk[2], rv[4];
    ld_T<64>(rk, B.RQK + (size_t)s0 * 512 + 256 + h * 64, 512, tid);
    ld_T<128>(rv, B.PROJ + (size_t)s0 * NPROJP + PC_RV + h * 128, NPROJP, tid);
    if (tid < 128) { const int lp = dir ? 127 - tid : tid; vz[tid] = __expf((float)(127 - lp) * lg); }
    st_T<64, false>(T0, 136, rk, vz, tid);
    __syncthreads();
    st_T<128, true>(T1, 136, rv, vz, tid);
    __syncthreads();
    f32x4 acc[4][1]; zero_acc<1>(acc);
    mma_tile<128, 1>(acc, T1, 136, T0, 136, wr, wc, fr, fq);
    float* dst = B.RLOC + (size_t)item * 8192;
#pragma unroll
    for (int m = 0; m < 4; ++m)
#pragma unroll
        for (int j = 0; j < 4; ++j) dst[(64 * wr + 16 * m + 4 * fq + j) * 64 + 16 * wc + fr] = acc[m][0][j];
    __syncthreads();
}

__device__ __forceinline__ void scan_phase(const Bufs& B) {
    const int gt = lbid() * 512 + ltid();
    if (gt < 131072) {
        const int dh = gt >> 14, idx = gt & 16383, dir = dh >> 2;
        float cst = 0.f, nst = 0.f, m = -1e30f;
#pragma unroll 1
        for (int s0 = 0; s0 < 64; s0 += 16) {
            float cl[16], ml[16], bl[16], nl[16];
#pragma unroll
            for (int u = 0; u < 16; ++u) { const int ch = dir ? 63 - (s0 + u) : s0 + u, it = dh * 64 + ch;
                cl[u] = B.CLOC[(size_t)it * 16384 + idx]; ml[u] = B.MLOC[it]; bl[u] = B.BLAST[it]; nl[u] = idx < 128 ? B.NLOC[(size_t)it * 128 + idx] : 0.f; }
#pragma unroll
            for (int u = 0; u < 16; ++u) { const int ch = dir ? 63 - (s0 + u) : s0 + u, it = dh * 64 + ch;
                B.CST[(size_t)it * 16384 + idx] = f2bf(cst);
                if (idx < 128) { B.NST[(size_t)it * 128 + idx] = nst; if (idx == 0) B.MST[it] = m; }
                const float mnew = fmaxf(bl[u] + m, ml[u]), a = __expf(bl[u] + m - mnew), g = __expf(ml[u] - mnew);
                cst = a * cst + g * cl[u]; nst = a * nst + g * nl[u]; m = mnew; }
        }
    }
    if (gt < 65536) {
        const int dh = gt >> 13, idx = gt & 8191, dir = dh >> 2, h = dh & 3, hd = dir ? 3 - h : h;
        const float cd = __expf(128.f * log1pf(-exp2f(-5.f - (float)hd)));
        float r = 0.f;
#pragma unroll 1
        for (int s0 = 0; s0 < 64; s0 += 16) {
            float rl[16];
#pragma unroll
            for (int u = 0; u < 16; ++u) { const int ch = dir ? 63 - (s0 + u) : s0 + u; rl[u] = B.RLOC[(size_t)(dh * 64 + ch) * 8192 + idx]; }
#pragma unroll
            for (int u = 0; u < 16; ++u) { const int ch = dir ? 63 - (s0 + u) : s0 + u; B.RST[(size_t)(dh * 64 + ch) * 8192 + idx] = f2bf(r); r = cd * r + rl[u]; }
        }
    }
}

__device__ __forceinline__ void mlstm_out(const Bufs& B, const float* __restrict__ g_out, int item, LAS unsigned char* lds) {
    const int tid = ltid(), wid = tid >> 6, lane = tid & 63, wr = wid >> 2, wc = wid & 3, fr = lane & 15, fq = lane >> 4;
    const int c = item >> 2, h = item & 3, s0 = c * 128;
    constexpr float SC = 0.08838834764831845f;
    LAS bf16_t* T0 = (LAS bf16_t*)(lds + CB0); LAS bf16_t* T1 = (LAS bf16_t*)(lds + CB1); LAS bf16_t* T2 = (LAS bf16_t*)(lds + CB2); LAS bf16_t* T3 = (LAS bf16_t*)(lds + CB3);
    LAS float* vea = (LAS float*)(lds + CVEC); LAS float* veM = vea + 256; LAS float* vedn = vea + 512; LAS float* vn = vea + 768; LAS float* vqn = vea + 1024;
    LAS float* vrs = vea + 1280; LAS float* vf = vea + 1408; LAS float* vsc = vea + 1536;
    LAS float* HT = (LAS float*)(lds + CB1);
    const float mst0 = B.MST[(0 * 4 + h) * 64 + c], mst1 = B.MST[(1 * 4 + h) * 64 + c];
    { u32x4 rq[4], rk[4], rv[4], rc[4];
        ld_N<128, 128>(rq, B.QKML + (size_t)s0 * 1024 + h * 128, 1024, tid);
        ld_N<128, 128>(rk, B.QKML + (size_t)s0 * 1024 + 512 + h * 128, 1024, tid);
        ld_T<128>(rv, B.PROJ + (size_t)s0 * NPROJP + PC_MLV + h * 128, NPROJP, tid);
        ld_N<128, 128>(rc, B.CST + (size_t)((0 * 4 + h) * 64 + c) * 16384, 128, tid);
        st_N<128, 128>(T0, 136, rq, tid); st_N<128, 128>(T1, 136, rk, tid); st_T<128, false>(T2, 136, rv, vea, tid); st_N<128, 128>(T3, 136, rc, tid); }
    if (wid < 2) {
        const int dir = wid; const float mst = dir ? mst1 : mst0;
        const int l0 = 2 * lane, l1 = l0 + 1, p0 = dir ? 127 - l0 : l0, p1 = dir ? 127 - l1 : l1, gi = 8 * dir + h, gf = gi + 4;
        const float li0 = B.G[(size_t)(s0 + p0) * 16 + gi], lf0 = B.G[(size_t)(s0 + p0) * 16 + gf], li1 = B.G[(size_t)(s0 + p1) * 16 + gi], lf1 = B.G[(size_t)(s0 + p1) * 16 + gf];
        const float t = lf0 + lf1, incl = scan_add64(t, lane), b0 = incl - t + lf0, b1 = incl;
        const float a0 = li0 - b0, a1 = li1 - b1, inm = scan_max64(fmaxf(a0, a1), lane);
        float exm = __shfl_up(inm, 1); if (lane == 0) exm = -3.0e38f;
        const float A0 = fmaxf(exm, a0), A1 = inm, amax = __shfl(inm, 63), cc = fmaxf(amax, mst);
        const float M0 = fmaxf(A0, mst), M1 = fmaxf(A1, mst);
        vea[dir * 128 + p0] = __expf(a0 - cc); vea[dir * 128 + p1] = __expf(a1 - cc);
        veM[dir * 128 + p0] = __expf(cc - M0) * SC; veM[dir * 128 + p1] = __expf(cc - M1) * SC;
        vedn[dir * 128 + p0] = __expf(-(b0 + M0)); vedn[dir * 128 + p1] = __expf(-(b1 + M1));
        if (lane == 0) vsc[dir] = __expf(mst - cc);
    }
    if (tid < 256) { const int dir = tid >> 7, d = tid & 127; vn[tid] = B.NST[(size_t)((dir * 4 + h) * 64 + c) * 128 + d]; }
    __syncthreads();
    f32x4 accS[4][2]; zero_acc<2>(accS);
    mma_tile<128, 2>(accS, T1, 136, T0, 136, wr, wc, fr, fq);
    { const int row = tid >> 2, qd = tid & 3; float q0 = 0.f, q1 = 0.f;
#pragma unroll
        for (int i = 0; i < 4; ++i) { float qv[8]; unpack8(*(const LAS u32x4*)(T0 + row * 136 + qd * 32 + i * 8), qv);
            const f32x4 n0a = *(const LAS f32x4*)(vn + qd * 32 + i * 8), n0b = *(const LAS f32x4*)(vn + qd * 32 + i * 8 + 4);
            const f32x4 n1a = *(const LAS f32x4*)(vn + 128 + qd * 32 + i * 8), n1b = *(const LAS f32x4*)(vn + 128 + qd * 32 + i * 8 + 4);
#pragma unroll
            for (int k = 0; k < 4; ++k) { q0 += qv[k] * n0a[k] + qv[4 + k] * n0b[k]; q1 += qv[k] * n1a[k] + qv[4 + k] * n1b[k]; } }
        q0 += __shfl_xor(q0, 1); q0 += __shfl_xor(q0, 2); q1 += __shfl_xor(q1, 1); q1 += __shfl_xor(q1, 2);
        if (qd == 0) { vqn[row] = q0; vqn[128 + row] = q1; } }
    __syncthreads();
    f32x4 hacc[4][2]; zero_acc<2>(hacc);
    u32x4 rc1[4]; ld_N<128, 128>(rc1, B.CST + (size_t)((1 * 4 + h) * 64 + c) * 16384, 128, tid);
#pragma unroll 1
    for (int dir = 0; dir < 2; ++dir) {
        if (dir == 1) st_N<128, 128>(T3, 136, rc1, tid);
        const float r = vsc[dir];
#pragma unroll
        for (int m = 0; m < 4; ++m)
#pragma unroll
            for (int n = 0; n < 2; ++n) { const int l = 32 * wc + 16 * n + fr, sb = 64 * wr + 16 * m + 4 * fq;
                const f32x4 e4 = *(const LAS f32x4*)(vea + dir * 128 + sb); float v[4];
#pragma unroll
                for (int j = 0; j < 4; ++j) { const int s = sb + j; const bool ok = dir ? (s >= l) : (s <= l); v[j] = ok ? accS[m][n][j] * e4[j] : 0.f; }
                u32x2 w; w.x = cvt_pk_bf16(v[0], v[1]); w.y = cvt_pk_bf16(v[2], v[3]);
                *(LAS u32x2*)(T1 + l * 136 + sb) = w; }
        __syncthreads();
        { const int row = tid >> 2, qd = tid & 3; float s = 0.f;
#pragma unroll
            for (int i = 0; i < 4; ++i) { float sv[8]; unpack8(*(const LAS u32x4*)(T1 + row * 136 + qd * 32 + i * 8), sv);
#pragma unroll
                for (int k = 0; k < 8; ++k) s += sv[k]; }
            s += __shfl_xor(s, 1); s += __shfl_xor(s, 2);
            if (qd == 0) { const float eM = veM[dir * 128 + row], den = eM * (s + r * vqn[dir * 128 + row]);
                vf[row] = eM / fmaxf(fabsf(den), vedn[dir * 128 + row]); } }
        f32x4 accN[4][2]; zero_acc<2>(accN);
        mma_tile<128, 2>(accN, T0, 136, T3, 136, wr, wc, fr, fq);
#pragma unroll
        for (int m = 0; m < 4; ++m)
#pragma unroll
            for (int n = 0; n < 2; ++n) accN[m][n] *= r;
        mma_tile<128, 2>(accN, T1, 136, T2, 136, wr, wc, fr, fq);
        __syncthreads();
#pragma unroll
        for (int m = 0; m < 4; ++m) { const f32x4 f4 = *(const LAS f32x4*)(vf + 64 * wr + 16 * m + 4 * fq);
#pragma unroll
            for (int n = 0; n < 2; ++n) hacc[m][n] += accN[m][n] * f4; }
        __syncthreads();
    }
    const int erow = tid >> 2, eqd = tid & 3, es = s0 + erow;
    u32x4 og4[4]; f32x4 gp4[8];
    { const bf16_t* og = B.PROJ + (size_t)es * NPROJP + PC_MLO + h * 128 + eqd * 32; const float* gp = g_out + h * 128 + eqd * 32;
#pragma unroll
        for (int i = 0; i < 4; ++i) og4[i] = *(const u32x4*)(og + i * 8);
#pragma unroll
        for (int i = 0; i < 8; ++i) gp4[i] = *(const f32x4*)(gp + i * 4); }
#pragma unroll
    for (int m = 0; m < 4; ++m)
#pragma unroll
        for (int n = 0; n < 2; ++n)
#pragma unroll
            for (int j = 0; j < 4; ++j) HT[(64 * wr + 16 * m + 4 * fq + j) * 132 + 32 * wc + 16 * n + fr] = hacc[m][n][j];
    __syncthreads();
    { float ssq = 0.f; f32x4 x4[8];
#pragma unroll
        for (int i = 0; i < 8; ++i) { x4[i] = *(const LAS f32x4*)(HT + erow * 132 + eqd * 32 + i * 4);
            ssq += x4[i][0] * x4[i][0] + x4[i][1] * x4[i][1] + x4[i][2] * x4[i][2] + x4[i][3] * x4[i][3]; }
        ssq += __shfl_xor(ssq, 1); ssq += __shfl_xor(ssq, 2);
        const float rstd = rsqrtf(ssq * (1.f / 128.f) + EPS_);
        bf16_t* yo = B.Y + (size_t)es * DM + h * 128 + eqd * 32;
#pragma unroll
        for (int i = 0; i < 4; ++i) { float o8[8]; unpack8(og4[i], o8); float r8[8];
#pragma unroll
            for (int k = 0; k < 8; ++k) { const float sg = __builtin_amdgcn_rcpf(1.f + __expf(-o8[k])); r8[k] = sg * x4[2 * i + (k >> 2)][k & 3] * rstd * gp4[2 * i + (k >> 2)][k & 3]; }
            *(u32x4*)(yo + i * 8) = pack8(r8); } }
    __syncthreads();
}

__device__ __forceinline__ void ret_out(const Bufs& B, const float* __restrict__ g_out, int item, LAS unsigned char* lds) {
    const int tid = ltid(), wid = tid >> 6, lane = tid & 63, wr = wid >> 2, wc = wid & 3, fr = lane & 15, fq = lane >> 4;
    const int c = item >> 2, h = item & 3, s0 = c * 128;
    LAS bf16_t* QB = (LAS bf16_t*)(lds + RQB); LAS bf16_t* KB = (LAS bf16_t*)(lds + RKB); LAS bf16_t* ST = (LAS bf16_t*)(lds + RST_); LAS bf16_t* VT = (LAS bf16_t*)(lds + RVT); LAS bf16_t* RT = (LAS bf16_t*)(lds + RRT);
    LAS float* HT = (LAS float*)(lds + RST_); LAS float* vcs = (LAS float*)(lds + CVEC); LAS float* vrw = vcs + 256;
    u32x4 rr1[2];
    { u32x4 rq[2], rk[2], rv[4], rr0[2];
        ld_N<128, 64>(rq, B.RQK + (size_t)s0 * 512 + h * 64, 512, tid);
        ld_N<128, 64>(rk, B.RQK + (size_t)s0 * 512 + 256 + h * 64, 512, tid);
        ld_T<128>(rv, B.PROJ + (size_t)s0 * NPROJP + PC_RV + h * 128, NPROJP, tid);
        ld_N<128, 64>(rr0, B.RST + (size_t)((0 * 4 + h) * 64 + c) * 8192, 64, tid);
        ld_N<128, 64>(rr1, B.RST + (size_t)((1 * 4 + h) * 64 + c) * 8192, 64, tid);
        st_N<128, 64>(QB, 72, rq, tid); st_N<128, 64>(KB, 72, rk, tid); st_T<128, false>(VT, 136, rv, HT, tid); st_N<128, 64>(RT, 72, rr0, tid); }
    if (tid < 256) { const int dir = tid >> 7, p = tid & 127, lp = dir ? 127 - p : p, hd = dir ? 3 - h : h; const float lg = log1pf(-exp2f(-5.f - (float)hd));
        vcs[tid] = __expf(-(float)lp * lg); vrw[tid] = __expf((float)lp * lg); }
    __syncthreads();
    f32x4 accS[4][2]; zero_acc<2>(accS);
    mma_tile<64, 2>(accS, KB, 72, QB, 72, wr, wc, fr, fq);
    f32x4 yacc[4][2]; zero_acc<2>(yacc);
#pragma unroll 1
    for (int dir = 0; dir < 2; ++dir) {
        const int hd = dir ? 3 - h : h; const float gam = 1.f - exp2f(-5.f - (float)hd);
        if (dir == 1) st_N<128, 64>(RT, 72, rr1, tid);
#pragma unroll
        for (int m = 0; m < 4; ++m)
#pragma unroll
            for (int n = 0; n < 2; ++n) { const int l = 32 * wc + 16 * n + fr, sb = 64 * wr + 16 * m + 4 * fq;
                const f32x4 c4 = *(const LAS f32x4*)(vcs + dir * 128 + sb); float v[4];
#pragma unroll
                for (int j = 0; j < 4; ++j) { const int s = sb + j; const bool ok = dir ? (s >= l) : (s <= l); v[j] = ok ? accS[m][n][j] * c4[j] : 0.f; }
                u32x2 w; w.x = cvt_pk_bf16(v[0], v[1]); w.y = cvt_pk_bf16(v[2], v[3]);
                *(LAS u32x2*)(ST + l * 136 + sb) = w; }
        __syncthreads();
        f32x4 accR[4][2]; zero_acc<2>(accR);
        mma_tile<64, 2>(accR, QB, 72, RT, 72, wr, wc, fr, fq);
#pragma unroll
        for (int m = 0; m < 4; ++m)
#pragma unroll
            for (int n = 0; n < 2; ++n) accR[m][n] *= gam;
        mma_tile<128, 2>(accR, ST, 136, VT, 136, wr, wc, fr, fq);
        __syncthreads();
#pragma unroll
        for (int m = 0; m < 4; ++m) { const f32x4 r4 = *(const LAS f32x4*)(vrw + dir * 128 + 64 * wr + 16 * m + 4 * fq);
#pragma unroll
            for (int n = 0; n < 2; ++n) yacc[m][n] += accR[m][n] * r4; }
    }
    const int erow = tid >> 2, eqd = tid & 3, es = s0 + erow;
    u32x4 og4[4]; f32x4 gp4[8];
    { const bf16_t* gg = B.PROJ + (size_t)es * NPROJP + PC_RG + h * 128 + eqd * 32; const float* gp = g_out + h * 128 + eqd * 32;
#pragma unroll
        for (int i = 0; i < 4; ++i) og4[i] = *(const u32x4*)(gg + i * 8);
#pragma unroll
        for (int i = 0; i < 8; ++i) gp4[i] = *(const f32x4*)(gp + i * 4); }
#pragma unroll
    for (int m = 0; m < 4; ++m)
#pragma unroll
        for (int n = 0; n < 2; ++n)
#pragma unroll
            for (int j = 0; j < 4; ++j) HT[(64 * wr + 16 * m + 4 * fq + j) * 132 + 32 * wc + 16 * n + fr] = yacc[m][n][j];
    __syncthreads();
    { float ssq = 0.f; f32x4 x4[8];
#pragma unroll
        for (int i = 0; i < 8; ++i) { x4[i] = *(const LAS f32x4*)(HT + erow * 132 + eqd * 32 + i * 4);
            ssq += x4[i][0] * x4[i][0] + x4[i][1] * x4[i][1] + x4[i][2] * x4[i][2] + x4[i][3] * x4[i][3]; }
        ssq += __shfl_xor(ssq, 1); ssq += __shfl_xor(ssq, 2);
        const float rstd = rsqrtf(ssq * (1.f / 128.f) + EPS_);
        bf16_t* yo = B.Y + (size_t)es * DM + 512 + h * 128 + eqd * 32;
#pragma unroll
        for (int i = 0; i < 4; ++i) { float o8[8]; unpack8(og4[i], o8); float r8[8];
#pragma unroll
            for (int k = 0; k < 8; ++k) { const float sl = o8[k] * __builtin_amdgcn_rcpf(1.f + __expf(-o8[k])); r8[k] = sl * x4[2 * i + (k >> 2)][k & 3] * rstd * gp4[2 * i + (k >> 2)][k & 3]; }
            *(u32x4*)(yo + i * 8) = pack8(r8); } }
    __syncthreads();
}

__device__ __forceinline__ int map_col(int n, int mode) {
    if (mode == 1) { const int h = n / 192, d = n % 192; if (d < 128) return h * 128 + d; const int jj = d - 128; return 1024 + h * 64 + 2 * (jj & 31) + (jj >> 5); }
    if (mode == 2) { const int h = n >> 8, d = n & 255; return d < 128 ? h * 128 + d : 1024 + h * 128 + (d - 128); }
    return n;
}
struct CvtTile { const float* W; bf16_t* dst; const float* gk; int K, N, kt, nt, mode; };
constexpr int TILES_L = 576 + 48 + 32 + 256 + 1024 + 1024;
__device__ __forceinline__ CvtTile cvt_get(const Params& p, int t) {
    const int l = t / TILES_L; int r = t % TILES_L; unsigned char* Wl = p.ws + OFF_W + (size_t)l * SZ_WL; CvtTile c; int nT; c.mode = 0; c.gk = nullptr;
    if (r < 576) { c.W = p.w_in + (size_t)l * DM * NPROJ; c.K = DM; c.N = NPROJ; nT = 18; c.dst = (bf16_t*)(Wl + WO_IN); c.gk = p.g_mix + l * DM; }
    else if ((r -= 576) < 48) { c.W = p.w_q_up + (size_t)l * 512 * 1536; c.K = 512; c.N = 1536; nT = 6; c.mode = 1; c.dst = (bf16_t*)(Wl + WO_Q); }
    else if ((r -= 48) < 32) { c.W = p.w_kv_up + (size_t)l * 256 * 2048; c.K = 256; c.N = 2048; nT = 8; c.mode = 2; c.dst = (bf16_t*)(Wl + WO_KV); }
    else if ((r -= 32) < 256) { c.W = p.w_out + (size_t)l * DM * DM; c.K = DM; c.N = DM; nT = 8; c.dst = (bf16_t*)(Wl + WO_OUT); }
    else if ((r -= 256) < 1024) { c.W = p.w_ff1 + (size_t)l * DM * DFF; c.K = DM; c.N = DFF; nT = 32; c.dst = (bf16_t*)(Wl + WO_1); c.gk = p.g_ffn + l * DM; }
    else { r -= 1024; c.W = p.w_ff2 + (size_t)l * DFF * DM; c.K = DFF; c.N = DM; nT = 8; c.dst = (bf16_t*)(Wl + WO_2); }
    c.kt = r / nT; c.nt = r % nT; return c;
}
__device__ __forceinline__ void cvt_load(const CvtTile& c, f32x4 (&v)[8], int tid) {
#pragma unroll
    for (int i = 0; i < 8; ++i) { const int k = (tid >> 6) + 8 * i, gn = c.nt * 256 + (tid & 63) * 4;
        v[i] = (f32x4){0.f, 0.f, 0.f, 0.f};
        if (gn < c.N) { v[i] = __builtin_nontemporal_load((const f32x4*)(c.W + (size_t)(c.kt * 64 + k) * c.N + gn)); if (c.gk) v[i] = v[i] * c.gk[c.kt * 64 + k]; } }
}
__device__ __forceinline__ void convert_phase(const Params& p, LAS unsigned char* lds) {
    LAS float* T = (LAS float*)lds;
    const int tid = ltid(), G = gridDim.x;
    int t = lbid();
    f32x4 v[8]; CvtTile c;
    if (t < NLAYER * TILES_L) { c = cvt_get(p, t); cvt_load(c, v, tid); }
    while (t < NLAYER * TILES_L) {
#pragma unroll
        for (int i = 0; i < 8; ++i) { const int k = (tid >> 6) + 8 * i, n4 = (tid & 63) * 4;
            T[k * 257 + n4] = v[i][0]; T[k * 257 + n4 + 1] = v[i][1]; T[k * 257 + n4 + 2] = v[i][2]; T[k * 257 + n4 + 3] = v[i][3]; }
        __syncthreads();
        const CvtTile cur = c; const int tn = t + G;
        if (tn < NLAYER * TILES_L) { c = cvt_get(p, tn); cvt_load(c, v, tid); }
#pragma unroll
        for (int i = 0; i < 4; ++i) { const int ch = tid + 512 * i, n = ch >> 3, k8 = (ch & 7) * 8, gn = cur.nt * 256 + n;
            if (gn < cur.N) { float f[8];
#pragma unroll
                for (int j = 0; j < 8; ++j) f[j] = T[(k8 + j) * 257 + n];
                *(u32x4*)(cur.dst + (size_t)map_col(gn, cur.mode) * cur.K + cur.kt * 64 + k8) = pack8(f); } }
        __syncthreads();
        t = tn;
    }
    constexpr int PADV = (NPROJP - NPROJ) * DM * 2 / 16;
    for (int i = lbid() * 512 + tid; i < NLAYER * PADV; i += G * 512) { const int l = i / PADV, j = i % PADV;
        ((u32x4*)(p.ws + OFF_W + (size_t)l * SZ_WL + WO_IN + (size_t)NPROJ * DM * 2))[j] = (u32x4){0u, 0u, 0u, 0u}; }
    for (int i = lbid() * 512 + tid; i < S_ * 32; i += G * 512) { const int s = i >> 5, j = i & 31;
        const float inv = powf(10000.f, -(float)j * (1.f / 32.f)); const float ang = (float)p.pos[s] * inv;
        const double a = (double)ang, tw = 6.283185307179586476925; const double r = a - tw * rint(a / tw); const float rf = (float)r;
        ((float*)(p.ws + OFF_ROPE))[i] = __cosf(rf); ((float*)(p.ws + OFF_ROPE))[S_ * 32 + i] = __sinf(rf); }
    { const int wid = tid >> 6, lane = tid & 63; bf16_t* H = (bf16_t*)(p.ws + OFF_H); unsigned long long* ssqa = (unsigned long long*)(p.ws + OFF_SSQA);
        for (int row = lbid() * 8 + wid; row < S_; row += G * 8) { const float* xr = p.x + (size_t)row * DM; float ssq = 0.f;
#pragma unroll
            for (int i = 0; i < 8; ++i) { const int col = (i * 64 + lane) * 4; const f32x4 x = *(const f32x4*)(xr + col);
                ssq += x[0] * x[0] + x[1] * x[1] + x[2] * x[2] + x[3] * x[3];
                u32x2 w; w.x = cvt_pk_bf16(x[0], x[1]); w.y = cvt_pk_bf16(x[2], x[3]); *(u32x2*)(H + (size_t)row * DM + col) = w; }
            ssq = wave_sum(ssq); if (lane == 0) ssqa[row] = (unsigned long long)(ssq * 1048576.f); } }
}

template <int MODE>
__device__ __forceinline__ void rms_phase(const float* __restrict__ src, const float* __restrict__ g, bf16_t* __restrict__ H, float* __restrict__ Xcopy, float* __restrict__ outf) {
    const int wid = ltid() >> 6, lane = ltid() & 63;
    for (int row = lbid() * 8 + wid; row < S_; row += gridDim.x * 8) {
        const float* xr = src + (size_t)row * DM; f32x4 v[8]; float ssq = 0.f;
#pragma unroll
        for (int i = 0; i < 8; ++i) { v[i] = *(const f32x4*)(xr + (i * 64 + lane) * 4); ssq += v[i][0] * v[i][0] + v[i][1] * v[i][1] + v[i][2] * v[i][2] + v[i][3] * v[i][3]; }
        ssq = wave_sum(ssq);
        const float rstd = rsqrtf(ssq * (1.f / DM) + EPS_);
#pragma unroll
        for (int i = 0; i < 8; ++i) { const int col = (i * 64 + lane) * 4; const f32x4 gv = *(const f32x4*)(g + col);
            const f32x4 y = v[i] * rstd * gv;
            if (MODE == 0) { u32x2 w; w.x = cvt_pk_bf16(y[0], y[1]); w.y = cvt_pk_bf16(y[2], y[3]); *(u32x2*)(H + (size_t)row * DM + col) = w;
                if (Xcopy) *(f32x4*)(Xcopy + (size_t)row * DM + col) = v[i]; }
            else *(f32x4*)(outf + (size_t)row * DM + col) = y; }
    }
}

__device__ __forceinline__ void final_phase(const bf16_t* __restrict__ H, const float* __restrict__ g, float* __restrict__ outf) {
    const int tid = ltid(), wid = tid >> 6, lane = tid & 63;
    for (int row = lbid() * 8 + wid; row < S_; row += gridDim.x * 8) {
        float v[32]; float ssq = 0.f;
#pragma unroll
        for (int i = 0; i < 4; ++i) { float f[8]; unpack8(*(const u32x4*)(H + (size_t)row * DM + (i * 64 + lane) * 8), f);
#pragma unroll
            for (int k = 0; k < 8; ++k) { v[i * 8 + k] = f[k]; ssq += f[k] * f[k]; } }
        ssq = wave_sum(ssq);
        const float rstd = rsqrtf(ssq * (1.f / DM) + EPS_);
#pragma unroll
        for (int i = 0; i < 4; ++i) { const int col = (i * 64 + lane) * 8;
#pragma unroll
            for (int q = 0; q < 2; ++q) { const f32x4 gv = *(const f32x4*)(g + col + q * 4); f32x4 y;
#pragma unroll
                for (int k = 0; k < 4; ++k) y[k] = v[i * 8 + q * 4 + k] * rstd * gv[k];
                *(f32x4*)(outf + (size_t)row * DM + col + q * 4) = y; } }
    }
}

__device__ __forceinline__ void prep_phase(const Params& p, const Bufs& B, int l) {
    const int wid = ltid() >> 6, lane = ltid() & 63;
    const float* wconv = p.w_conv + (size_t)l * 3 * 1024; const float* bg = p.b_gates + l * 16;
    const float* gq = p.g_q_norm + l * 512; const float* gkv = p.g_kv_norm + l * 256;
    for (int s = lbid() * 8 + wid; s < S_; s += gridDim.x * 8) {
        const bf16_t* pr = B.PROJ + (size_t)s * NPROJP;
        const u32x4 z4 = (u32x4){0u, 0u, 0u, 0u};
        u32x4 cm[2], cc[2], cp[2];
#pragma unroll
        for (int hf = 0; hf < 2; ++hf) { const int c0 = lane * 16 + hf * 8;
            cm[hf] = s > 0 ? *(const u32x4*)(pr - NPROJP + c0) : z4; cc[hf] = *(const u32x4*)(pr + c0); cp[hf] = s < S_ - 1 ? *(const u32x4*)(pr + NPROJP + c0) : z4; }
        const int tensor = lane >> 5, head = (lane & 31) >> 3, j0 = (lane & 7) * 4, base = PC_RQ + tensor * 256 + head * 64;
        const u32x2 w1 = *(const u32x2*)(pr + base + j0), w2 = *(const u32x2*)(pr + base + 32 + j0);
        const f32x4 rc4 = *(const f32x4*)(B.RC + (size_t)s * 32 + j0), rs4 = *(const f32x4*)(B.RS + (size_t)s * 32 + j0);
        const u32x4 cqv = *(const u32x4*)(pr + PC_CQ + lane * 8); const u32x2 ckvv = *(const u32x2*)(pr + PC_CKV + lane * 4);
        const int l32 = lane & 31, l16 = lane & 15;
        const bf16_t kr1 = pr[PC_KR + l32], kr2 = pr[PC_KR + 32 + l32]; const float krc = B.RC[(size_t)s * 32 + l32], krs = B.RS[(size_t)s * 32 + l32];
        const bf16_t gt = pr[PC_GATE + l16]; const float bgl = bg[l16];
#pragma unroll
        for (int hf = 0; hf < 2; ++hf) { const int c0 = lane * 16 + hf * 8; float xm[8], x0[8], xp[8], r[8];
            unpack8(cm[hf], xm); unpack8(cc[hf], x0); unpack8(cp[hf], xp);
#pragma unroll
            for (int i = 0; i < 8; ++i) { const float v = xm[i] * wconv[c0 + i] + x0[i] * wconv[1024 + c0 + i] + xp[i] * wconv[2048 + c0 + i]; r[i] = v * __builtin_amdgcn_rcpf(1.f + __expf(-v)); }
            *(u32x4*)(B.QKML + (size_t)s * 1024 + c0) = pack8(r); }
        { const float x1[4] = {bflo(w1.x), bfhi(w1.x), bflo(w1.y), bfhi(w1.y)}, x2[4] = {bflo(w2.x), bfhi(w2.x), bflo(w2.y), bfhi(w2.y)};
            const float sc = tensor ? 0.125f : 1.f; float o1[4], o2[4];
#pragma unroll
            for (int i = 0; i < 4; ++i) { o1[i] = (x1[i] * rc4[i] - x2[i] * rs4[i]) * sc; o2[i] = (x2[i] * rc4[i] + x1[i] * rs4[i]) * sc; }
            u32x2 a, b2; a.x = cvt_pk_bf16(o1[0], o1[1]); a.y = cvt_pk_bf16(o1[2], o1[3]); b2.x = cvt_pk_bf16(o2[0], o2[1]); b2.y = cvt_pk_bf16(o2[2], o2[3]);
            bf16_t* d = B.RQK + (size_t)s * 512 + tensor * 256 + head * 64 + j0; *(u32x2*)d = a; *(u32x2*)(d + 32) = b2; }
        { float f[8]; unpack8(cqv, f); float g4[4] = {bflo(ckvv.x), bfhi(ckvv.x), bflo(ckvv.y), bfhi(ckvv.y)};
            float ssq = 0.f, ssk = g4[0] * g4[0] + g4[1] * g4[1] + g4[2] * g4[2] + g4[3] * g4[3];
#pragma unroll
            for (int i = 0; i < 8; ++i) ssq += f[i] * f[i];
#pragma unroll
            for (int o = 32; o > 0; o >>= 1) { ssq += __shfl_xor(ssq, o); ssk += __shfl_xor(ssk, o); }
            const float rstd = rsqrtf(ssq * (1.f / 512.f) + EPS_), rstk = rsqrtf(ssk * (1.f / 256.f) + EPS_);
#pragma unroll
            for (int i = 0; i < 8; ++i) f[i] = f[i] * rstd * gq[lane * 8 + i];
            *(u32x4*)(B.CQN + (size_t)s * 512 + lane * 8) = pack8(f);
#pragma unroll
            for (int i = 0; i < 4; ++i) g4[i] = g4[i] * rstk * gkv[lane * 4 + i];
            u32x2 o; o.x = cvt_pk_bf16(g4[0], g4[1]); o.y = cvt_pk_bf16(g4[2], g4[3]); *(u32x2*)(B.CKVN + (size_t)s * 256 + lane * 4) = o; }
        if (lane < 32) { const float x1 = bf2f(kr1), x2 = bf2f(kr2);
            const unsigned w = cvt_pk_bf16(x1 * krc - x2 * krs, x2 * krc + x1 * krs);
#pragma unroll
            for (int h = 0; h < 8; ++h) *(unsigned*)(B.K + ((size_t)h * S_ + s) * 192 + 128 + 2 * lane) = w; }
        if (lane < 16) { float v = bf2f(gt) + bgl;
            if ((lane >> 2) & 1) v = fminf(v, 0.f) - log1pf(__expf(-fabsf(v)));
            B.G[(size_t)s * 16 + lane] = v; }
    }
}

constexpr int NSUB = 8;
constexpr int NPHASE = 2 + NLAYER * NSUB;
__global__ void __launch_bounds__(512) mega_fwd(Params p) {
    extern __shared__ __attribute__((aligned(16))) unsigned char lds_raw[];
    LAS unsigned char* lds = (LAS unsigned char*)lds_raw;
    cg::grid_group grid = cg::this_grid();
    const int G = gridDim.x;
    volatile LAS unsigned* xst = (volatile LAS unsigned*)(lds + LDS_BYTES - 16);
    if (threadIdx.x == 0) { xst[0] = 0u; xst[1] = 0u; }
    if (blockIdx.x == 0) { unsigned* bw = (unsigned*)(p.ws + OFF_BAR); for (int i = threadIdx.x; i < XCD_BAR_WORDS; i += 512) bw[i] = 0u; __threadfence(); }
    __syncthreads();
    XcdBarrier xbar; xbar.bar = (unsigned*)(p.ws + OFF_BAR); xbar.x = 0; xbar.st = xst;
    for (int ph = p.ph_lo; ph < p.ph_hi; ++ph) {
        if (ph > p.ph_lo) { if (ph == p.ph_lo + 1) { grid.sync(); xbar = xcd_barrier_post((unsigned*)(p.ws + OFF_BAR), xst); } else xcd_barrier(xbar); }
        const int bx = lbid();
        unsigned char* ws = p.ws; asm volatile("" : "+s"(ws));
        Bufs B;
        B.H = (bf16_t*)(ws + OFF_H); B.Y = (bf16_t*)(ws + OFF_Y); B.QKML = (bf16_t*)(ws + OFF_QKML); B.RQK = (bf16_t*)(ws + OFF_RQK); B.CQN = (bf16_t*)(ws + OFF_CQN);
        B.CKVN = (bf16_t*)(ws + OFF_CKVN); B.CST = (bf16_t*)(ws + OFF_CST); B.RST = (bf16_t*)(ws + OFF_RST); B.PROJ = (bf16_t*)(ws + OFF_PROJ);
        B.Q = (bf16_t*)(ws + OFF_Q); B.K = (bf16_t*)(ws + OFF_K); B.V = (bf16_t*)(ws + OFF_V); B.ACT = (bf16_t*)(ws + OFF_ACT);
        B.X = (float*)(ws + OFF_X); B.RC = (float*)(ws + OFF_ROPE); B.RS = B.RC + S_ * 32; B.G = (float*)(ws + OFF_G); B.CLOC = (float*)(ws + OFF_CLOC);
        B.NLOC = (float*)(ws + OFF_NLOC); B.NST = (float*)(ws + OFF_NST); B.MLOC = (float*)(ws + OFF_MLOC); B.BLAST = (float*)(ws + OFF_BLAST); B.MST = (float*)(ws + OFF_MST);
        B.RLOC = (float*)(ws + OFF_RLOC); B.Wl = nullptr;
        unsigned long long* ssqa = (unsigned long long*)(ws + OFF_SSQA); unsigned long long* ssqb = (unsigned long long*)(ws + OFF_SSQB);
        if (ph == 0) { convert_phase(p, lds); continue; }
        if (ph == NPHASE - 1) { final_phase(B.H, p.g_final, p.out); continue; }
        const int l = (ph - 1) / NSUB, sub = (ph - 1) % NSUB;
        unsigned char* Wl = ws + OFF_W + (size_t)l * SZ_WL;
        pg8::StaticOrder so;
        switch (sub) {
        case 0: { so.init(S_, NPROJP - 512, G, bx, 6, 2); pg8::Gemm g{B.H, (const bf16_t*)(Wl + WO_IN), S_, NPROJP, DM}; pg8::EpiBf16<0> e{B.PROJ, NPROJP, ssqa}; pg8::gemm_phase(lds, g, so, e); } break;
        case 1: prep_phase(p, B, l); break;
        case 2: {
            if (bx < 192) { so.init(S_, 1536, 192, bx); pg8::Gemm g{B.CQN, (const bf16_t*)(Wl + WO_Q), S_, 1536, 512}; pg8::EpiQup e{B.Q, B.RC, B.RS}; pg8::gemm_phase(lds, g, so, e); }
            else { so.init(S_, 512, 64, bx - 192, 0, 6); pg8::Gemm g{B.H, (const bf16_t*)(Wl + WO_IN), S_, NPROJP, DM}; pg8::EpiBf16<0> e{B.PROJ, NPROJP, ssqa}; pg8::gemm_phase(lds, g, so, e); }
            { so.init(S_, 2048, G, bx); pg8::Gemm g{B.CKVN, (const bf16_t*)(Wl + WO_KV), S_, 2048, 256}; pg8::EpiKVup e{B.K, B.V}; pg8::gemm_phase(lds, g, so, e); }
            if (bx < 192) for (int it = bx; it < 1024; it += 192) { if (it < 512) mlstm_local(B, it, lds); else ret_local(B, it - 512, lds); }
        } break;
        case 3: { scan_phase(B);
            for (int i = bx * 512 + ltid(); i < S_; i += G * 512) { ssqa[i] = 0ull; ssqb[i] = 0ull; } } break;
        case 4: {
            for (int it = bx; it < 256; it += G) mlstm_out(B, p.g_ml_out + l * 512, it, lds);
            for (int it = bx; it < 256; it += G) ret_out(B, p.g_ret_out + l * 512, it, lds);
            for (int it = bx; it < 256; it += G) { const int h = it & 7, qb = it >> 3;
                att::attn_body(B.Q + ((size_t)h * S_ + qb * 256) * 192, B.K + (size_t)h * S_ * 192, B.V + (size_t)h * S_ * 128,
                               B.Y + (size_t)(qb * 256) * DM + 1024 + h * 128, S_, (char*)lds_raw); }
        } break;
        case 5: { so.init(S_, DM, G, bx); pg8::Gemm g{B.Y, (const bf16_t*)(Wl + WO_OUT), S_, DM, DM};
 pg8::EpiResid e{B.H, ssqb, DM}; pg8::gemm_phase(lds, g, so, e); } break;
        case 6: { so.init(S_, DFF, G, bx); pg8::Gemm g{B.H, (const bf16_t*)(Wl + WO_1), S_, DFF, DM}; pg8::EpiBf16<1> e{B.ACT, DFF, ssqb}; pg8::gemm_phase(lds, g, so, e); } break;
        case 7: { so.init(S_, DM, G, bx); pg8::Gemm g{B.ACT, (const bf16_t*)(Wl + WO_2), S_, DM, DFF};
            pg8::EpiResid e{B.H, ssqa, DM}; pg8::gemm_phase(lds, g, so, e); } break;
        }
    }
}

#ifndef MK_MULTI
#define MK_MULTI 0
#endif
extern "C" void kernel_launch(void* const* d_in, const int* in_sizes, int n_in, void* d_out, int out_size, void* d_ws, size_t ws_size, hipStream_t stream) {
    static int grid = 0;
    if (grid == 0) {
        if (n_in != 17 || out_size != S_ * DM || ws_size < WS_END) { fprintf(stderr, "kernel_launch: unexpected shapes: n_in %d out %d ws %zu (need %zu)\n", n_in, out_size, ws_size, (size_t)WS_END); grid = -1; return; }
        int dev = 0, cus = 0, per_cu = 0;
        hipGetDevice(&dev); hipDeviceGetAttribute(&cus, hipDeviceAttributeMultiprocessorCount, dev);
        if (hipFuncSetAttribute((const void*)mega_fwd, hipFuncAttributeMaxDynamicSharedMemorySize, LDS_BYTES) != hipSuccess) { fprintf(stderr, "kernel_launch: hipFuncSetAttribute failed\n"); grid = -1; return; }
        if (hipOccupancyMaxActiveBlocksPerMultiprocessor(&per_cu, (const void*)mega_fwd, 512, LDS_BYTES) != hipSuccess || per_cu < 1) { fprintf(stderr, "kernel_launch: occupancy query says %d\n", per_cu); per_cu = 1; }
        (void)hipGetLastError();
        grid = cus * 1;
        fprintf(stderr, "kernel_launch: cus %d per_cu %d grid %d\n", cus, per_cu, grid);
    }
    if (grid < 0) return;
    Params p{};
    p.x = (const float*)d_in[0]; p.pos = (const int*)d_in[1]; p.g_mix = (const float*)d_in[2]; p.w_in = (const float*)d_in[3]; p.b_gates = (const float*)d_in[4];
    p.w_conv = (const float*)d_in[5]; p.g_ml_out = (const float*)d_in[6]; p.g_ret_out = (const float*)d_in[7]; p.g_q_norm = (const float*)d_in[8]; p.w_q_up = (const float*)d_in[9];
    p.g_kv_norm = (const float*)d_in[10]; p.w_kv_up = (const float*)d_in[11]; p.w_out = (const float*)d_in[12]; p.g_ffn = (const float*)d_in[13]; p.w_ff1 = (const float*)d_in[14];
    p.w_ff2 = (const float*)d_in[15]; p.g_final = (const float*)d_in[16]; p.out = (float*)d_out; p.ws = (unsigned char*)d_ws;
#if MK_MULTI
    for (int ph = 0; ph < NPHASE; ++ph) { p.ph_lo = ph; p.ph_hi = ph + 1; hipLaunchKernelGGL(mega_fwd, dim3(grid), dim3(512), LDS_BYTES, stream, p); }
#else
    p.ph_lo = 0; p.ph_hi = NPHASE;
    void* args[] = {&p};
    hipError_t e = hipLaunchCooperativeKernel((const void*)mega_fwd, dim3(grid), dim3(512), args, LDS_BYTES, stream);
    if (e != hipSuccess) fprintf(stderr, "kernel_launch: cooperative launch failed: %s (grid %d)\n", hipGetErrorString(e), grid);
#endif
}
```

```cpp
#include <hip/hip_runtime.h>
#include <hip/hip_cooperative_groups.h>
#include <cstdio>
#include <cstdint>
namespace cg = cooperative_groups;

typedef unsigned short bf16_t;
typedef short bf16x8 __attribute__((ext_vector_type(8)));
typedef short s16x4 __attribute__((ext_vector_type(4)));
typedef float f32x4 __attribute__((ext_vector_type(4)));
typedef float f32x16 __attribute__((ext_vector_type(16)));
typedef unsigned u32x4 __attribute__((ext_vector_type(4)));
typedef unsigned u32x2 __attribute__((ext_vector_type(2)));
#define LAS __attribute__((address_space(3)))

constexpr int S_ = 8192, DM = 2048, NPROJ = 4432, NPROJP = 4608, DFF = 8192, NLAYER = 4;
constexpr float EPS_ = 1e-6f;
constexpr int LDS_BYTES = 147456;

constexpr int PC_MLQ = 0, PC_MLK = 512, PC_MLV = 1024, PC_MLO = 1536, PC_GATE = 2048, PC_RQ = 2064, PC_RK = 2320, PC_RV = 2576, PC_RG = 3088,
              PC_CQ = 3600, PC_CKV = 4112, PC_KR = 4368;

constexpr size_t SZ_WIN = (size_t)NPROJP * DM * 2, SZ_WQ = (size_t)1536 * 512 * 2, SZ_WKV = (size_t)2048 * 256 * 2, SZ_WOUT = (size_t)DM * DM * 2,
                 SZ_W1 = (size_t)DFF * DM * 2, SZ_W2 = (size_t)DM * DFF * 2;
constexpr size_t WO_IN = 0, WO_Q = WO_IN + SZ_WIN, WO_KV = WO_Q + SZ_WQ, WO_OUT = WO_KV + SZ_WKV, WO_1 = WO_OUT + SZ_WOUT, WO_2 = WO_1 + SZ_W1, SZ_WL = WO_2 + SZ_W2;
constexpr size_t OFF_W = 0;
constexpr size_t OFF_X = OFF_W + NLAYER * SZ_WL;
constexpr size_t OFF_H = OFF_X + (size_t)S_ * DM * 4;
constexpr size_t OFF_Y = OFF_H + (size_t)S_ * DM * 2;
constexpr size_t OFF_ROPE = OFF_Y + (size_t)S_ * DM * 2;
constexpr size_t OFF_G = OFF_ROPE + (size_t)S_ * 32 * 4 * 2;
constexpr size_t OFF_QKML = OFF_G + (size_t)S_ * 16 * 4;
constexpr size_t OFF_RQK = OFF_QKML + (size_t)S_ * 1024 * 2;
constexpr size_t OFF_CQN = OFF_RQK + (size_t)S_ * 512 * 2;
constexpr size_t OFF_CKVN = OFF_CQN + (size_t)S_ * 512 * 2;
constexpr size_t OFF_CLOC = OFF_CKVN + (size_t)S_ * 256 * 2;
constexpr size_t OFF_CST = OFF_CLOC + (size_t)512 * 16384 * 4;
constexpr size_t OFF_NLOC = OFF_CST + (size_t)512 * 16384 * 2;
constexpr size_t OFF_NST = OFF_NLOC + (size_t)512 * 128 * 4;
constexpr size_t OFF_MLOC = OFF_NST + (size_t)512 * 128 * 4;
constexpr size_t OFF_BLAST = OFF_MLOC + 2048;
constexpr size_t OFF_MST = OFF_BLAST + 2048;
constexpr size_t OFF_RLOC = OFF_MST + 2048;
constexpr size_t OFF_RST = OFF_RLOC + (size_t)512 * 8192 * 4;
constexpr size_t OFF_BAR = OFF_RST + (size_t)512 * 8192 * 2;
constexpr size_t OFF_SSQA = OFF_BAR + 16384;
constexpr size_t OFF_SSQB = OFF_SSQA + (size_t)S_ * 8;
constexpr size_t OFF_MIX = OFF_SSQB + (size_t)S_ * 8;
constexpr size_t OFF_PROJ = OFF_MIX;
constexpr size_t OFF_Q = OFF_PROJ + (size_t)S_ * NPROJP * 2;
constexpr size_t OFF_K = OFF_Q + (size_t)8 * S_ * 192 * 2;
constexpr size_t OFF_V = OFF_K + (size_t)8 * S_ * 192 * 2;
constexpr size_t OFF_END0 = OFF_V + (size_t)8 * S_ * 128 * 2;
constexpr size_t OFF_ACT = OFF_MIX;
constexpr size_t OFF_END1 = OFF_ACT + (size_t)S_ * DFF * 2;
constexpr size_t WS_END = OFF_END0 > OFF_END1 ? OFF_END0 : OFF_END1;

struct Params {
    const float* x; const int* pos; const float* g_mix; const float* w_in; const float* b_gates; const float* w_conv;
    const float* g_ml_out; const float* g_ret_out; const float* g_q_norm; const float* w_q_up; const float* g_kv_norm; const float* w_kv_up;
    const float* w_out; const float* g_ffn; const float* w_ff1; const float* w_ff2; const float* g_final;
    float* out; unsigned char* ws;
    int ph_lo, ph_hi;
};

__device__ __forceinline__ unsigned cvt_pk_bf16(float lo, float hi) { unsigned r; asm volatile("v_cvt_pk_bf16_f32 %0, %1, %2" : "=v"(r) : "v"(lo), "v"(hi)); return r; }
__device__ __forceinline__ int ltid() { int t = threadIdx.x; asm volatile("" : "+v"(t)); return t; }
__device__ __forceinline__ int lbid() { int t = blockIdx.x; asm volatile("" : "+s"(t)); return t; }
__device__ __forceinline__ float bf2f(bf16_t b) { return __uint_as_float(((unsigned)b) << 16); }
__device__ __forceinline__ float bflo(unsigned w) { return __uint_as_float(w << 16); }
__device__ __forceinline__ float bfhi(unsigned w) { return __uint_as_float(w & 0xffff0000u); }
__device__ __forceinline__ bf16_t f2bf(float f) { return (bf16_t)(cvt_pk_bf16(f, 0.f) & 0xffffu); }
__device__ __forceinline__ float wave_sum(float v) { for (int o = 32; o > 0; o >>= 1) v += __shfl_xor(v, o); return v; }
__device__ __forceinline__ float wave_max(float v) { for (int o = 32; o > 0; o >>= 1) v = fmaxf(v, __shfl_xor(v, o)); return v; }
__device__ __forceinline__ void unpack8(u32x4 w, float* f) { f[0] = bflo(w.x); f[1] = bfhi(w.x); f[2] = bflo(w.y); f[3] = bfhi(w.y); f[4] = bflo(w.z); f[5] = bfhi(w.z); f[6] = bflo(w.w); f[7] = bfhi(w.w); }
__device__ __forceinline__ u32x4 pack8(const float* f) { u32x4 w; w.x = cvt_pk_bf16(f[0], f[1]); w.y = cvt_pk_bf16(f[2], f[3]); w.z = cvt_pk_bf16(f[4], f[5]); w.w = cvt_pk_bf16(f[6], f[7]); return w; }


#define XB_TMO      128
#define XB_XCNT(j)  (256  + 64 * (j))
#define XB_XSUB(j)  (1280 + 64 * (j))
#define XB_XGEN(j)  (2304 + 64 * (j))
#define XB_TOP      3328
#define XB_TOPGEN   3392
#define XCD_BAR_WORDS 3456
#define XB_SPIN_CAP (1u << 18)

__device__ __forceinline__ unsigned xb_ld(unsigned* p)              { return __hip_atomic_load(p, __ATOMIC_RELAXED, __HIP_MEMORY_SCOPE_AGENT); }
__device__ __forceinline__ unsigned xb_add(unsigned* p, unsigned v) { return __hip_atomic_fetch_add(p, v, __ATOMIC_RELAXED, __HIP_MEMORY_SCOPE_AGENT); }
__device__ __forceinline__ unsigned xb_xcc_id() { return (unsigned)__builtin_amdgcn_s_getreg((3 << 11) | 20) & 0xFu; }
#define XB_SPIN(cond, bar) do { unsigned _sp = 0; while (cond) { __builtin_amdgcn_s_sleep(1); \
    if ((++_sp & 255u) == 0u) { if (xb_ld(&(bar)[XB_TMO])) break; if (_sp > XB_SPIN_CAP) { atomicAdd(&(bar)[XB_TMO], 1u); break; } } } } while (0)

struct XcdBarrier {
    unsigned* bar; unsigned x;
    volatile LAS unsigned* st;
};

__device__ __forceinline__ XcdBarrier xcd_barrier_post(unsigned* bar, volatile LAS unsigned* st) {
    XcdBarrier b; b.bar = bar; b.x = xb_xcc_id(); b.st = st;
    if (threadIdx.x == 0) (void)xb_add(&bar[XB_XCNT(b.x)], 1u);
    return b;
}
__device__ __forceinline__ void xcd_barrier_complete(unsigned* bar, unsigned x, unsigned& nloc, unsigned& nx) {
    const unsigned G = gridDim.x * gridDim.y * gridDim.z;
    unsigned sum, cnt, mine, sp = 0u;
    for (;;) {
        sum = 0u; cnt = 0u; mine = 0u;
#pragma unroll
        for (unsigned j = 0; j < 16; ++j) { const unsigned c = xb_ld(&bar[XB_XCNT(j)]); sum += c; cnt += (c > 0u) ? 1u : 0u; mine = (j == x) ? c : mine; }
        if (sum == G) break;
        __builtin_amdgcn_s_sleep(1);
        if ((++sp & 255u) == 0u) { if (xb_ld(&bar[XB_TMO])) break; if (sp > XB_SPIN_CAP) { atomicAdd(&bar[XB_TMO], 1u); break; } }
    }
    nloc = mine > 0u ? mine : 1u; nx = cnt > 0u ? cnt : 1u;
}

__device__ __forceinline__ void xcd_barrier(const XcdBarrier& b) {
    asm volatile("s_waitcnt vmcnt(0)" ::: "memory");
    __syncthreads();
    if (threadIdx.x == 0) {
        unsigned* bar = b.bar;
        __builtin_amdgcn_s_waitcnt(0);
        unsigned nloc = b.st[0], nx = b.st[1];
        if (nloc == 0u) { xcd_barrier_complete(bar, b.x, nloc, nx); b.st[0] = nloc; b.st[1] = nx; }
        const unsigned old = xb_add(&bar[XB_XSUB(b.x)], 1u);
        const unsigned gen = old / nloc;
        if (old + 1u == (gen + 1u) * nloc) {
            __builtin_amdgcn_fence(__ATOMIC_RELEASE, "agent");
            asm volatile("s_waitcnt vmcnt(0)" ::: "memory");
            const unsigned og = xb_add(&bar[XB_TOP], 1u);
            const unsigned tg = og / nx;
            if (og + 1u == (tg + 1u) * nx) xb_add(&bar[XB_TOPGEN], 1u);
            else XB_SPIN(xb_ld(&bar[XB_TOPGEN]) == tg, bar);
            __builtin_amdgcn_fence(__ATOMIC_ACQUIRE, "agent");
            xb_add(&bar[XB_XGEN(b.x)], 1u);
            asm volatile("s_waitcnt vmcnt(0)" ::: "memory");
        } else {
            XB_SPIN(xb_ld(&bar[XB_XGEN(b.x)]) == gen, bar);
            __builtin_amdgcn_fence(__ATOMIC_ACQUIRE, "agent");
            asm volatile("s_waitcnt vmcnt(0)" ::: "memory");
        }
    }
    __syncthreads();
}

namespace pg8 {
constexpr int BM = 256, BK = 64, HALF = 128, HTB = HALF * BK * 2, STAGE_BYTES = 8 * HTB, NXCD = 8, WGM = 8;
__host__ __device__ __forceinline__ int lds_byte(int r, int c) { const int st = (r >> 4) * 2 + (c >> 5), rr = r & 15, cc = c & 31, ob = rr * 64 + cc * 2; return st * 1024 + (ob ^ (((ob >> 9) & 1) << 5)); }
__host__ __device__ __forceinline__ void stage_rc(int b, int& R, int& C) { const int st = b / 1024, sb = b % 1024, swz = sb ^ (((sb >> 9) & 1) << 5); R = (st >> 1) * 16 + swz / 64; C = (st & 1) * 32 + (swz % 64) / 2; }
__host__ __device__ __forceinline__ int perm32(int rho) { const int n = rho >> 4, i = rho & 15; return 8 * (i >> 2) + 4 * n + (i & 3); }
struct Unit { int pm, pn; };
struct Gemm { const bf16_t* A; const bf16_t* Bt; int M, N, K; };
struct StaticOrder {
    int nM, nN, nwg, G, c, skip_lo, skip_n, ioff = 0, icnt = 1 << 20;
    __device__ void init(int M, int N, int G_, int c_, int slo = 1 << 20, int sn = 0) { nM = M / BM; nN = N / BM; nwg = nM * nN; G = G_; c = c_; skip_lo = slo; skip_n = sn; }
    __device__ bool next(int i, Unit& u) const {
        if (i >= icnt) return false; const long L = (long)(i + ioff) * G + c; if (L >= nwg) return false;
        int wgid = (int)L; { const int q = nwg / NXCD, r = nwg % NXCD, xcd = wgid % NXCD, off = wgid / NXCD; wgid = (xcd < r ? xcd * (q + 1) : r * (q + 1) + (xcd - r) * q) + off; }
        const int nig = WGM * nN, gid = wgid / nig, fm = gid * WGM, gsz = (nM - fm) < WGM ? (nM - fm) : WGM;
        u.pm = fm + ((wgid % nig) % gsz); u.pn = (wgid % nig) / gsz; if (u.pn >= skip_lo) u.pn += skip_n; return true;
    }
};
template <class Epi>
__device__ __forceinline__ void gemm_phase(LAS unsigned char* lds, const Gemm g, const StaticOrder& S, const Epi& E) {
    const int tid = ltid(), wid = __builtin_amdgcn_readfirstlane(tid >> 6), lane = tid & 63, wr = wid >> 2, wc = wid & 3, fr = lane & 15, fq = lane >> 4;
    int K = g.K; asm volatile("" : "+s"(K)); const int nt = K / BK;
    unsigned voffA[2], voffB[2];
#pragma unroll
    for (int i = 0; i < 2; ++i) { int R, C; stage_rc(tid * 16 + i * 8192, R, C); const int Rb = Epi::PERM ? ((R & ~31) + perm32(R & 31)) : R;
        voffA[i] = (unsigned)(R * K + C) * 2u; voffB[i] = (unsigned)(Rb * K + C) * 2u; }
    const size_t kstep = (size_t)(BK * 2);
    const size_t hstep = (size_t)HALF * K * 2;
    const size_t tstep = 2 * hstep;
    const unsigned ldsw = (unsigned)wid * 1024u;
    const int aoff = lds_byte(wr * 64 + fr, fq * 8), boff = lds_byte(wc * 32 + fr, fq * 8);
#define PG8_SA(b, h) (((b) * 2 + (h)) * HTB)
#define PG8_SB(b, h) ((4 + (b) * 2 + (h)) * HTB)
#define PG8_STAGE(bufoff, gbase, voff) do { _Pragma("unroll") for (int _i = 0; _i < 2; ++_i) \
        __builtin_amdgcn_global_load_lds((const unsigned*)((const char*)(gbase) + (voff)[_i]), (LAS unsigned*)(lds + (bufoff) + ldsw + _i * 8192), 16, 0, 0); } while (0)
#define PG8_LDA(dst, b, h) do { _Pragma("unroll") for (int m = 0; m < 4; ++m) _Pragma("unroll") for (int k = 0; k < 2; ++k) dst[m][k] = *(const LAS bf16x8*)(lds + PG8_SA(b, h) + aoff + m * 2048 + k * 1024); } while (0)
#define PG8_LDB(dst, b, h) do { _Pragma("unroll") for (int n = 0; n < 2; ++n) _Pragma("unroll") for (int k = 0; k < 2; ++k) dst[n][k] = *(const LAS bf16x8*)(lds + PG8_SB(b, h) + boff + n * 2048 + k * 1024); } while (0)
#define PG8_MMA(ai, bj, At, Bt) do { __builtin_amdgcn_s_setprio(1); _Pragma("unroll") for (int m = 0; m < 4; ++m) _Pragma("unroll") for (int n = 0; n < 2; ++n) _Pragma("unroll") for (int k = 0; k < 2; ++k) \
        acc[ai][bj][m][n] = __builtin_amdgcn_mfma_f32_16x16x32_bf16(Bt[n][k], At[m][k], acc[ai][bj][m][n], 0, 0, 0); __builtin_amdgcn_s_setprio(0); } while (0)
#define PG8_WAIT_V(n) asm volatile("s_waitcnt vmcnt(" #n ")" ::: "memory")
#define PG8_WAIT_L(n) asm volatile("s_waitcnt lgkmcnt(" #n ")" ::: "memory")
#define PG8_BAR __builtin_amdgcn_s_barrier()
#define PG8_SCHED __builtin_amdgcn_sched_barrier(0)
    Unit cur, nxt; int ui = 0;
    if (!S.next(0, cur)) return;
    f32x4 acc[2][2][4][2];
#pragma unroll
    for (int a = 0; a < 2; ++a)
#pragma unroll
        for (int b = 0; b < 2; ++b)
#pragma unroll
            for (int m = 0; m < 4; ++m)
#pragma unroll
                for (int n = 0; n < 2; ++n) acc[a][b][m][n] = (f32x4){0.f, 0.f, 0.f, 0.f};
    bf16x8 At[4][2], B0[2][2], B1[2][2];
    const char* cA = (const char*)g.A + (size_t)cur.pm * tstep; const char* cB = (const char*)g.Bt + (size_t)cur.pn * tstep;
    if (Epi::PRE) E.stash(E.prefetch(cur.pm, tid), lds, 0, tid);
    PG8_STAGE(PG8_SB(0, 0), cB, voffB); PG8_STAGE(PG8_SA(0, 0), cA, voffA); PG8_STAGE(PG8_SB(0, 1), cB + hstep, voffB); PG8_STAGE(PG8_SA(0, 1), cA + hstep, voffA);
    if (wr == 1) PG8_BAR;
    PG8_WAIT_V(4); PG8_BAR;
    PG8_STAGE(PG8_SB(1, 0), cB + kstep, voffB); PG8_STAGE(PG8_SA(1, 0), cA + kstep, voffA); PG8_STAGE(PG8_SB(1, 1), cB + hstep + kstep, voffB);
    PG8_WAIT_V(6); PG8_BAR;
    for (;;) {
        const bool has_next = S.next(ui + 1, nxt);
        const char* nA = has_next ? (const char*)g.A + (size_t)nxt.pm * tstep : cA; const char* nB = has_next ? (const char*)g.Bt + (size_t)nxt.pn * tstep : cB;
        for (int t = 0; t < nt; t += 2) {
            const bool last = (t == nt - 2);
            const char* a1 = cA + (size_t)(t + 1) * kstep;
            const char* a2 = last ? nA : cA + (size_t)(t + 2) * kstep; const char* b2 = last ? nB : cB + (size_t)(t + 2) * kstep;
            const char* a3 = a2 + kstep; const char* b3 = b2 + kstep;
            PG8_LDB(B0, 0, 0); PG8_SCHED; PG8_LDA(At, 0, 0); PG8_STAGE(PG8_SA(1, 1), a1 + hstep, voffA);
            PG8_WAIT_L(8); PG8_BAR; PG8_WAIT_L(0); PG8_MMA(0, 0, At, B0); PG8_BAR; PG8_SCHED;
            PG8_LDB(B1, 0, 1); PG8_STAGE(PG8_SB(0, 0), b2, voffB);
            PG8_BAR; PG8_WAIT_L(0); PG8_MMA(0, 1, At, B1); PG8_BAR;
            PG8_LDA(At, 0, 1); PG8_STAGE(PG8_SA(0, 0), a2, voffA);
            PG8_BAR; PG8_WAIT_L(0); PG8_MMA(1, 0, At, B0); PG8_BAR; PG8_SCHED;
            PG8_STAGE(PG8_SB(0, 1), b2 + hstep, voffB);
            PG8_WAIT_V(6); PG8_BAR; PG8_MMA(1, 1, At, B1); PG8_BAR;
            PG8_LDB(B0, 1, 0); PG8_SCHED; PG8_LDA(At, 1, 0); PG8_STAGE(PG8_SA(0, 1), a2 + hstep, voffA);
            PG8_WAIT_L(8); PG8_BAR; PG8_WAIT_L(0); PG8_MMA(0, 0, At, B0); PG8_BAR; PG8_SCHED;
            PG8_LDB(B1, 1, 1); PG8_STAGE(PG8_SB(1, 0), b3, voffB);
            PG8_BAR; PG8_WAIT_L(0); PG8_MMA(0, 1, At, B1); PG8_BAR;
            PG8_LDA(At, 1, 1); PG8_STAGE(PG8_SA(1, 0), a3, voffA);
            PG8_BAR; PG8_WAIT_L(0); PG8_MMA(1, 0, At, B0); PG8_BAR; PG8_SCHED;
            PG8_STAGE(PG8_SB(1, 1), b3 + hstep, voffB);
            PG8_WAIT_V(6); PG8_BAR; PG8_MMA(1, 1, At, B1); PG8_BAR;
        }
        E(acc, cur, wr, wc, fr, fq, lds, ui & 1, has_next ? nxt.pm : -1, tid);
        if (!has_next) break;
#pragma unroll
        for (int a = 0; a < 2; ++a)
#pragma unroll
            for (int b = 0; b < 2; ++b)
#pragma unroll
                for (int m = 0; m < 4; ++m)
#pragma unroll
                    for (int n = 0; n < 2; ++n) acc[a][b][m][n] = (f32x4){0.f, 0.f, 0.f, 0.f};
        cur = nxt; cA = nA; cB = nB; ++ui;
    }
    PG8_WAIT_V(0);
    if (wr == 0) PG8_BAR;
    PG8_BAR;
#undef PG8_SA
#undef PG8_SB
#undef PG8_STAGE
#undef PG8_LDA
#undef PG8_LDB
#undef PG8_MMA
#undef PG8_WAIT_V
#undef PG8_WAIT_L
#undef PG8_BAR
#undef PG8_SCHED
}

template <int ACT> struct EpiBf16 {
    static constexpr bool PERM = true, PRE = true;
    bf16_t* O; int ldc; const unsigned long long* ssq;
    __device__ __forceinline__ unsigned long long prefetch(int pm, int tid) const { return tid < 256 ? ssq[pm * BM + tid] : 0ull; }
    __device__ __forceinline__ void stash(unsigned long long v, LAS unsigned char* lds, int par, int tid) const { if (tid < 256) *(LAS float*)(lds + 131072 + par * 1024 + tid * 4) = rsqrtf((float)v * (1.f / (1048576.f * DM)) + EPS_); }
    __device__ __forceinline__ void operator()(const f32x4 (&acc)[2][2][4][2], const Unit& u, int wr, int wc, int fr, int fq, LAS unsigned char* lds, int par, int npm, int tid) const {
        const int row0 = u.pm * BM + wr * 64 + fr, col0 = u.pn * BM + wc * 32 + 8 * fq;
        unsigned long long nx = 0ull; if (npm >= 0) nx = prefetch(npm, tid);
#pragma unroll
        for (int ai = 0; ai < 2; ++ai)
#pragma unroll
            for (int m = 0; m < 4; ++m) { const int row = row0 + ai * HALF + m * 16; bf16_t* rowp = O + (size_t)row * ldc + col0;
                const float rstd = *(const LAS float*)(lds + 131072 + par * 1024 + (wr * 64 + fr + ai * HALF + m * 16) * 4);
#pragma unroll
                for (int bj = 0; bj < 2; ++bj) { f32x4 v0 = acc[ai][bj][m][0] * rstd, v1 = acc[ai][bj][m][1] * rstd;
                    if (ACT == 1) {
#pragma unroll
                        for (int j = 0; j < 4; ++j) { const float a = fmaxf(v0[j], 0.f), b = fmaxf(v1[j], 0.f); v0[j] = a * a; v1[j] = b * b; } }
                    u32x4 w; w.x = cvt_pk_bf16(v0[0], v0[1]); w.y = cvt_pk_bf16(v0[2], v0[3]); w.z = cvt_pk_bf16(v1[0], v1[1]); w.w = cvt_pk_bf16(v1[2], v1[3]);
                    *(u32x4*)(rowp + bj * HALF) = w; } }
        if (npm >= 0) stash(nx, lds, par ^ 1, tid);
    }
};
struct EpiResid {
    static constexpr bool PERM = true, PRE = false;
    __device__ __forceinline__ unsigned long long prefetch(int, int) const { return 0ull; }
    __device__ __forceinline__ void stash(unsigned long long, LAS unsigned char*, int, int) const {}
    bf16_t* Hb; unsigned long long* ssq; int ldc;
    __device__ __forceinline__ void operator()(const f32x4 (&acc)[2][2][4][2], const Unit& u, int wr, int wc, int fr, int fq, LAS unsigned char* lds, int par, int npm, int tid) const {
        const int row0 = u.pm * BM + wr * 64 + fr, col0 = u.pn * BM + wc * 32 + 8 * fq;
        u32x4 old[2][4][2];
#pragma unroll
        for (int ai = 0; ai < 2; ++ai)
#pragma unroll
            for (int m = 0; m < 4; ++m)
#pragma unroll
                for (int bj = 0; bj < 2; ++bj) old[ai][m][bj] = *(const u32x4*)(Hb + (size_t)(row0 + ai * HALF + m * 16) * ldc + col0 + bj * HALF);
#pragma unroll
        for (int ai = 0; ai < 2; ++ai)
#pragma unroll
            for (int m = 0; m < 4; ++m) { const int row = row0 + ai * HALF + m * 16; bf16_t* hp = Hb + (size_t)row * ldc + col0;
                float part = 0.f;
#pragma unroll
                for (int bj = 0; bj < 2; ++bj) { float o[8]; unpack8(old[ai][m][bj], o);
                    const f32x4 a0 = acc[ai][bj][m][0], a1 = acc[ai][bj][m][1];
                    float v[8] = {o[0] + a0[0], o[1] + a0[1], o[2] + a0[2], o[3] + a0[3], o[4] + a1[0], o[5] + a1[1], o[6] + a1[2], o[7] + a1[3]};
#pragma unroll
                    for (int k = 0; k < 8; ++k) part += v[k] * v[k];
                    *(u32x4*)(hp + bj * HALF) = pack8(v); }
                part += __shfl_xor(part, 16); part += __shfl_xor(part, 32);
                if (fq == 0) atomicAdd(ssq + row, (unsigned long long)(part * 1048576.f)); }
    }
};
struct EpiQup {
    static constexpr bool PERM = true, PRE = false;
    __device__ __forceinline__ unsigned long long prefetch(int, int) const { return 0ull; }
    __device__ __forceinline__ void stash(unsigned long long, LAS unsigned char*, int, int) const {}
    bf16_t* Q; const float* rc; const float* rs;
    __device__ __forceinline__ void operator()(const f32x4 (&acc)[2][2][4][2], const Unit& u, int wr, int wc, int fr, int fq, LAS unsigned char* lds, int par, int npm, int tid) const {
        const int row0 = u.pm * BM + wr * 64 + fr;
        if (u.pn < 4) {
            bf16_t* d0 = Q + ((size_t)(u.pn * 2) * S_ + row0) * 192 + wc * 32 + 8 * fq;
#pragma unroll
            for (int ai = 0; ai < 2; ++ai)
#pragma unroll
                for (int m = 0; m < 4; ++m)
#pragma unroll
                    for (int bj = 0; bj < 2; ++bj) { const f32x4 v0 = acc[ai][bj][m][0], v1 = acc[ai][bj][m][1];
                        u32x4 w; w.x = cvt_pk_bf16(v0[0], v0[1]); w.y = cvt_pk_bf16(v0[2], v0[3]); w.z = cvt_pk_bf16(v1[0], v1[1]); w.w = cvt_pk_bf16(v1[2], v1[3]);
                        *(u32x4*)(d0 + (size_t)(ai * HALF + m * 16) * 192 + (size_t)bj * S_ * 192) = w; }
        } else {
            const int jj0 = (wc & 1) * 32 + 8 * fq, j0 = jj0 >> 1;
            bf16_t* d0 = Q + ((size_t)((u.pn - 4) * 4 + (wc >> 1)) * S_ + row0) * 192 + 128 + jj0;
            const float* c0 = rc + (size_t)row0 * 32 + j0; const float* s0 = rs + (size_t)row0 * 32 + j0;
            f32x4 cv[2][4], sv[2][4];
#pragma unroll
            for (int ai = 0; ai < 2; ++ai)
#pragma unroll
                for (int m = 0; m < 4; ++m) { const int ro = ai * HALF + m * 16; cv[ai][m] = *(const f32x4*)(c0 + ro * 32); sv[ai][m] = *(const f32x4*)(s0 + ro * 32); }
#pragma unroll
            for (int ai = 0; ai < 2; ++ai)
#pragma unroll
                for (int m = 0; m < 4; ++m) { const int ro = ai * HALF + m * 16; const f32x4 c = cv[ai][m], s = sv[ai][m];
#pragma unroll
                    for (int bj = 0; bj < 2; ++bj) { const f32x4 v0 = acc[ai][bj][m][0], v1 = acc[ai][bj][m][1];
                        u32x4 w;
                        w.x = cvt_pk_bf16(v0[0] * c[0] - v0[1] * s[0], v0[1] * c[0] + v0[0] * s[0]);
                        w.y = cvt_pk_bf16(v0[2] * c[1] - v0[3] * s[1], v0[3] * c[1] + v0[2] * s[1]);
                        w.z = cvt_pk_bf16(v1[0] * c[2] - v1[1] * s[2], v1[1] * c[2] + v1[0] * s[2]);
                        w.w = cvt_pk_bf16(v1[2] * c[3] - v1[3] * s[3], v1[3] * c[3] + v1[2] * s[3]);
                        *(u32x4*)(d0 + (size_t)ro * 192 + (size_t)bj * 2 * S_ * 192) = w; } }
        }
    }
};
struct EpiKVup {
    static constexpr bool PERM = true, PRE = false;
    __device__ __forceinline__ unsigned long long prefetch(int, int) const { return 0ull; }
    __device__ __forceinline__ void stash(unsigned long long, LAS unsigned char*, int, int) const {}
    bf16_t* Kb; bf16_t* Vb;
    template <int LD> __device__ __forceinline__ void put(const f32x4 (&acc)[2][2][4][2], bf16_t* d0) const {
#pragma unroll
        for (int ai = 0; ai < 2; ++ai)
#pragma unroll
            for (int m = 0; m < 4; ++m)
#pragma unroll
                for (int bj = 0; bj < 2; ++bj) { const f32x4 v0 = acc[ai][bj][m][0], v1 = acc[ai][bj][m][1];
                    u32x4 w; w.x = cvt_pk_bf16(v0[0], v0[1]); w.y = cvt_pk_bf16(v0[2], v0[3]); w.z = cvt_pk_bf16(v1[0], v1[1]); w.w = cvt_pk_bf16(v1[2], v1[3]);
                    *(u32x4*)(d0 + (size_t)(ai * HALF + m * 16) * LD + (size_t)bj * S_ * LD) = w; }
    }
    __device__ __forceinline__ void operator()(const f32x4 (&acc)[2][2][4][2], const Unit& u, int wr, int wc, int fr, int fq, LAS unsigned char* lds, int par, int npm, int tid) const {
        const int row0 = u.pm * BM + wr * 64 + fr;
        if (u.pn < 4) put<192>(acc, Kb + ((size_t)(u.pn * 2) * S_ + row0) * 192 + wc * 32 + 8 * fq);
        else put<128>(acc, Vb + ((size_t)((u.pn - 4) * 2) * S_ + row0) * 128 + wc * 32 + 8 * fq);
    }
};
}

namespace att {
constexpr int DQ = 192, DV = 128, NW = 8, QBLK = 32, KVBLK = 64;
constexpr float SCALE = 0.07216878364870322f;
constexpr float THR = 8.f;
#ifndef ATT_SDEPTH
#define ATT_SDEPTH 1
#endif
constexpr int SDEPTH = ATT_SDEPTH;
#ifndef ATT_NQREG
#define ATT_NQREG 12
#endif
constexpr int NQREG = ATT_NQREG;
constexpr int LDQ = 192, LDKK = 192, LDVV = 128, LDO = 2048;
constexpr int SHM_V = KVBLK * DV * 2, SHM_K = KVBLK * 400, SHM_QR = 2 * SHM_V + 2 * SHM_K + NW * 64 * 4, SHM_ATTN = SHM_QR + NW * (12 - NQREG) * 64 * 16;
#define KSWZ(row, colB) ((row) * 400 + (colB))
#define SBAR() __builtin_amdgcn_sched_barrier(0)
__device__ __forceinline__ int crow(int r, int hi) { return (r & 3) + 8 * (r >> 2) + 4 * hi; }
__device__ __forceinline__ void partialSM(f32x16& p0, f32x16& p1, float& m_reg, float& mn, float& alpha) {
  constexpr float C = SCALE * 1.4426950408889634f;
  float pmax = p0[0]; for (int r = 1; r < 16; ++r) pmax = fmaxf(pmax, p0[r]); for (int r = 0; r < 16; ++r) pmax = fmaxf(pmax, p1[r]);
  { auto rr = __builtin_amdgcn_permlane32_swap(__float_as_uint(pmax), __float_as_uint(pmax), false, false);
    pmax = fmaxf(__uint_as_float(rr[0]), __uint_as_float(rr[1])); }
  if (__builtin_expect(__all(pmax - m_reg <= THR / SCALE), 1)) { mn = m_reg; alpha = 1.f; }
  else { mn = fmaxf(m_reg, pmax); alpha = __builtin_amdgcn_exp2f((m_reg - mn) * C); m_reg = mn; }
  float mnC = -mn * C;
  for (int r = 0; r < 16; ++r) p0[r] = fmaf(p0[r], C, mnC); for (int r = 0; r < 16; ++r) p1[r] = fmaf(p1[r], C, mnC);
  for (int r = 0; r < 16; ++r) p0[r] = __builtin_amdgcn_exp2f(p0[r]);
}
__device__ __forceinline__ void finishSM(f32x16& p0, f32x16& p1, float alpha, float& l_reg, bf16x8& pa0, bf16x8& pa1, bf16x8& pa2, bf16x8& pa3) {
  for (int r = 0; r < 16; ++r) p1[r] = __builtin_amdgcn_exp2f(p1[r]);
  float ps = 0; for (int r = 0; r < 16; ++r) ps += p0[r]; for (int r = 0; r < 16; ++r) ps += p1[r];
  { auto rr = __builtin_amdgcn_permlane32_swap(__float_as_uint(ps), __float_as_uint(ps), false, false);
    ps = __uint_as_float(rr[0]) + __uint_as_float(rr[1]); }
  l_reg = l_reg * alpha + ps;
#define PK4(P, BASE, OUT) do { unsigned a0 = cvt_pk_bf16(P[BASE + 0], P[BASE + 1]), a1 = cvt_pk_bf16(P[BASE + 2], P[BASE + 3]);   \
    unsigned b0 = cvt_pk_bf16(P[BASE + 4], P[BASE + 5]), b1 = cvt_pk_bf16(P[BASE + 6], P[BASE + 7]);                              \
    auto r0 = __builtin_amdgcn_permlane32_swap(a0, b0, false, false); auto r1 = __builtin_amdgcn_permlane32_swap(a1, b1, false, false); \
    u32x4 w = {r0[0], r1[0], r0[1], r1[1]}; OUT = *reinterpret_cast<bf16x8*>(&w); } while (0)
  PK4(p0, 0, pa0); PK4(p0, 8, pa1); PK4(p1, 0, pa2); PK4(p1, 8, pa3);
#undef PK4
}
__device__ __forceinline__ void qkt(f32x16& p0, f32x16& p1, const bf16_t* Ks, const bf16x8* qr, const bf16x8* qrl, int r32, int hi) {
  p0 = f32x16{}; p1 = f32x16{};
#pragma unroll
  for (int d0 = 0; d0 < 12; ++d0) { int cb = (d0 * 16 + hi * 8) * 2;
    bf16x8 b0 = *reinterpret_cast<const bf16x8*>((const char*)Ks + KSWZ(r32, cb));
    bf16x8 b1 = *reinterpret_cast<const bf16x8*>((const char*)Ks + KSWZ(32 + r32, cb));
    const bf16x8 qv = d0 < NQREG ? qr[d0 < NQREG ? d0 : 0] : qrl[(d0 - NQREG) * 64];
    p0 = __builtin_amdgcn_mfma_f32_32x32x16_bf16(b0, qv, p0, 0, 0, 0);
    p1 = __builtin_amdgcn_mfma_f32_32x32x16_bf16(b1, qv, p1, 0, 0, 0); }
}
__device__ __forceinline__ int v_st(int k, int c) { const int kk = (k & ~0xC) | ((k & 4) << 1) | ((k & 8) >> 1); return ((kk >> 3) * 4 + (c >> 5)) * 512 + ((kk & 7) * 32 + (c & 31)) * 2; }
__device__ __forceinline__ int v_rd_base(int lane) { return ((lane & 3) << 3) | (((lane >> 2) & 3) << 6) | (((lane >> 4) & 1) << 5) | (((lane >> 5) & 1) << 8); }
constexpr int v_rd_off(int d0, int ks, int half) { return d0 * 512 + ks * 4096 + half * 2048; }
template <int OFF> __device__ __forceinline__ s16x4 tr_read(int vb) {
  s16x4 r; asm volatile("ds_read_b64_tr_b16 %0, %1 offset:%2" : "=&v"(r) : "v"(vb), "i"(OFF) : "memory"); return r;
}
template <int D0> __device__ __forceinline__ void pv_one(f32x16& od, int vb, bf16x8 pa0, bf16x8 pa1, bf16x8 pa2, bf16x8 pa3) {
  const s16x4 l0 = tr_read<v_rd_off(D0, 0, 0)>(vb), h0 = tr_read<v_rd_off(D0, 0, 1)>(vb), l1 = tr_read<v_rd_off(D0, 1, 0)>(vb), h1 = tr_read<v_rd_off(D0, 1, 1)>(vb);
  const s16x4 l2 = tr_read<v_rd_off(D0, 2, 0)>(vb), h2 = tr_read<v_rd_off(D0, 2, 1)>(vb), l3 = tr_read<v_rd_off(D0, 3, 0)>(vb), h3 = tr_read<v_rd_off(D0, 3, 1)>(vb);
  asm volatile("s_waitcnt lgkmcnt(0)" ::: "memory"); SBAR();
#define PK(L, H) (bf16x8){L[0], L[1], L[2], L[3], H[0], H[1], H[2], H[3]}
  od = __builtin_amdgcn_mfma_f32_32x32x16_bf16(pa0, PK(l0, h0), od, 0, 0, 0);
  od = __builtin_amdgcn_mfma_f32_32x32x16_bf16(pa1, PK(l1, h1), od, 0, 0, 0);
  od = __builtin_amdgcn_mfma_f32_32x32x16_bf16(pa2, PK(l2, h2), od, 0, 0, 0);
  od = __builtin_amdgcn_mfma_f32_32x32x16_bf16(pa3, PK(l3, h3), od, 0, 0, 0);
#undef PK
}
__device__ __forceinline__ void pv_d0(f32x16* o, int vb, bf16x8 pa0, bf16x8 pa1, bf16x8 pa2, bf16x8 pa3) {
  pv_one<0>(o[0], vb, pa0, pa1, pa2, pa3); pv_one<1>(o[1], vb, pa0, pa1, pa2, pa3); pv_one<2>(o[2], vb, pa0, pa1, pa2, pa3); pv_one<3>(o[3], vb, pa0, pa1, pa2, pa3);
}
__device__ __forceinline__ void attn_body(const bf16_t* __restrict__ Qb, const bf16_t* __restrict__ Kh, const bf16_t* __restrict__ Vh,
                                          bf16_t* __restrict__ Ob, int seq, char* lds) {
  const int tid = ltid(), wid = tid >> 6, lane = tid & 63, r32 = lane & 31, hi = lane >> 5;
  bf16_t* V_lds = (bf16_t*)lds; bf16_t* K_lds = (bf16_t*)(lds + 2 * SHM_V);
  float* ws = (float*)(lds + 2 * SHM_V + 2 * SHM_K) + wid * 64; float* li_l = ws; float* al_l = ws + 32;
  float m_reg = -1e30f, l_reg = 0; f32x16 o[4] = {}; bf16x8 qr[NQREG];
  const bf16_t* Qw = Qb + (long)(wid * QBLK + r32) * LDQ + hi * 8;
  bf16x8* qrl = (bf16x8*)(lds + SHM_QR) + wid * ((12 - NQREG) * 64) + lane;
#pragma unroll
  for (int d0 = 0; d0 < NQREG; ++d0) qr[d0] = *reinterpret_cast<const bf16x8*>(Qw + d0 * 16);
#pragma unroll
  for (int d0 = NQREG; d0 < 12; ++d0) qrl[(d0 - NQREG) * 64] = *reinterpret_cast<const bf16x8*>(Qw + d0 * 16);
  const int sr = tid >> 4, sc = (tid & 15) * 8, vst0 = v_st(sr, sc), vst1 = v_st(32 + sr, sc);
  const int kc0 = tid, kc1 = tid + 512, kc2 = tid + 1024;
  const int kr0 = kc0 / 24, kr1 = kc1 / 24, kr2 = kc2 / 24, ke0 = (kc0 % 24) * 8, ke1 = (kc1 % 24) * 8, ke2 = (kc2 % 24) * 8;
  const int kw0 = KSWZ(kr0, ke0 * 2), kw1 = KSWZ(kr1, ke1 * 2), kw2 = KSWZ(kr2, ke2 * 2);
  const int vb0 = (int)(uintptr_t)V_lds + v_rd_base(lane);
  struct { bf16x8 vs0, vs1, ks0, ks1, ks2; } sr_[SDEPTH];
#define SLOAD(i, k0) do { sr_[i].vs0 = *(const bf16x8*)(&Vh[(long)((k0) + sr) * LDVV + sc]); sr_[i].vs1 = *(const bf16x8*)(&Vh[(long)((k0) + 32 + sr) * LDVV + sc]); \
    { const char* kt_ = (const char*)Kh + (size_t)(k0) * 384; sr_[i].ks0 = *(const bf16x8*)(kt_ + tid * 16); sr_[i].ks1 = *(const bf16x8*)(kt_ + 8192 + tid * 16); \
    sr_[i].ks2 = *(const bf16x8*)(kt_ + 16384 + tid * 16); } } while (0)
#define SWRITE(b, i) do { *(bf16x8*)((char*)V_lds + (b) * SHM_V + vst0) = sr_[i].vs0;          \
    *(bf16x8*)((char*)V_lds + (b) * SHM_V + vst1) = sr_[i].vs1;               \
    *(bf16x8*)((char*)K_lds + (b) * SHM_K + kw0) = sr_[i].ks0;                       \
    *(bf16x8*)((char*)K_lds + (b) * SHM_K + kw1) = sr_[i].ks1;                       \
    *(bf16x8*)((char*)K_lds + (b) * SHM_K + kw2) = sr_[i].ks2; } while (0)
#define SWAIT() do { if constexpr (SDEPTH == 2) asm volatile("s_waitcnt vmcnt(5)" ::: "memory"); else asm volatile("s_waitcnt vmcnt(0)" ::: "memory"); } while (0)
#define RESC(a) do { if (__any((a) < 1.f)) { if (hi == 0) al_l[r32] = (a); asm volatile("s_waitcnt lgkmcnt(0)" ::: "memory"); \
    for (int d = 0; d < 4; ++d) for (int r = 0; r < 16; ++r) o[d][r] *= al_l[crow(r, hi)]; } } while (0)
  f32x16 pA0, pA1, pB0, pB1; float mnA, mnB, alA, alB; bf16x8 pa0, pa1, pa2, pa3; const int NT = seq / KVBLK;
  constexpr int SE = 0, SO = SDEPTH - 1;
  SLOAD(SE, 0); asm volatile("s_waitcnt vmcnt(0)" ::: "memory"); SWRITE(0, SE); __syncthreads();
  qkt(pA0, pA1, K_lds, qr, qrl, r32, hi); partialSM(pA0, pA1, m_reg, mnA, alA);
  SLOAD(SO, KVBLK); if constexpr (SDEPTH == 2) { if (2 < NT) SLOAD(SE, 2 * KVBLK); }
  SWAIT(); SWRITE(1, SO); __syncthreads();
  for (int j = 1; j + 1 < NT; j += 2) {
    SBAR(); qkt(pB0, pB1, (bf16_t*)((char*)K_lds + SHM_K), qr, qrl, r32, hi);
    finishSM(pA0, pA1, alA, l_reg, pa0, pa1, pa2, pa3); SBAR();
    SLOAD(SO, (j + SDEPTH) * KVBLK); SBAR();
    pv_d0(o, vb0, pa0, pa1, pa2, pa3); partialSM(pB0, pB1, m_reg, mnB, alB);
    __syncthreads(); SWAIT(); SWRITE(0, SE);
    RESC(alB); __syncthreads();
    SBAR(); qkt(pA0, pA1, K_lds, qr, qrl, r32, hi);
    finishSM(pB0, pB1, alB, l_reg, pa0, pa1, pa2, pa3); SBAR();
    if (SDEPTH == 1 || j + 3 < NT) SLOAD(SE, (j + 1 + SDEPTH) * KVBLK); SBAR();
    pv_d0(o, vb0 + (int)SHM_V, pa0, pa1, pa2, pa3); partialSM(pA0, pA1, m_reg, mnA, alA);
    __syncthreads(); SWAIT(); SWRITE(1, SO);
    RESC(alA); __syncthreads();
  }
  SBAR(); qkt(pB0, pB1, (bf16_t*)((char*)K_lds + SHM_K), qr, qrl, r32, hi);
  finishSM(pA0, pA1, alA, l_reg, pa0, pa1, pa2, pa3); SBAR();
  pv_d0(o, vb0, pa0, pa1, pa2, pa3); partialSM(pB0, pB1, m_reg, mnB, alB);
  __syncthreads(); RESC(alB);
  finishSM(pB0, pB1, alB, l_reg, pa0, pa1, pa2, pa3); SBAR();
  pv_d0(o, vb0 + (int)SHM_V, pa0, pa1, pa2, pa3);
  if (hi == 0) li_l[r32] = l_reg; asm volatile("s_waitcnt lgkmcnt(0)" ::: "memory");
  float rli[16];
#pragma unroll
  for (int r = 0; r < 16; ++r) rli[r] = __builtin_amdgcn_rcpf(li_l[crow(r, hi)]);
  bf16_t* Ow = Ob + (long)(wid * QBLK) * LDO;
#pragma unroll
  for (int r = 0; r < 16; ++r) { int orow = crow(r, hi);
    for (int d0 = 0; d0 < 4; ++d0) Ow[(long)orow * LDO + d0 * 32 + r32] = f2bf(o[d0][r] * rli[r]); }
  asm volatile("s_waitcnt vmcnt(0)" ::: "memory");
  __syncthreads();
#undef SLOAD
#undef SWRITE
#undef SWAIT
#undef RESC
}
}

template <int K, int NT>
__device__ __forceinline__ void mma_tile(f32x4 (&acc)[4][NT], const LAS bf16_t* A, int lda, const LAS bf16_t* Bt, int ldb, int wr, int wc, int fr, int fq) {
#pragma unroll 1
    for (int k0 = 0; k0 < K; k0 += 32) {
        bf16x8 a[4], b[NT];
#pragma unroll
        for (int m = 0; m < 4; ++m) a[m] = *(const LAS bf16x8*)(A + (64 * wr + 16 * m + fr) * lda + k0 + fq * 8);
#pragma unroll
        for (int n = 0; n < NT; ++n) b[n] = *(const LAS bf16x8*)(Bt + (16 * NT * wc + 16 * n + fr) * ldb + k0 + fq * 8);
#pragma unroll
        for (int m = 0; m < 4; ++m)
#pragma unroll
            for (int n = 0; n < NT; ++n) acc[m][n] = __builtin_amdgcn_mfma_f32_16x16x32_bf16(a[m], b[n], acc[m][n], 0, 0, 0);
    }
}
template <int NT> __device__ __forceinline__ void zero_acc(f32x4 (&acc)[4][NT]) {
#pragma unroll
    for (int m = 0; m < 4; ++m)
#pragma unroll
        for (int n = 0; n < NT; ++n) acc[m][n] = (f32x4){0.f, 0.f, 0.f, 0.f};
}
template <int R, int C> __device__ __forceinline__ void stage_N(LAS bf16_t* dst, int ld, const bf16_t* __restrict__ src, size_t ldg) {
    constexpr int CH = C / 8;
    for (int idx = ltid(); idx < R * CH; idx += 512) { const int r = idx / CH, c = (idx % CH) * 8;
        *(LAS u32x4*)(dst + r * ld + c) = *(const u32x4*)(src + (size_t)r * ldg + c); }
}
template <int C, bool SCL> __device__ __forceinline__ void stage_T(LAS bf16_t* dst, int ld, const bf16_t* __restrict__ src, size_t ldg, const LAS float* sc) {
    for (int idx = ltid(); idx < 128 * (C / 8); idx += 512) { const int r = idx & 127, c0 = (idx >> 7) * 8;
        const u32x4 w = *(const u32x4*)(src + (size_t)r * ldg + c0); float f[8]; unpack8(w, f);
        float s = 1.f; if (SCL) s = sc[r];
#pragma unroll
        for (int i = 0; i < 8; ++i) dst[(c0 + i) * ld + r] = f2bf(f[i] * s); }
}
template <int R, int C> __device__ __forceinline__ void ld_N(u32x4 (&r)[R * C / 8 / 512], const bf16_t* __restrict__ src, size_t ldg, int tid) {
    constexpr int CH = C / 8;
#pragma unroll
    for (int i = 0; i < R * CH / 512; ++i) { const int idx = tid + 512 * i, rr = idx / CH, c = (idx % CH) * 8; r[i] = *(const u32x4*)(src + (size_t)rr * ldg + c); }
}
template <int R, int C> __device__ __forceinline__ void st_N(LAS bf16_t* dst, int ld, const u32x4 (&r)[R * C / 8 / 512], int tid) {
    constexpr int CH = C / 8;
#pragma unroll
    for (int i = 0; i < R * CH / 512; ++i) { const int idx = tid + 512 * i, rr = idx / CH, c = (idx % CH) * 8; *(LAS u32x4*)(dst + rr * ld + c) = r[i]; }
}
template <int C> __device__ __forceinline__ void ld_T(u32x4 (&r)[128 * C / 8 / 512], const bf16_t* __restrict__ src, size_t ldg, int tid) {
#pragma unroll
    for (int i = 0; i < 128 * C / 8 / 512; ++i) { const int idx = tid + 512 * i, rr = idx & 127, c0 = (idx >> 7) * 8; r[i] = *(const u32x4*)(src + (size_t)rr * ldg + c0); }
}
template <int C, bool SCL> __device__ __forceinline__ void st_T(LAS bf16_t* dst, int ld, const u32x4 (&r)[128 * C / 8 / 512], const LAS float* sc, int tid) {
#pragma unroll
    for (int i = 0; i < 128 * C / 8 / 512; ++i) { const int idx = tid + 512 * i, rr = idx & 127, c0 = (idx >> 7) * 8;
        if (SCL) { float f[8]; unpack8(r[i], f); const float sv = sc[rr];
#pragma unroll
            for (int k = 0; k < 8; ++k) dst[(c0 + k) * ld + rr] = f2bf(f[k] * sv); }
        else { const unsigned w[4] = {r[i].x, r[i].y, r[i].z, r[i].w};
#pragma unroll
            for (int k = 0; k < 4; ++k) { dst[(c0 + 2 * k) * ld + rr] = (bf16_t)(w[k] & 0xffffu); dst[(c0 + 2 * k + 1) * ld + rr] = (bf16_t)(w[k] >> 16); } } }
}
__device__ __forceinline__ float scan_add64(float v, int lane) {
#pragma unroll
    for (int o = 1; o < 64; o <<= 1) { const float t = __shfl_up(v, o); if (lane >= o) v += t; } return v; }
__device__ __forceinline__ float scan_max64(float v, int lane) {
#pragma unroll
    for (int o = 1; o < 64; o <<= 1) { const float t = __shfl_up(v, o); if (lane >= o) v = fmaxf(v, t); } return v; }

constexpr int CB0 = 0, CB1 = 34816, CB2 = 69632, CB3 = 104448, CVEC = 139264;
constexpr int RQB = 0, RKB = 18432, RST_ = 36864, RVT = 71680, RRT = 106496;

struct Bufs {
    bf16_t *Wl, *H, *Y, *QKML, *RQK, *CQN, *CKVN, *CST, *RST, *PROJ, *Q, *K, *V, *ACT;
    float *X, *RC, *RS, *G, *CLOC, *NLOC, *NST, *MLOC, *BLAST, *MST, *RLOC;
};

__device__ __forceinline__ void mlstm_local(const Bufs& B, int item, LAS unsigned char* lds) {
    const int tid = ltid(), wid = tid >> 6, lane = tid & 63, wr = wid >> 2, wc = wid & 3, fr = lane & 15, fq = lane >> 4;
    const int c = item & 63, h = (item >> 6) & 3, dir = item >> 8, s0 = c * 128;
    LAS bf16_t* T0 = (LAS bf16_t*)(lds + CB0); LAS bf16_t* T1 = (LAS bf16_t*)(lds + CB1); LAS float* ve = (LAS float*)(lds + CVEC);
    u32x4 rk[4], rv[4];
    ld_T<128>(rk, B.QKML + (size_t)s0 * 1024 + 512 + h * 128, 1024, tid);
    ld_T<128>(rv, B.PROJ + (size_t)s0 * NPROJP + PC_MLV + h * 128, NPROJP, tid);
    if (wid == 0) {
        const int l0 = 2 * lane, l1 = l0 + 1, p0 = dir ? 127 - l0 : l0, p1 = dir ? 127 - l1 : l1, gi = 8 * dir + h, gf = gi + 4;
        const float li0 = B.G[(size_t)(s0 + p0) * 16 + gi], lf0 = B.G[(size_t)(s0 + p0) * 16 + gf], li1 = B.G[(size_t)(s0 + p1) * 16 + gi], lf1 = B.G[(size_t)(s0 + p1) * 16 + gf];
        const float t = lf0 + lf1, incl = scan_add64(t, lane), b0 = incl - t + lf0, b1 = incl, btot = __shfl(incl, 63);
        const float w0 = btot - b0 + li0, w1 = btot - b1 + li1, mloc = wave_max(fmaxf(w0, w1));
        ve[p0] = __expf(w0 - mloc); ve[p1] = __expf(w1 - mloc);
        if (lane == 0) { B.MLOC[item] = mloc; B.BLAST[item] = btot; }
    }
    st_T<128, false>(T0, 136, rk, ve, tid);
    __syncthreads();
    st_T<128, true>(T1, 136, rv, ve, tid);
    __syncthreads();
    f32x4 acc[4][2]; zero_acc<2>(acc);
    mma_tile<128, 2>(acc, T1, 136, T0, 136, wr, wc, fr, fq);
    float* dst = B.CLOC + (size_t)item * 16384;
#pragma unroll
    for (int m = 0; m < 4; ++m)
#pragma unroll
        for (int n = 0; n < 2; ++n)
#pragma unroll
            for (int j = 0; j < 4; ++j) dst[(64 * wr + 16 * m + 4 * fq + j) * 128 + 32 * wc + 16 * n + fr] = acc[m][n][j];
    { const int dk = tid >> 2, qd = tid & 3; float s = 0.f;
#pragma unroll
        for (int i = 0; i < 4; ++i) { float kv[8]; unpack8(*(const LAS u32x4*)(T0 + dk * 136 + qd * 32 + i * 8), kv);
#pragma unroll
            for (int k = 0; k < 8; ++k) s += kv[k] * ve[qd * 32 + i * 8 + k]; }
        s += __shfl_xor(s, 1); s += __shfl_xor(s, 2);
        if (qd == 0) B.NLOC[(size_t)item * 128 + dk] = s; }
    __syncthreads();
}

__device__ __forceinline__ void ret_local(const Bufs& B, int item, LAS unsigned char* lds) {
    const int tid = ltid(), wid = tid >> 6, lane = tid & 63, wr = wid >> 2, wc = wid & 3, fr = lane & 15, fq = lane >> 4;
    const int c = item & 63, h = (item >> 6) & 3, dir = item >> 8, s0 = c * 128, hd = dir ? 3 - h : h;
    const float lg = log1pf(-exp2f(-5.f - (float)hd));
    LAS bf16_t* T0 = (LAS bf16_t*)(lds + CB0); LAS bf16_t* T1 = (LAS bf16_t*)(lds + CB1); LAS float* vz = (LAS float*)(lds + CVEC);
    u32x4 rk[2], rv[4];
    ld_T<64>(rk, B.RQK + (size_t)s0 * 512 + 256 + h * 64, 512, tid);
    ld_T<128>(rv, B.PROJ + (size_t)s0 * NPROJP + PC_RV + h * 128, NPROJP, tid);
    if (tid < 128) { const int lp = dir ? 127 - tid : tid; vz[tid] = __expf((float)(127 - lp) * lg); }
    st_T<64, false>(T0, 136, rk, vz, tid);
    __syncthreads();
    st_T<128, true>(T1, 136, rv, vz, tid);
    __syncthreads();
    f32x4 acc[4][1]; zero_acc<1>(acc);
    mma_tile<128, 1>(acc, T1, 136, T0, 136, wr, wc, fr, fq);
    float* dst = B.RLOC + (size_t)item * 8192;
#pragma unroll
    for (int m = 0; m < 4; ++m)
#pragma unroll
        for (int j = 0; j < 4; ++j) dst[(64 * wr + 16 * m + 4 * fq + j) * 64 + 16 * wc + fr] = acc[m][0][j];
    __syncthreads();
}

__device__ __forceinline__ void scan_phase(const Bufs& B) {
    const int gt = lbid() * 512 + ltid();
    if (gt < 131072) {
        const int dh = gt >> 14, idx = gt & 16383, dir = dh >> 2;
        float cst = 0.f, nst = 0.f, m = -1e30f;
#pragma unroll 1
        for (int s0 = 0; s0 < 64; s0 += 16) {
            float cl[16], ml[16], bl[16], nl[16];
#pragma unroll
            for (int u = 0; u < 16; ++u) { const int ch = dir ? 63 - (s0 + u) : s0 + u, it = dh * 64 + ch;
                cl[u] = B.CLOC[(size_t)it * 16384 + idx]; ml[u] = B.MLOC[it]; bl[u] = B.BLAST[it]; nl[u] = idx < 128 ? B.NLOC[(size_t)it * 128 + idx] : 0.f; }
#pragma unroll
            for (int u = 0; u < 16; ++u) { const int ch = dir ? 63 - (s0 + u) : s0 + u, it = dh * 64 + ch;
                B.CST[(size_t)it * 16384 + idx] = f2bf(cst);
                if (idx < 128) { B.NST[(size_t)it * 128 + idx] = nst; if (idx == 0) B.MST[it] = m; }
                const float mnew = fmaxf(bl[u] + m, ml[u]), a = __expf(bl[u] + m - mnew), g = __expf(ml[u] - mnew);
                cst = a * cst + g * cl[u]; nst = a * nst + g * nl[u]; m = mnew; }
        }
    }
    if (gt < 65536) {
        const int dh = gt >> 13, idx = gt & 8191, dir = dh >> 2, h = dh & 3, hd = dir ? 3 - h : h;
        const float cd = __expf(128.f * log1pf(-exp2f(-5.f - (float)hd)));
        float r = 0.f;
#pragma unroll 1
        for (int s0 = 0; s0 < 64; s0 += 16) {
            float rl[16];
#pragma unroll
            for (int u = 0; u < 16; ++u) { const int ch = dir ? 63 - (s0 + u) : s0 + u; rl[u] = B.RLOC[(size_t)(dh * 64 + ch) * 8192 + idx]; }
#pragma unroll
            for (int u = 0; u < 16; ++u) { const int ch = dir ? 63 - (s0 + u) : s0 + u; B.RST[(size_t)(dh * 64 + ch) * 8192 + idx] = f2bf(r); r = cd * r + rl[u]; }
        }
    }
}

__device__ __forceinline__ void mlstm_out(const Bufs& B, const float* __restrict__ g_out, int item, LAS unsigned char* lds) {
    const int tid = ltid(), wid = tid >> 6, lane = tid & 63, wr = wid >> 2, wc = wid & 3, fr = lane & 15, fq = lane >> 4;
    const int c = item >> 2, h = item & 3, s0 = c * 128;
    constexpr float SC = 0.08838834764831845f;
    LAS bf16_t* T0 = (LAS bf16_t*)(lds + CB0); LAS bf16_t* T1 = (LAS bf16_t*)(lds + CB1); LAS bf16_t* T2 = (LAS bf16_t*)(lds + CB2); LAS bf16_t* T3 = (LAS bf16_t*)(lds + CB3);
    LAS float* vea = (LAS float*)(lds + CVEC); LAS float* veM = vea + 256; LAS float* vedn = vea + 512; LAS float* vn = vea + 768; LAS float* vqn = vea + 1024;
    LAS float* vrs = vea + 1280; LAS float* vf = vea + 1408; LAS float* vsc = vea + 1536;
    LAS float* HT = (LAS float*)(lds + CB1);
    const float mst0 = B.MST[(0 * 4 + h) * 64 + c], mst1 = B.MST[(1 * 4 + h) * 64 + c];
    { u32x4 rq[4], rk[4], rv[4], rc[4];
        ld_N<128, 128>(rq, B.QKML + (size_t)s0 * 1024 + h * 128, 1024, tid);
        ld_N<128, 128>(rk, B.QKML + (size_t)s0 * 1024 + 512 + h * 128, 1024, tid);
        ld_T<128>(rv, B.PROJ + (size_t)s0 * NPROJP + PC_MLV + h * 128, NPROJP, tid);
        ld_N<128, 128>(rc, B.CST + (size_t)((0 * 4 + h) * 64 + c) * 16384, 128, tid);
        st_N<128, 128>(T0, 136, rq, tid); st_N<128, 128>(T1, 136, rk, tid); st_T<128, false>(T2, 136, rv, vea, tid); st_N<128, 128>(T3, 136, rc, tid); }
    if (wid < 2) {
        const int dir = wid; const float mst = dir ? mst1 : mst0;
        const int l0 = 2 * lane, l1 = l0 + 1, p0 = dir ? 127 - l0 : l0, p1 = dir ? 127 - l1 : l1, gi = 8 * dir + h, gf = gi + 4;
        const float li0 = B.G[(size_t)(s0 + p0) * 16 + gi], lf0 = B.G[(size_t)(s0 + p0) * 16 + gf], li1 = B.G[(size_t)(s0 + p1) * 16 + gi], lf1 = B.G[(size_t)(s0 + p1) * 16 + gf];
        const float t = lf0 + lf1, incl = scan_add64(t, lane), b0 = incl - t + lf0, b1 = incl;
        const float a0 = li0 - b0, a1 = li1 - b1, inm = scan_max64(fmaxf(a0, a1), lane);
        float exm = __shfl_up(inm, 1); if (lane == 0) exm = -3.0e38f;
        const float A0 = fmaxf(exm, a0), A1 = inm, amax = __shfl(inm, 63), cc = fmaxf(amax, mst);
        const float M0 = fmaxf(A0, mst), M1 = fmaxf(A1, mst);
        vea[dir * 128 + p0] = __expf(a0 - cc); vea[dir * 128 + p1] = __expf(a1 - cc);
        veM[dir * 128 + p0] = __expf(cc - M0) * SC; veM[dir * 128 + p1] = __expf(cc - M1) * SC;
        vedn[dir * 128 + p0] = __expf(-(b0 + M0)); vedn[dir * 128 + p1] = __expf(-(b1 + M1));
        if (lane == 0) vsc[dir] = __expf(mst - cc);
    }
    if (tid < 256) { const int dir = tid >> 7, d = tid & 127; vn[tid] = B.NST[(size_t)((dir * 4 + h) * 64 + c) * 128 + d]; }
    __syncthreads();
    f32x4 accS[4][2]; zero_acc<2>(accS);
    mma_tile<128, 2>(accS, T1, 136, T0, 136, wr, wc, fr, fq);
    { const int row = tid >> 2, qd = tid & 3; float q0 = 0.f, q1 = 0.f;
#pragma unroll
        for (int i = 0; i < 4; ++i) { float qv[8]; unpack8(*(const LAS u32x4*)(T0 + row * 136 + qd * 32 + i * 8), qv);
            const f32x4 n0a = *(const LAS f32x4*)(vn + qd * 32 + i * 8), n0b = *(const LAS f32x4*)(vn + qd * 32 + i * 8 + 4);
            const f32x4 n1a = *(const LAS f32x4*)(vn + 128 + qd * 32 + i * 8), n1b = *(const LAS f32x4*)(vn + 128 + qd * 32 + i * 8 + 4);
#pragma unroll
            for (int k = 0; k < 4; ++k) { q0 += qv[k] * n0a[k] + qv[4 + k] * n0b[k]; q1 += qv[k] * n1a[k] + qv[4 + k] * n1b[k]; } }
        q0 += __shfl_xor(q0, 1); q0 += __shfl_xor(q0, 2); q1 += __shfl_xor(q1, 1); q1 += __shfl_xor(q1, 2);
        if (qd == 0) { vqn[row] = q0; vqn[128 + row] = q1; } }
    __syncthreads();
    f32x4 hacc[4][2]; zero_acc<2>(hacc);
    u32x4 rc1[4]; ld_N<128, 128>(rc1, B.CST + (size_t)((1 * 4 + h) * 64 + c) * 16384, 128, tid);
#pragma unroll 1
    for (int dir = 0; dir < 2; ++dir) {
        if (dir == 1) st_N<128, 128>(T3, 136, rc1, tid);
        const float r = vsc[dir];
#pragma unroll
        for (int m = 0; m < 4; ++m)
#pragma unroll
            for (int n = 0; n < 2; ++n) { const int l = 32 * wc + 16 * n + fr, sb = 64 * wr + 16 * m + 4 * fq;
                const f32x4 e4 = *(const LAS f32x4*)(vea + dir * 128 + sb); float v[4];
#pragma unroll
                for (int j = 0; j < 4; ++j) { const int s = sb + j; const bool ok = dir ? (s >= l) : (s <= l); v[j] = ok ? accS[m][n][j] * e4[j] : 0.f; }
                u32x2 w; w.x = cvt_pk_bf16(v[0], v[1]); w.y = cvt_pk_bf16(v[2], v[3]);
                *(LAS u32x2*)(T1 + l * 136 + sb) = w; }
        __syncthreads();
        { const int row = tid >> 2, qd = tid & 3; float s = 0.f;
#pragma unroll
            for (int i = 0; i < 4; ++i) { float sv[8]; unpack8(*(const LAS u32x4*)(T1 + row * 136 + qd * 32 + i * 8), sv);
#pragma unroll
                for (int k = 0; k < 8; ++k) s += sv[k]; }
            s += __shfl_xor(s, 1); s += __shfl_xor(s, 2);
            if (qd == 0) { const float eM = veM[dir * 128 + row], den = eM * (s + r * vqn[dir * 128 + row]);
                vf[row] = eM / fmaxf(fabsf(den), vedn[dir * 128 + row]); } }
        f32x4 accN[4][2]; zero_acc<2>(accN);
        mma_tile<128, 2>(accN, T0, 136, T3, 136, wr, wc, fr, fq);
#pragma unroll
        for (int m = 0; m < 4; ++m)
#pragma unroll
            for (int n = 0; n < 2; ++n) accN[m][n] *= r;
        mma_tile<128, 2>(accN, T1, 136, T2, 136, wr, wc, fr, fq);
        __syncthreads();
#pragma unroll
        for (int m = 0; m < 4; ++m) { const f32x4 f4 = *(const LAS f32x4*)(vf + 64 * wr + 16 * m + 4 * fq);
#pragma unroll
            for (int n = 0; n < 2; ++n) hacc[m][n] += accN[m][n] * f4; }
        __syncthreads();
    }
    const int erow = tid >> 2, eqd = tid & 3, es = s0 + erow;
    u32x4 og4[4]; f32x4 gp4[8];
    { const bf16_t* og = B.PROJ + (size_t)es * NPROJP + PC_MLO + h * 128 + eqd * 32; const float* gp = g_out + h * 128 + eqd * 32;
#pragma unroll
        for (int i = 0; i < 4; ++i) og4[i] = *(const u32x4*)(og + i * 8);
#pragma unroll
        for (int i = 0; i < 8; ++i) gp4[i] = *(const f32x4*)(gp + i * 4); }
#pragma unroll
    for (int m = 0; m < 4; ++m)
#pragma unroll
        for (int n = 0; n < 2; ++n)
#pragma unroll
            for (int j = 0; j < 4; ++j) HT[(64 * wr + 16 * m + 4 * fq + j) * 132 + 32 * wc + 16 * n + fr] = hacc[m][n][j];
    __syncthreads();
    { float ssq = 0.f; f32x4 x4[8];
#pragma unroll
        for (int i = 0; i < 8; ++i) { x4[i] = *(const LAS f32x4*)(HT + erow * 132 + eqd * 32 + i * 4);
            ssq += x4[i][0] * x4[i][0] + x4[i][1] * x4[i][1] + x4[i][2] * x4[i][2] + x4[i][3] * x4[i][3]; }
        ssq += __shfl_xor(ssq, 1); ssq += __shfl_xor(ssq, 2);
        const float rstd = rsqrtf(ssq * (1.f / 128.f) + EPS_);
        bf16_t* yo = B.Y + (size_t)es * DM + h * 128 + eqd * 32;
#pragma unroll
        for (int i = 0; i < 4; ++i) { float o8[8]; unpack8(og4[i], o8); float r8[8];
#pragma unroll
            for (int k = 0; k < 8; ++k) { const float sg = __builtin_amdgcn_rcpf(1.f + __expf(-o8[k])); r8[k] = sg * x4[2 * i + (k >> 2)][k & 3] * rstd * gp4[2 * i + (k >> 2)][k & 3]; }
            *(u32x4*)(yo + i * 8) = pack8(r8); } }
    __syncthreads();
}

__device__ __forceinline__ void ret_out(const Bufs& B, const float* __restrict__ g_out, int item, LAS unsigned char* lds) {
    const int tid = ltid(), wid = tid >> 6, lane = tid & 63, wr = wid >> 2, wc = wid & 3, fr = lane & 15, fq = lane >> 4;
    const int c = item >> 2, h = item & 3, s0 = c * 128;
    LAS bf16_t* QB = (LAS bf16_t*)(lds + RQB); LAS bf16_t* KB = (LAS bf16_t*)(lds + RKB); LAS bf16_t* ST = (LAS bf16_t*)(lds + RST_); LAS bf16_t* VT = (LAS bf16_t*)(lds + RVT); LAS bf16_t* RT = (LAS bf16_t*)(lds + RRT);
    LAS float* HT = (LAS float*)(lds + RST_); LAS float* vcs = (LAS float*)(lds + CVEC); LAS float* vrw = vcs + 256;
    u32x4 rr1[2];
    { u32x4 rq[2], rk[2], rv[4], rr0[2];
        ld_N<128, 64>(rq, B.RQK + (size_t)s0 * 512 + h * 64, 512, tid);
        ld_N<128, 64>(rk, B.RQK + (size_t)s0 * 512 + 256 + h * 64, 512, tid);
        ld_T<128>(rv, B.PROJ + (size_t)s0 * NPROJP + PC_RV + h * 128, NPROJP, tid);
        ld_N<128, 64>(rr0, B.RST + (size_t)((0 * 4 + h) * 64 + c) * 8192, 64, tid);
        ld_N<128, 64>(rr1, B.RST + (size_t)((1 * 4 + h) * 64 + c) * 8192, 64, tid);
        st_N<128, 64>(QB, 72, rq, tid); st_N<128, 64>(KB, 72, rk, tid); st_T<128, false>(VT, 136, rv, HT, tid); st_N<128, 64>(RT, 72, rr0, tid); }
    if (tid < 256) { const int dir = tid >> 7, p = tid & 127, lp = dir ? 127 - p : p, hd = dir ? 3 - h : h; const float lg = log1pf(-exp2f(-5.f - (float)hd));
        vcs[tid] = __expf(-(float)lp * lg); vrw[tid] = __expf((float)lp * lg); }
    __syncthreads();
    f32x4 accS[4][2]; zero_acc<2>(accS);
    mma_tile<64, 2>(accS, KB, 72, QB, 72, wr, wc, fr, fq);
    f32x4 yacc[4][2]; zero_acc<2>(yacc);
#pragma unroll 1
    for (int dir = 0; dir < 2; ++dir) {
        const int hd = dir ? 3 - h : h; const float gam = 1.f - exp2f(-5.f - (float)hd);
        if (dir == 1) st_N<128, 64>(RT, 72, rr1, tid);
#pragma unroll
        for (int m = 0; m < 4; ++m)
#pragma unroll
            for (int n = 0; n < 2; ++n) { const int l = 32 * wc + 16 * n + fr, sb = 64 * wr + 16 * m + 4 * fq;
                const f32x4 c4 = *(const LAS f32x4*)(vcs + dir * 128 + sb); float v[4];
#pragma unroll
                for (int j = 0; j < 4; ++j) { const int s = sb + j; const bool ok = dir ? (s >= l) : (s <= l); v[j] = ok ? accS[m][n][j] * c4[j] : 0.f; }
                u32x2 w; w.x = cvt_pk_bf16(v[0], v[1]); w.y = cvt_pk_bf16(v[2], v[3]);
                *(LAS u32x2*)(ST + l * 136 + sb) = w; }
        __syncthreads();
        f32x4 accR[4][2]; zero_acc<2>(accR);
        mma_tile<64, 2>(accR, QB, 72, RT, 72, wr, wc, fr, fq);
#pragma unroll
        for (int m = 0; m < 4; ++m)
#pragma unroll
            for (int n = 0; n < 2; ++n) accR[m][n] *= gam;
        mma_tile<128, 2>(accR, ST, 136, VT, 136, wr, wc, fr, fq);
        __syncthreads();
#pragma unroll
        for (int m = 0; m < 4; ++m) { const f32x4 r4 = *(const LAS f32x4*)(vrw + dir * 128 + 64 * wr + 16 * m + 4 * fq);
#pragma unroll
            for (int n = 0; n < 2; ++n) yacc[m][n] += accR[m][n] * r4; }
    }
    const int erow = tid >> 2, eqd = tid & 3, es = s0 + erow;
    u32x4 og4[4]; f32x4 gp4[8];
    { const bf16_t* gg = B.PROJ + (size_t)es * NPROJP + PC_RG + h * 128 + eqd * 32; const float* gp = g_out + h * 128 + eqd * 32;
#pragma unroll
        for (int i = 0; i < 4; ++i) og4[i] = *(const u32x4*)(gg + i * 8);
#pragma unroll
        for (int i = 0; i < 8; ++i) gp4[i] = *(const f32x4*)(gp + i * 4); }
#pragma unroll
    for (int m = 0; m < 4; ++m)
#pragma unroll
        for (int n = 0; n < 2; ++n)
#pragma unroll
            for (int j = 0; j < 4; ++j) HT[(64 * wr + 16 * m + 4 * fq + j) * 132 + 32 * wc + 16 * n + fr] = yacc[m][n][j];
    __syncthreads();
    { float ssq = 0.f; f32x4 x4[8];
#pragma unroll
        for (int i = 0; i < 8; ++i) { x4[i] = *(const LAS f32x4*)(HT + erow * 132 + eqd * 32 + i * 4);
            ssq += x4[i][0] * x4[i][0] + x4[i][1] * x4[i][1] + x4[i][2] * x4[i][2] + x4[i][3] * x4[i][3]; }
        ssq += __shfl_xor(ssq, 1); ssq += __shfl_xor(ssq, 2);
        const float rstd = rsqrtf(ssq * (1.f / 128.f) + EPS_);
        bf16_t* yo = B.Y + (size_t)es * DM + 512 + h * 128 + eqd * 32;
#pragma unroll
        for (int i = 0; i < 4; ++i) { float o8[8]; unpack8(og4[i], o8); float r8[8];
#pragma unroll
            for (int k = 0; k < 8; ++k) { const float sl = o8[k] * __builtin_amdgcn_rcpf(1.f + __expf(-o8[k])); r8[k] = sl * x4[2 * i + (k >> 2)][k & 3] * rstd * gp4[2 * i + (k >> 2)][k & 3]; }
            *(u32x4*)(yo + i * 8) = pack8(r8); } }
    __syncthreads();
}

__device__ __forceinline__ int map_col(int n, int mode) {
    if (mode == 1) { const int h = n / 192, d = n % 192; if (d < 128) return h * 128 + d; const int jj = d - 128; return 1024 + h * 64 + 2 * (jj & 31) + (jj >> 5); }
    if (mode == 2) { const int h = n >> 8, d = n & 255; return d < 128 ? h * 128 + d : 1024 + h * 128 + (d - 128); }
    return n;
}
struct CvtTile { const float* W; bf16_t* dst; const float* gk; int K, N, kt, nt, mode; };
constexpr int TILES_L = 576 + 48 + 32 + 256 + 1024 + 1024;
__device__ __forceinline__ CvtTile cvt_get(const Params& p, int t) {
    const int l = t / TILES_L; int r = t % TILES_L; unsigned char* Wl = p.ws + OFF_W + (size_t)l * SZ_WL; CvtTile c; int nT; c.mode = 0; c.gk = nullptr;
    if (r < 576) { c.W = p.w_in + (size_t)l * DM * NPROJ; c.K = DM; c.N = NPROJ; nT = 18; c.dst = (bf16_t*)(Wl + WO_IN); c.gk = p.g_mix + l * DM; }
    else if ((r -= 576) < 48) { c.W = p.w_q_up + (size_t)l * 512 * 1536; c.K = 512; c.N = 1536; nT = 6; c.mode = 1; c.dst = (bf16_t*)(Wl + WO_Q); }
    else if ((r -= 48) < 32) { c.W = p.w_kv_up + (size_t)l * 256 * 2048; c.K = 256; c.N = 2048; nT = 8; c.mode = 2; c.dst = (bf16_t*)(Wl + WO_KV); }
    else if ((r -= 32) < 256) { c.W = p.w_out + (size_t)l * DM * DM; c.K = DM; c.N = DM; nT = 8; c.dst = (bf16_t*)(Wl + WO_OUT); }
    else if ((r -= 256) < 1024) { c.W = p.w_ff1 + (size_t)l * DM * DFF; c.K = DM; c.N = DFF; nT = 32; c.dst = (bf16_t*)(Wl + WO_1); c.gk = p.g_ffn + l * DM; }
    else { r -= 1024; c.W = p.w_ff2 + (size_t)l * DFF * DM; c.K = DFF; c.N = DM; nT = 8; c.dst = (bf16_t*)(Wl + WO_2); }
    c.kt = r / nT; c.nt = r % nT; return c;
}
__device__ __forceinline__ void cvt_load(const CvtTile& c, f32x4 (&v)[8], int tid) {
#pragma unroll
    for (int i = 0; i < 8; ++i) { const int k = (tid >> 6) + 8 * i, gn = c.nt * 256 + (tid & 63) * 4;
        v[i] = (f32x4){0.f, 0.f, 0.f, 0.f};
        if (gn < c.N) { v[i] = __builtin_nontemporal_load((const f32x4*)(c.W + (size_t)(c.kt * 64 + k) * c.N + gn)); if (c.gk) v[i] = v[i] * c.gk[c.kt * 64 + k]; } }
}
__device__ __forceinline__ void convert_phase(const Params& p, LAS unsigned char* lds) {
    LAS float* T = (LAS float*)lds;
    const int tid = ltid(), G = gridDim.x;
    int t = lbid();
    f32x4 v[8]; CvtTile c;
    if (t < NLAYER * TILES_L) { c = cvt_get(p, t); cvt_load(c, v, tid); }
    while (t < NLAYER * TILES_L) {
#pragma unroll
        for (int i = 0; i < 8; ++i) { const int k = (tid >> 6) + 8 * i, n4 = (tid & 63) * 4;
            T[k * 257 + n4] = v[i][0]; T[k * 257 + n4 + 1] = v[i][1]; T[k * 257 + n4 + 2] = v[i][2]; T[k * 257 + n4 + 3] = v[i][3]; }
        __syncthreads();
        const CvtTile cur = c; const int tn = t + G;
        if (tn < NLAYER * TILES_L) { c = cvt_get(p, tn); cvt_load(c, v, tid); }
#pragma unroll
        for (int i = 0; i < 4; ++i) { const int ch = tid + 512 * i, n = ch >> 3, k8 = (ch & 7) * 8, gn = cur.nt * 256 + n;
            if (gn < cur.N) { float f[8];
#pragma unroll
                for (int j = 0; j < 8; ++j) f[j] = T[(k8 + j) * 257 + n];
                *(u32x4*)(cur.dst + (size_t)map_col(gn, cur.mode) * cur.K + cur.kt * 64 + k8) = pack8(f); } }
        __syncthreads();
        t = tn;
    }
    constexpr int PADV = (NPROJP - NPROJ) * DM * 2 / 16;
    for (int i = lbid() * 512 + tid; i < NLAYER * PADV; i += G * 512) { const int l = i / PADV, j = i % PADV;
        ((u32x4*)(p.ws + OFF_W + (size_t)l * SZ_WL + WO_IN + (size_t)NPROJ * DM * 2))[j] = (u32x4){0u, 0u, 0u, 0u}; }
    for (int i = lbid() * 512 + tid; i < S_ * 32; i += G * 512) { const int s = i >> 5, j = i & 31;
        const float inv = powf(10000.f, -(float)j * (1.f / 32.f)); const float ang = (float)p.pos[s] * inv;
        const double a = (double)ang, tw = 6.283185307179586476925; const double r = a - tw * rint(a / tw); const float rf = (float)r;
        ((float*)(p.ws + OFF_ROPE))[i] = __cosf(rf); ((float*)(p.ws + OFF_ROPE))[S_ * 32 + i] = __sinf(rf); }
    { const int wid = tid >> 6, lane = tid & 63; bf16_t* H = (bf16_t*)(p.ws + OFF_H); unsigned long long* ssqa = (unsigned long long*)(p.ws + OFF_SSQA);
        for (int row = lbid() * 8 + wid; row < S_; row += G * 8) { const float* xr = p.x + (size_t)row * DM; float ssq = 0.f;
#pragma unroll
            for (int i = 0; i < 8; ++i) { const int col = (i * 64 + lane) * 4; const f32x4 x = *(const f32x4*)(xr + col);
                ssq += x[0] * x[0] + x[1] * x[1] + x[2] * x[2] + x[3] * x[3];
                u32x2 w; w.x = cvt_pk_bf16(x[0], x[1]); w.y = cvt_pk_bf16(x[2], x[3]); *(u32x2*)(H + (size_t)row * DM + col) = w; }
            ssq = wave_sum(ssq); if (lane == 0) ssqa[row] = (unsigned long long)(ssq * 1048576.f); } }
}

template <int MODE>
__device__ __forceinline__ void rms_phase(const float* __restrict__ src, const float* __restrict__ g, bf16_t* __restrict__ H, float* __restrict__ Xcopy, float* __restrict__ outf) {
    const int wid = ltid() >> 6, lane = ltid() & 63;
    for (int row = lbid() * 8 + wid; row < S_; row += gridDim.x * 8) {
        const float* xr = src + (size_t)row * DM; f32x4 v[8]; float ssq = 0.f;
#pragma unroll
        for (int i = 0; i < 8; ++i) { v[i] = *(const f32x4*)(xr + (i * 64 + lane) * 4); ssq += v[i][0] * v[i][0] + v[i][1] * v[i][1] + v[i][2] * v[i][2] + v[i][3] * v[i][3]; }
        ssq = wave_sum(ssq);
        const float rstd = rsqrtf(ssq * (1.f / DM) + EPS_);
#pragma unroll
        for (int i = 0; i < 8; ++i) { const int col = (i * 64 + lane) * 4; const f32x4 gv = *(const f32x4*)(g + col);
            const f32x4 y = v[i] * rstd * gv;
            if (MODE == 0) { u32x2 w; w.x = cvt_pk_bf16(y[0], y[1]); w.y = cvt_pk_bf16(y[2], y[3]); *(u32x2*)(H + (size_t)row * DM + col) = w;
                if (Xcopy) *(f32x4*)(Xcopy + (size_t)row * DM + col) = v[i]; }
            else *(f32x4*)(outf + (size_t)row * DM + col) = y; }
    }
}

__device__ __forceinline__ void final_phase(const bf16_t* __restrict__ H, const float* __restrict__ g, float* __restrict__ outf) {
    const int tid = ltid(), wid = tid >> 6, lane = tid & 63;
    for (int row = lbid() * 8 + wid; row < S_; row += gridDim.x * 8) {
        float v[32]; float ssq = 0.f;
#pragma unroll
        for (int i = 0; i < 4; ++i) { float f[8]; unpack8(*(const u32x4*)(H + (size_t)row * DM + (i * 64 + lane) * 8), f);
#pragma unroll
            for (int k = 0; k < 8; ++k) { v[i * 8 + k] = f[k]; ssq += f[k] * f[k]; } }
        ssq = wave_sum(ssq);
        const float rstd = rsqrtf(ssq * (1.f / DM) + EPS_);
#pragma unroll
        for (int i = 0; i < 4; ++i) { const int col = (i * 64 + lane) * 8;
#pragma unroll
            for (int q = 0; q < 2; ++q) { const f32x4 gv = *(const f32x4*)(g + col + q * 4); f32x4 y;
#pragma unroll
                for (int k = 0; k < 4; ++k) y[k] = v[i * 8 + q * 4 + k] * rstd * gv[k];
                *(f32x4*)(outf + (size_t)row * DM + col + q * 4) = y; } }
    }
}

__device__ __forceinline__ void prep_phase(const Params& p, const Bufs& B, int l) {
    const int wid = ltid() >> 6, lane = ltid() & 63;
    const float* wconv = p.w_conv + (size_t)l * 3 * 1024; const float* bg = p.b_gates + l * 16;
    const float* gq = p.g_q_norm + l * 512; const float* gkv = p.g_kv_norm + l * 256;
    for (int s = lbid() * 8 + wid; s < S_; s += gridDim.x * 8) {
        const bf16_t* pr = B.PROJ + (size_t)s * NPROJP;
        const u32x4 z4 = (u32x4){0u, 0u, 0u, 0u};
        u32x4 cm[2], cc[2], cp[2];
#pragma unroll
        for (int hf = 0; hf < 2; ++hf) { const int c0 = lane * 16 + hf * 8;
            cm[hf] = s > 0 ? *(const u32x4*)(pr - NPROJP + c0) : z4; cc[hf] = *(const u32x4*)(pr + c0); cp[hf] = s < S_ - 1 ? *(const u32x4*)(pr + NPROJP + c0) : z4; }
        const int tensor = lane >> 5, head = (lane & 31) >> 3, j0 = (lane & 7) * 4, base = PC_RQ + tensor * 256 + head * 64;
        const u32x2 w1 = *(const u32x2*)(pr + base + j0), w2 = *(const u32x2*)(pr + base + 32 + j0);
        const f32x4 rc4 = *(const f32x4*)(B.RC + (size_t)s * 32 + j0), rs4 = *(const f32x4*)(B.RS + (size_t)s * 32 + j0);
        const u32x4 cqv = *(const u32x4*)(pr + PC_CQ + lane * 8); const u32x2 ckvv = *(const u32x2*)(pr + PC_CKV + lane * 4);
        const int l32 = lane & 31, l16 = lane & 15;
        const bf16_t kr1 = pr[PC_KR + l32], kr2 = pr[PC_KR + 32 + l32]; const float krc = B.RC[(size_t)s * 32 + l32], krs = B.RS[(size_t)s * 32 + l32];
        const bf16_t gt = pr[PC_GATE + l16]; const float bgl = bg[l16];
#pragma unroll
        for (int hf = 0; hf < 2; ++hf) { const int c0 = lane * 16 + hf * 8; float xm[8], x0[8], xp[8], r[8];
            unpack8(cm[hf], xm); unpack8(cc[hf], x0); unpack8(cp[hf], xp);
#pragma unroll
            for (int i = 0; i < 8; ++i) { const float v = xm[i] * wconv[c0 + i] + x0[i] * wconv[1024 + c0 + i] + xp[i] * wconv[2048 + c0 + i]; r[i] = v * __builtin_amdgcn_rcpf(1.f + __expf(-v)); }
            *(u32x4*)(B.QKML + (size_t)s * 1024 + c0) = pack8(r); }
        { const float x1[4] = {bflo(w1.x), bfhi(w1.x), bflo(w1.y), bfhi(w1.y)}, x2[4] = {bflo(w2.x), bfhi(w2.x), bflo(w2.y), bfhi(w2.y)};
            const float sc = tensor ? 0.125f : 1.f; float o1[4], o2[4];
#pragma unroll
            for (int i = 0; i < 4; ++i) { o1[i] = (x1[i] * rc4[i] - x2[i] * rs4[i]) * sc; o2[i] = (x2[i] * rc4[i] + x1[i] * rs4[i]) * sc; }
            u32x2 a, b2; a.x = cvt_pk_bf16(o1[0], o1[1]); a.y = cvt_pk_bf16(o1[2], o1[3]); b2.x = cvt_pk_bf16(o2[0], o2[1]); b2.y = cvt_pk_bf16(o2[2], o2[3]);
            bf16_t* d = B.RQK + (size_t)s * 512 + tensor * 256 + head * 64 + j0; *(u32x2*)d = a; *(u32x2*)(d + 32) = b2; }
        { float f[8]; unpack8(cqv, f); float g4[4] = {bflo(ckvv.x), bfhi(ckvv.x), bflo(ckvv.y), bfhi(ckvv.y)};
            float ssq = 0.f, ssk = g4[0] * g4[0] + g4[1] * g4[1] + g4[2] * g4[2] + g4[3] * g4[3];
#pragma unroll
            for (int i = 0; i < 8; ++i) ssq += f[i] * f[i];
#pragma unroll
            for (int o = 32; o > 0; o >>= 1) { ssq += __shfl_xor(ssq, o); ssk += __shfl_xor(ssk, o); }
            const float rstd = rsqrtf(ssq * (1.f / 512.f) + EPS_), rstk = rsqrtf(ssk * (1.f / 256.f) + EPS_);
#pragma unroll
            for (int i = 0; i < 8; ++i) f[i] = f[i] * rstd * gq[lane * 8 + i];
            *(u32x4*)(B.CQN + (size_t)s * 512 + lane * 8) = pack8(f);
#pragma unroll
            for (int i = 0; i < 4; ++i) g4[i] = g4[i] * rstk * gkv[lane * 4 + i];
            u32x2 o; o.x = cvt_pk_bf16(g4[0], g4[1]); o.y = cvt_pk_bf16(g4[2], g4[3]); *(u32x2*)(B.CKVN + (size_t)s * 256 + lane * 4) = o; }
        if (lane < 32) { const float x1 = bf2f(kr1), x2 = bf2f(kr2);
            const unsigned w = cvt_pk_bf16(x1 * krc - x2 * krs, x2 * krc + x1 * krs);
#pragma unroll
            for (int h = 0; h < 8; ++h) *(unsigned*)(B.K + ((size_t)h * S_ + s) * 192 + 128 + 2 * lane) = w; }
        if (lane < 16) { float v = bf2f(gt) + bgl;
            if ((lane >> 2) & 1) v = fminf(v, 0.f) - log1pf(__expf(-fabsf(v)));
            B.G[(size_t)s * 16 + lane] = v; }
    }
}

constexpr int NSUB = 8;
constexpr int NPHASE = 2 + NLAYER * NSUB;
__global__ void __launch_bounds__(512) mega_fwd(Params p) {
    extern __shared__ __attribute__((aligned(16))) unsigned char lds_raw[];
    LAS unsigned char* lds = (LAS unsigned char*)lds_raw;
    cg::grid_group grid = cg::this_grid();
    const int G = gridDim.x;
    volatile LAS unsigned* xst = (volatile LAS unsigned*)(lds + LDS_BYTES - 16);
    if (threadIdx.x == 0) { xst[0] = 0u; xst[1] = 0u; }
    if (blockIdx.x == 0) { unsigned* bw = (unsigned*)(p.ws + OFF_BAR); for (int i = threadIdx.x; i < XCD_BAR_WORDS; i += 512) bw[i] = 0u; __threadfence(); }
    __syncthreads();
    XcdBarrier xbar; xbar.bar = (unsigned*)(p.ws + OFF_BAR); xbar.x = 0; xbar.st = xst;
    for (int ph = p.ph_lo; ph < p.ph_hi; ++ph) {
        if (ph > p.ph_lo) { if (ph == p.ph_lo + 1) { grid.sync(); xbar = xcd_barrier_post((unsigned*)(p.ws + OFF_BAR), xst); } else xcd_barrier(xbar); }
        const int bx = lbid();
        unsigned char* ws = p.ws; asm volatile("" : "+s"(ws));
        Bufs B;
        B.H = (bf16_t*)(ws + OFF_H); B.Y = (bf16_t*)(ws + OFF_Y); B.QKML = (bf16_t*)(ws + OFF_QKML); B.RQK = (bf16_t*)(ws + OFF_RQK); B.CQN = (bf16_t*)(ws + OFF_CQN);
        B.CKVN = (bf16_t*)(ws + OFF_CKVN); B.CST = (bf16_t*)(ws + OFF_CST); B.RST = (bf16_t*)(ws + OFF_RST); B.PROJ = (bf16_t*)(ws + OFF_PROJ);
        B.Q = (bf16_t*)(ws + OFF_Q); B.K = (bf16_t*)(ws + OFF_K); B.V = (bf16_t*)(ws + OFF_V); B.ACT = (bf16_t*)(ws + OFF_ACT);
        B.X = (float*)(ws + OFF_X); B.RC = (float*)(ws + OFF_ROPE); B.RS = B.RC + S_ * 32; B.G = (float*)(ws + OFF_G); B.CLOC = (float*)(ws + OFF_CLOC);
        B.NLOC = (float*)(ws + OFF_NLOC); B.NST = (float*)(ws + OFF_NST); B.MLOC = (float*)(ws + OFF_MLOC); B.BLAST = (float*)(ws + OFF_BLAST); B.MST = (float*)(ws + OFF_MST);
        B.RLOC = (float*)(ws + OFF_RLOC); B.Wl = nullptr;
        unsigned long long* ssqa = (unsigned long long*)(ws + OFF_SSQA); unsigned long long* ssqb = (unsigned long long*)(ws + OFF_SSQB);
        if (ph == 0) { convert_phase(p, lds); continue; }
        if (ph == NPHASE - 1) { final_phase(B.H, p.g_final, p.out); continue; }
        const int l = (ph - 1) / NSUB, sub = (ph - 1) % NSUB;
        unsigned char* Wl = ws + OFF_W + (size_t)l * SZ_WL;
        pg8::StaticOrder so;
        switch (sub) {
        case 0: { so.init(S_, NPROJP - 512, G, bx, 6, 2); pg8::Gemm g{B.H, (const bf16_t*)(Wl + WO_IN), S_, NPROJP, DM}; pg8::EpiBf16<0> e{B.PROJ, NPROJP, ssqa}; pg8::gemm_phase(lds, g, so, e); } break;
        case 1: prep_phase(p, B, l); break;
        case 2: {
            if (bx < 192) { so.init(S_, 1536, 192, bx); pg8::Gemm g{B.CQN, (const bf16_t*)(Wl + WO_Q), S_, 1536, 512}; pg8::EpiQup e{B.Q, B.RC, B.RS}; pg8::gemm_phase(lds, g, so, e); }
            else { so.init(S_, 512, 64, bx - 192, 0, 6); pg8::Gemm g{B.H, (const bf16_t*)(Wl + WO_IN), S_, NPROJP, DM}; pg8::EpiBf16<0> e{B.PROJ, NPROJP, ssqa}; pg8::gemm_phase(lds, g, so, e); }
            { so.init(S_, 2048, G, bx); pg8::Gemm g{B.CKVN, (const bf16_t*)(Wl + WO_KV), S_, 2048, 256}; pg8::EpiKVup e{B.K, B.V}; pg8::gemm_phase(lds, g, so, e); }
            if (bx < 192) for (int it = bx; it < 1024; it += 192) { if (it < 512) mlstm_local(B, it, lds); else ret_local(B, it - 512, lds); }
        } break;
        case 3: { scan_phase(B);
            for (int i = bx * 512 + ltid(); i < S_; i += G * 512) { ssqa[i] = 0ull; ssqb[i] = 0ull; } } break;
        case 4: {
            for (int it = bx; it < 256; it += G) mlstm_out(B, p.g_ml_out + l * 512, it, lds);
            for (int it = bx; it < 256; it += G) ret_out(B, p.g_ret_out + l * 512, it, lds);
            for (int it = bx; it < 256; it += G) { const int h = it & 7, qb = it >> 3;
                att::attn_body(B.Q + ((size_t)h * S_ + qb * 256) * 192, B.K + (size_t)h * S_ * 192, B.V + (size_t)h * S_ * 128,
                               B.Y + (size_t)(qb * 256) * DM + 1024 + h * 128, S_, (char*)lds_raw); }
        } break;
        case 5: { so.init(S_, DM, G, bx); pg8::Gemm g{B.Y, (const bf16_t*)(Wl + WO_OUT), S_, DM, DM};
 pg8::EpiResid e{B.H, ssqb, DM}; pg8::gemm_phase(lds, g, so, e); } break;
        case 6: { so.init(S_, DFF, G, bx); pg8::Gemm g{B.H, (const bf16_t*)(Wl + WO_1), S_, DFF, DM}; pg8::EpiBf16<1> e{B.ACT, DFF, ssqb}; pg8::gemm_phase(lds, g, so, e); } break;
        case 7: { so.init(S_, DM, G, bx); pg8::Gemm g{B.ACT, (const bf16_t*)(Wl + WO_2), S_, DM, DFF};
            pg8::EpiResid e{B.H, ssqa, DM}; pg8::gemm_phase(lds, g, so, e); } break;
        }
    }
}

#ifndef MK_MULTI
#define MK_MULTI 0
#endif
extern "C" void kernel_launch(void* const* d_in, const int* in_sizes, int n_in, void* d_out, int out_size, void* d_ws, size_t ws_size, hipStream_t stream) {
    static int grid = 0;
    if (grid == 0) {
        if (n_in != 17 || out_size != S_ * DM || ws_size < WS_END) { fprintf(stderr, "kernel_launch: unexpected shapes: n_in %d out %d ws %zu (need %zu)\n", n_in, out_size, ws_size, (size_t)WS_END); grid = -1; return; }
        int dev = 0, cus = 0, per_cu = 0;
        hipGetDevice(&dev); hipDeviceGetAttribute(&cus, hipDeviceAttributeMultiprocessorCount, dev);
        if (hipFuncSetAttribute((const void*)mega_fwd, hipFuncAttributeMaxDynamicSharedMemorySize, LDS_BYTES) != hipSuccess) { fprintf(stderr, "kernel_launch: hipFuncSetAttribute failed\n"); grid = -1; return; }
        if (hipOccupancyMaxActiveBlocksPerMultiprocessor(&per_cu, (const void*)mega_fwd, 512, LDS_BYTES) != hipSuccess || per_cu < 1) { fprintf(stderr, "kernel_launch: occupancy query says %d\n", per_cu); per_cu = 1; }
        (void)hipGetLastError();
        grid = cus * 1;
        fprintf(stderr, "kernel_launch: cus %d per_cu %d grid %d\n", cus, per_cu, grid);
    }
    if (grid < 0) return;
    Params p{};
    p.x = (const float*)d_in[0]; p.pos = (const int*)d_in[1]; p.g_mix = (const float*)d_in[2]; p.w_in = (const float*)d_in[3]; p.b_gates = (const float*)d_in[4];
    p.w_conv = (const float*)d_in[5]; p.g_ml_out = (const float*)d_in[6]; p.g_ret_out = (const float*)d_in[7]; p.g_q_norm = (const float*)d_in[8]; p.w_q_up = (const float*)d_in[9];
    p.g_kv_norm = (const float*)d_in[10]; p.w_kv_up = (const float*)d_in[11]; p.w_out = (const float*)d_in[12]; p.g_ffn = (const float*)d_in[13]; p.w_ff1 = (const float*)d_in[14];
    p.w_ff2 = (const float*)d_in[15]; p.g_final = (const float*)d_in[16]; p.out = (float*)d_out; p.ws = (unsigned char*)d_ws;
#if MK_MULTI
    for (int ph = 0; ph < NPHASE; ++ph) { p.ph_lo = ph; p.ph_hi = ph + 1; hipLaunchKernelGGL(mega_fwd, dim3(grid), dim3(512), LDS_BYTES, stream, p); }
#else
    p.ph_lo = 0; p.ph_hi = NPHASE;
    void* args[] = {&p};
    hipError_t e = hipLaunchCooperativeKernel((const void*)mega_fwd, dim3(grid), dim3(512), args, LDS_BYTES, stream);
    if (e != hipSuccess) fprintf(stderr, "kernel_launch: cooperative launch failed: %s (grid %d)\n", hipGetErrorString(e), grid);
#endif
}
```

```cpp
#include <hip/hip_runtime.h>
#include <hip/hip_cooperative_groups.h>
#include <cstdio>
#include <cstdint>
namespace cg = cooperative_groups;

typedef unsigned short bf16_t;
typedef short bf16x8 __attribute__((ext_vector_type(8)));
typedef short s16x4 __attribute__((ext_vector_type(4)));
typedef float f32x4 __attribute__((ext_vector_type(4)));
typedef float f32x16 __attribute__((ext_vector_type(16)));
typedef unsigned u32x4 __attribute__((ext_vector_type(4)));
typedef unsigned u32x2 __attribute__((ext_vector_type(2)));
#define LAS __attribute__((address_space(3)))

constexpr int S_ = 8192, DM = 2048, NPROJ = 4432, NPROJP = 4608, DFF = 8192, NLAYER = 4;
constexpr float EPS_ = 1e-6f;
constexpr int LDS_BYTES = 147456;

constexpr int PC_MLQ = 0, PC_MLK = 512, PC_MLV = 1024, PC_MLO = 1536, PC_GATE = 2048, PC_RQ = 2064, PC_RK = 2320, PC_RV = 2576, PC_RG = 3088,
              PC_CQ = 3600, PC_CKV = 4112, PC_KR = 4368;

constexpr size_t SZ_WIN = (size_t)NPROJP * DM * 2, SZ_WQ = (size_t)1536 * 512 * 2, SZ_WKV = (size_t)2048 * 256 * 2, SZ_WOUT = (size_t)DM * DM * 2,
                 SZ_W1 = (size_t)DFF * DM * 2, SZ_W2 = (size_t)DM * DFF * 2;
constexpr size_t WO_IN = 0, WO_Q = WO_IN + SZ_WIN, WO_KV = WO_Q + SZ_WQ, WO_OUT = WO_KV + SZ_WKV, WO_1 = WO_OUT + SZ_WOUT, WO_2 = WO_1 + SZ_W1, SZ_WL = WO_2 + SZ_W2;
constexpr size_t OFF_W = 0;
constexpr size_t OFF_X = OFF_W + NLAYER * SZ_WL;
constexpr size_t OFF_H = OFF_X + (size_t)S_ * DM * 4;
constexpr size_t OFF_Y = OFF_H + (size_t)S_ * DM * 2;
constexpr size_t OFF_ROPE = OFF_Y + (size_t)S_ * DM * 2;
constexpr size_t OFF_G = OFF_ROPE + (size_t)S_ * 32 * 4 * 2;
constexpr size_t OFF_QKML = OFF_G + (size_t)S_ * 16 * 4;
constexpr size_t OFF_RQK = OFF_QKML + (size_t)S_ * 1024 * 2;
constexpr size_t OFF_CQN = OFF_RQK + (size_t)S_ * 512 * 2;
constexpr size_t OFF_CKVN = OFF_CQN + (size_t)S_ * 512 * 2;
constexpr size_t OFF_CLOC = OFF_CKVN + (size_t)S_ * 256 * 2;
constexpr size_t OFF_CST = OFF_CLOC + (size_t)512 * 16384 * 4;
constexpr size_t OFF_NLOC = OFF_CST + (size_t)512 * 16384 * 2;
constexpr size_t OFF_NST = OFF_NLOC + (size_t)512 * 128 * 4;
constexpr size_t OFF_MLOC = OFF_NST + (size_t)512 * 128 * 4;
constexpr size_t OFF_BLAST = OFF_MLOC + 2048;
constexpr size_t OFF_MST = OFF_BLAST + 2048;
constexpr size_t OFF_RLOC = OFF_MST + 2048;
constexpr size_t OFF_RST = OFF_RLOC + (size_t)512 * 8192 * 4;
constexpr size_t OFF_BAR = OFF_RST + (size_t)512 * 8192 * 2;
constexpr size_t OFF_SSQA = OFF_BAR + 16384;
constexpr size_t OFF_SSQB = OFF_SSQA + (size_t)S_ * 8;
constexpr size_t OFF_MIX = OFF_SSQB + (size_t)S_ * 8;
constexpr size_t OFF_PROJ = OFF_MIX;
constexpr size_t OFF_Q = OFF_PROJ + (size_t)S_ * NPROJP * 2;
constexpr size_t OFF_K = OFF_Q + (size_t)8 * S_ * 192 * 2;
constexpr size_t OFF_V = OFF_K + (size_t)8 * S_ * 192 * 2;
constexpr size_t OFF_END0 = OFF_V + (size_t)8 * S_ * 128 * 2;
constexpr size_t OFF_ACT = OFF_MIX;
constexpr size_t OFF_END1 = OFF_ACT + (size_t)S_ * DFF * 2;
constexpr size_t WS_END = OFF_END0 > OFF_END1 ? OFF_END0 : OFF_END1;

struct Params {
    const float* x; const int* pos; const float* g_mix; const float* w_in; const float* b_gates; const float* w_conv;
    const float* g_ml_out; const float* g_ret_out; const float* g_q_norm; const float* w_q_up; const float* g_kv_norm; const float* w_kv_up;
    const float* w_out; const float* g_ffn; const float* w_ff1; const float* w_ff2; const float* g_final;
    float* out; unsigned char* ws;
    int ph_lo, ph_hi;
};

__device__ __forceinline__ unsigned cvt_pk_bf16(float lo, float hi) { unsigned r; asm volatile("v_cvt_pk_bf16_f32 %0, %1, %2" : "=v"(r) : "v"(lo), "v"(hi)); return r; }
__device__ __forceinline__ int ltid() { int t = threadIdx.x; asm volatile("" : "+v"(t)); return t; }
__device__ __forceinline__ int lbid() { int t = blockIdx.x; asm volatile("" : "+s"(t)); return t; }
__device__ __forceinline__ float bf2f(bf16_t b) { return __uint_as_float(((unsigned)b) << 16); }
__device__ __forceinline__ float bflo(unsigned w) { return __uint_as_float(w << 16); }
__device__ __forceinline__ float bfhi(unsigned w) { return __uint_as_float(w & 0xffff0000u); }
__device__ __forceinline__ bf16_t f2bf(float f) { return (bf16_t)(cvt_pk_bf16(f, 0.f) & 0xffffu); }
__device__ __forceinline__ float wave_sum(float v) { for (int o = 32; o > 0; o >>= 1) v += __shfl_xor(v, o); return v; }
__device__ __forceinline__ float wave_max(float v) { for (int o = 32; o > 0; o >>= 1) v = fmaxf(v, __shfl_xor(v, o)); return v; }
__device__ __forceinline__ void unpack8(u32x4 w, float* f) { f[0] = bflo(w.x); f[1] = bfhi(w.x); f[2] = bflo(w.y); f[3] = bfhi(w.y); f[4] = bflo(w.z); f[5] = bfhi(w.z); f[6] = bflo(w.w); f[7] = bfhi(w.w); }
__device__ __forceinline__ u32x2 pack8_fp8(const float* f) { int a = 0, b = 0;
    a = __builtin_amdgcn_cvt_pk_fp8_f32(f[0], f[1], a, false); a = __builtin_amdgcn_cvt_pk_fp8_f32(f[2], f[3], a, true);
    b = __builtin_amdgcn_cvt_pk_fp8_f32(f[4], f[5], b, false); b = __builtin_amdgcn_cvt_pk_fp8_f32(f[6], f[7], b, true);
    u32x2 w; w.x = (unsigned)a; w.y = (unsigned)b; return w; }
__device__ __forceinline__ u32x4 pack8(const float* f) { u32x4 w; w.x = cvt_pk_bf16(f[0], f[1]); w.y = cvt_pk_bf16(f[2], f[3]); w.z = cvt_pk_bf16(f[4], f[5]); w.w = cvt_pk_bf16(f[6], f[7]); return w; }


#define XB_TMO      128
#define XB_XCNT(j)  (256  + 64 * (j))
#define XB_XSUB(j)  (1280 + 64 * (j))
#define XB_XGEN(j)  (2304 + 64 * (j))
#define XB_TOP      3328
#define XB_TOPGEN   3392
#define XCD_BAR_WORDS 3456
#define XB_SPIN_CAP (1u << 18)

__device__ __forceinline__ unsigned xb_ld(unsigned* p)              { return __hip_atomic_load(p, __ATOMIC_RELAXED, __HIP_MEMORY_SCOPE_AGENT); }
__device__ __forceinline__ unsigned xb_add(unsigned* p, unsigned v) { return __hip_atomic_fetch_add(p, v, __ATOMIC_RELAXED, __HIP_MEMORY_SCOPE_AGENT); }
__device__ __forceinline__ unsigned xb_xcc_id() { return (unsigned)__builtin_amdgcn_s_getreg((3 << 11) | 20) & 0xFu; }
#define XB_SPIN(cond, bar) do { unsigned _sp = 0; while (cond) { __builtin_amdgcn_s_sleep(1); \
    if ((++_sp & 255u) == 0u) { if (xb_ld(&(bar)[XB_TMO])) break; if (_sp > XB_SPIN_CAP) { atomicAdd(&(bar)[XB_TMO], 1u); break; } } } } while (0)

struct XcdBarrier {
    unsigned* bar; unsigned x;
    volatile LAS unsigned* st;
};

__device__ __forceinline__ XcdBarrier xcd_barrier_post(unsigned* bar, volatile LAS unsigned* st) {
    XcdBarrier b; b.bar = bar; b.x = xb_xcc_id(); b.st = st;
    if (threadIdx.x == 0) (void)xb_add(&bar[XB_XCNT(b.x)], 1u);
    return b;
}
__device__ __forceinline__ void xcd_barrier_complete(unsigned* bar, unsigned x, unsigned& nloc, unsigned& nx) {
    const unsigned G = gridDim.x * gridDim.y * gridDim.z;
    unsigned sum, cnt, mine, sp = 0u;
    for (;;) {
        sum = 0u; cnt = 0u; mine = 0u;
#pragma unroll
        for (unsigned j = 0; j < 16; ++j) { const unsigned c = xb_ld(&bar[XB_XCNT(j)]); sum += c; cnt += (c > 0u) ? 1u : 0u; mine = (j == x) ? c : mine; }
        if (sum == G) break;
        __builtin_amdgcn_s_sleep(1);
        if ((++sp & 255u) == 0u) { if (xb_ld(&bar[XB_TMO])) break; if (sp > XB_SPIN_CAP) { atomicAdd(&bar[XB_TMO], 1u); break; } }
    }
    nloc = mine > 0u ? mine : 1u; nx = cnt > 0u ? cnt : 1u;
}

__device__ __forceinline__ void xcd_barrier(const XcdBarrier& b) {
    asm volatile("s_waitcnt vmcnt(0)" ::: "memory");
    __syncthreads();
    if (threadIdx.x == 0) {
        unsigned* bar = b.bar;
        __builtin_amdgcn_s_waitcnt(0);
        unsigned nloc = b.st[0], nx = b.st[1];
        if (nloc == 0u) { xcd_barrier_complete(bar, b.x, nloc, nx); b.st[0] = nloc; b.st[1] = nx; }
        const unsigned old = xb_add(&bar[XB_XSUB(b.x)], 1u);
        const unsigned gen = old / nloc;
        if (old + 1u == (gen + 1u) * nloc) {
            __builtin_amdgcn_fence(__ATOMIC_RELEASE, "agent");
            asm volatile("s_waitcnt vmcnt(0)" ::: "memory");
            const unsigned og = xb_add(&bar[XB_TOP], 1u);
            const unsigned tg = og / nx;
            if (og + 1u == (tg + 1u) * nx) xb_add(&bar[XB_TOPGEN], 1u);
            else XB_SPIN(xb_ld(&bar[XB_TOPGEN]) == tg, bar);
            __builtin_amdgcn_fence(__ATOMIC_ACQUIRE, "agent");
            xb_add(&bar[XB_XGEN(b.x)], 1u);
            asm volatile("s_waitcnt vmcnt(0)" ::: "memory");
        } else {
            XB_SPIN(xb_ld(&bar[XB_XGEN(b.x)]) == gen, bar);
            __builtin_amdgcn_fence(__ATOMIC_ACQUIRE, "agent");
            asm volatile("s_waitcnt vmcnt(0)" ::: "memory");
        }
    }
    __syncthreads();
}

namespace pg8 {
constexpr int BM = 256, BK = 64, HALF = 128, HTB = HALF * BK * 2, STAGE_BYTES = 8 * HTB, NXCD = 8, WGM = 8;
__host__ __device__ __forceinline__ int lds_byte(int r, int c) { const int st = (r >> 4) * 2 + (c >> 5), rr = r & 15, cc = c & 31, ob = rr * 64 + cc * 2; return st * 1024 + (ob ^ (((ob >> 9) & 1) << 5)); }
__host__ __device__ __forceinline__ void stage_rc(int b, int& R, int& C) { const int st = b / 1024, sb = b % 1024, swz = sb ^ (((sb >> 9) & 1) << 5); R = (st >> 1) * 16 + swz / 64; C = (st & 1) * 32 + (swz % 64) / 2; }
__host__ __device__ __forceinline__ int perm32(int rho) { const int n = rho >> 4, i = rho & 15; return 8 * (i >> 2) + 4 * n + (i & 3); }
struct Unit { int pm, pn; };
struct Gemm { const bf16_t* A; const bf16_t* Bt; int M, N, K; };
struct StaticOrder {
    int nM, nN, nwg, G, c, skip_lo, skip_n, ioff = 0, icnt = 1 << 20;
    __device__ void init(int M, int N, int G_, int c_, int slo = 1 << 20, int sn = 0) { nM = M / BM; nN = N / BM; nwg = nM * nN; G = G_; c = c_; skip_lo = slo; skip_n = sn; }
    __device__ bool next(int i, Unit& u) const {
        if (i >= icnt) return false; const long L = (long)(i + ioff) * G + c; if (L >= nwg) return false;
        int wgid = (int)L; { const int q = nwg / NXCD, r = nwg % NXCD, xcd = wgid % NXCD, off = wgid / NXCD; wgid = (xcd < r ? xcd * (q + 1) : r * (q + 1) + (xcd - r) * q) + off; }
        const int nig = WGM * nN, gid = wgid / nig, fm = gid * WGM, gsz = (nM - fm) < WGM ? (nM - fm) : WGM;
        u.pm = fm + ((wgid % nig) % gsz); u.pn = (wgid % nig) / gsz; if (u.pn >= skip_lo) u.pn += skip_n; return true;
    }
};
template <class Epi>
__device__ __forceinline__ void gemm_phase(LAS unsigned char* lds, const Gemm g, const StaticOrder& S, const Epi& E) {
    const int tid = ltid(), wid = __builtin_amdgcn_readfirstlane(tid >> 6), lane = tid & 63, wr = wid >> 2, wc = wid & 3, fr = lane & 15, fq = lane >> 4;
    int K = g.K; asm volatile("" : "+s"(K)); const int nt = K / BK;
    unsigned voffA[2], voffB[2];
#pragma unroll
    for (int i = 0; i < 2; ++i) { int R, C; stage_rc(tid * 16 + i * 8192, R, C); const int Rb = Epi::PERM ? ((R & ~31) + perm32(R & 31)) : R;
        voffA[i] = (unsigned)(R * K + C) * 2u; voffB[i] = (unsigned)(Rb * K + C) * 2u; }
    const size_t kstep = (size_t)(BK * 2);
    const size_t hstep = (size_t)HALF * K * 2;
    const size_t tstep = 2 * hstep;
    const unsigned ldsw = (unsigned)wid * 1024u;
    const int aoff = lds_byte(wr * 64 + fr, fq * 8), boff = lds_byte(wc * 32 + fr, fq * 8);
#define PG8_SA(b, h) (((b) * 2 + (h)) * HTB)
#define PG8_SB(b, h) ((4 + (b) * 2 + (h)) * HTB)
#define PG8_STAGE(bufoff, gbase, voff) do { _Pragma("unroll") for (int _i = 0; _i < 2; ++_i) \
        __builtin_amdgcn_global_load_lds((const unsigned*)((const char*)(gbase) + (voff)[_i]), (LAS unsigned*)(lds + (bufoff) + ldsw + _i * 8192), 16, 0, 0); } while (0)
#define PG8_LDA(dst, b, h) do { _Pragma("unroll") for (int m = 0; m < 4; ++m) _Pragma("unroll") for (int k = 0; k < 2; ++k) dst[m][k] = *(const LAS bf16x8*)(lds + PG8_SA(b, h) + aoff + m * 2048 + k * 1024); } while (0)
#define PG8_LDB(dst, b, h) do { _Pragma("unroll") for (int n = 0; n < 2; ++n) _Pragma("unroll") for (int k = 0; k < 2; ++k) dst[n][k] = *(const LAS bf16x8*)(lds + PG8_SB(b, h) + boff + n * 2048 + k * 1024); } while (0)
#define PG8_MMA(ai, bj, At, Bt) do { __builtin_amdgcn_s_setprio(1); _Pragma("unroll") for (int m = 0; m < 4; ++m) _Pragma("unroll") for (int n = 0; n < 2; ++n) _Pragma("unroll") for (int k = 0; k < 2; ++k) \
        acc[ai][bj][m][n] = __builtin_amdgcn_mfma_f32_16x16x32_bf16(Bt[n][k], At[m][k], acc[ai][bj][m][n], 0, 0, 0); __builtin_amdgcn_s_setprio(0); } while (0)
#define PG8_WAIT_V(n) asm volatile("s_waitcnt vmcnt(" #n ")" ::: "memory")
#define PG8_WAIT_L(n) asm volatile("s_waitcnt lgkmcnt(" #n ")" ::: "memory")
#define PG8_BAR __builtin_amdgcn_s_barrier()
#define PG8_SCHED __builtin_amdgcn_sched_barrier(0)
    Unit cur, nxt; int ui = 0;
    if (!S.next(0, cur)) return;
    f32x4 acc[2][2][4][2];
#pragma unroll
    for (int a = 0; a < 2; ++a)
#pragma unroll
        for (int b = 0; b < 2; ++b)
#pragma unroll
            for (int m = 0; m < 4; ++m)
#pragma unroll
                for (int n = 0; n < 2; ++n) acc[a][b][m][n] = (f32x4){0.f, 0.f, 0.f, 0.f};
    bf16x8 At[4][2], B0[2][2], B1[2][2];
    const char* cA = (const char*)g.A + (size_t)cur.pm * tstep; const char* cB = (const char*)g.Bt + (size_t)cur.pn * tstep;
    if (Epi::PRE) E.stash(E.prefetch(cur.pm, tid), lds, 0, tid);
    PG8_STAGE(PG8_SB(0, 0), cB, voffB); PG8_STAGE(PG8_SA(0, 0), cA, voffA); PG8_STAGE(PG8_SB(0, 1), cB + hstep, voffB); PG8_STAGE(PG8_SA(0, 1), cA + hstep, voffA);
    if (wr == 1) PG8_BAR;
    PG8_WAIT_V(4); PG8_BAR;
    PG8_STAGE(PG8_SB(1, 0), cB + kstep, voffB); PG8_STAGE(PG8_SA(1, 0), cA + kstep, voffA); PG8_STAGE(PG8_SB(1, 1), cB + hstep + kstep, voffB);
    PG8_WAIT_V(6); PG8_BAR;
    for (;;) {
        const bool has_next = S.next(ui + 1, nxt);
        const char* nA = has_next ? (const char*)g.A + (size_t)nxt.pm * tstep : cA; const char* nB = has_next ? (const char*)g.Bt + (size_t)nxt.pn * tstep : cB;
        for (int t = 0; t < nt; t += 2) {
            const bool last = (t == nt - 2);
            const char* a1 = cA + (size_t)(t + 1) * kstep;
            const char* a2 = last ? nA : cA + (size_t)(t + 2) * kstep; const char* b2 = last ? nB : cB + (size_t)(t + 2) * kstep;
            const char* a3 = a2 + kstep; const char* b3 = b2 + kstep;
            PG8_LDB(B0, 0, 0); PG8_SCHED; PG8_LDA(At, 0, 0); PG8_STAGE(PG8_SA(1, 1), a1 + hstep, voffA);
            PG8_WAIT_L(8); PG8_BAR; PG8_WAIT_L(0); PG8_MMA(0, 0, At, B0); PG8_BAR; PG8_SCHED;
            PG8_LDB(B1, 0, 1); PG8_STAGE(PG8_SB(0, 0), b2, voffB);
            PG8_BAR; PG8_WAIT_L(0); PG8_MMA(0, 1, At, B1); PG8_BAR;
            PG8_LDA(At, 0, 1); PG8_STAGE(PG8_SA(0, 0), a2, voffA);
            PG8_BAR; PG8_WAIT_L(0); PG8_MMA(1, 0, At, B0); PG8_BAR; PG8_SCHED;
            PG8_STAGE(PG8_SB(0, 1), b2 + hstep, voffB);
            PG8_WAIT_V(6); PG8_BAR; PG8_MMA(1, 1, At, B1); PG8_BAR;
            PG8_LDB(B0, 1, 0); PG8_SCHED; PG8_LDA(At, 1, 0); PG8_STAGE(PG8_SA(0, 1), a2 + hstep, voffA);
            PG8_WAIT_L(8); PG8_BAR; PG8_WAIT_L(0); PG8_MMA(0, 0, At, B0); PG8_BAR; PG8_SCHED;
            PG8_LDB(B1, 1, 1); PG8_STAGE(PG8_SB(1, 0), b3, voffB);
            PG8_BAR; PG8_WAIT_L(0); PG8_MMA(0, 1, At, B1); PG8_BAR;
            PG8_LDA(At, 1, 1); PG8_STAGE(PG8_SA(1, 0), a3, voffA);
            PG8_BAR; PG8_WAIT_L(0); PG8_MMA(1, 0, At, B0); PG8_BAR; PG8_SCHED;
            PG8_STAGE(PG8_SB(1, 1), b3 + hstep, voffB);
            PG8_WAIT_V(6); PG8_BAR; PG8_MMA(1, 1, At, B1); PG8_BAR;
        }
        E(acc, cur, wr, wc, fr, fq, lds, ui & 1, has_next ? nxt.pm : -1, tid);
        if (!has_next) break;
#pragma unroll
        for (int a = 0; a < 2; ++a)
#pragma unroll
            for (int b = 0; b < 2; ++b)
#pragma unroll
                for (int m = 0; m < 4; ++m)
#pragma unroll
                    for (int n = 0; n < 2; ++n) acc[a][b][m][n] = (f32x4){0.f, 0.f, 0.f, 0.f};
        cur = nxt; cA = nA; cB = nB; ++ui;
    }
    PG8_WAIT_V(0);
    if (wr == 0) PG8_BAR;
    PG8_BAR;
#undef PG8_SA
#undef PG8_SB
#undef PG8_STAGE
#undef PG8_LDA
#undef PG8_LDB
#undef PG8_MMA
#undef PG8_WAIT_V
#undef PG8_WAIT_L
#undef PG8_BAR
#undef PG8_SCHED
}

template <int ACT> struct EpiBf16 {
    static constexpr bool PERM = true, PRE = true;
    bf16_t* O; int ldc; const unsigned long long* ssq;
    __device__ __forceinline__ unsigned long long prefetch(int pm, int tid) const { return tid < 256 ? ssq[pm * BM + tid] : 0ull; }
    __device__ __forceinline__ void stash(unsigned long long v, LAS unsigned char* lds, int par, int tid) const { if (tid < 256) *(LAS float*)(lds + 131072 + par * 1024 + tid * 4) = rsqrtf((float)v * (1.f / (1048576.f * DM)) + EPS_); }
    __device__ __forceinline__ void operator()(const f32x4 (&acc)[2][2][4][2], const Unit& u, int wr, int wc, int fr, int fq, LAS unsigned char* lds, int par, int npm, int tid) const {
        const int row0 = u.pm * BM + wr * 64 + fr, col0 = u.pn * BM + wc * 32 + 8 * fq;
        unsigned long long nx = 0ull; if (npm >= 0) nx = prefetch(npm, tid);
#pragma unroll
        for (int ai = 0; ai < 2; ++ai)
#pragma unroll
            for (int m = 0; m < 4; ++m) { const int row = row0 + ai * HALF + m * 16; bf16_t* rowp = O + (size_t)row * ldc + col0;
                const float rstd = *(const LAS float*)(lds + 131072 + par * 1024 + (wr * 64 + fr + ai * HALF + m * 16) * 4);
#pragma unroll
                for (int bj = 0; bj < 2; ++bj) { f32x4 v0 = acc[ai][bj][m][0] * rstd, v1 = acc[ai][bj][m][1] * rstd;
                    if (ACT == 1) {
#pragma unroll
                        for (int j = 0; j < 4; ++j) { const float a = fmaxf(v0[j], 0.f), b = fmaxf(v1[j], 0.f); v0[j] = a * a; v1[j] = b * b; } }
                    u32x4 w; w.x = cvt_pk_bf16(v0[0], v0[1]); w.y = cvt_pk_bf16(v0[2], v0[3]); w.z = cvt_pk_bf16(v1[0], v1[1]); w.w = cvt_pk_bf16(v1[2], v1[3]);
                    *(u32x4*)(rowp + bj * HALF) = w; } }
        if (npm >= 0) stash(nx, lds, par ^ 1, tid);
    }
};
struct EpiResid {
    static constexpr bool PERM = true, PRE = false;
    __device__ __forceinline__ unsigned long long prefetch(int, int) const { return 0ull; }
    __device__ __forceinline__ void stash(unsigned long long, LAS unsigned char*, int, int) const {}
    bf16_t* Hb; unsigned long long* ssq; int ldc;
    __device__ __forceinline__ void operator()(const f32x4 (&acc)[2][2][4][2], const Unit& u, int wr, int wc, int fr, int fq, LAS unsigned char* lds, int par, int npm, int tid) const {
        const int row0 = u.pm * BM + wr * 64 + fr, col0 = u.pn * BM + wc * 32 + 8 * fq;
        u32x4 old[2][4][2];
#pragma unroll
        for (int ai = 0; ai < 2; ++ai)
#pragma unroll
            for (int m = 0; m < 4; ++m)
#pragma unroll
                for (int bj = 0; bj < 2; ++bj) old[ai][m][bj] = *(const u32x4*)(Hb + (size_t)(row0 + ai * HALF + m * 16) * ldc + col0 + bj * HALF);
#pragma unroll
        for (int ai = 0; ai < 2; ++ai)
#pragma unroll
            for (int m = 0; m < 4; ++m) { const int row = row0 + ai * HALF + m * 16; bf16_t* hp = Hb + (size_t)row * ldc + col0;
                float part = 0.f;
#pragma unroll
                for (int bj = 0; bj < 2; ++bj) { float o[8]; unpack8(old[ai][m][bj], o);
                    const f32x4 a0 = acc[ai][bj][m][0], a1 = acc[ai][bj][m][1];
                    float v[8] = {o[0] + a0[0], o[1] + a0[1], o[2] + a0[2], o[3] + a0[3], o[4] + a1[0], o[5] + a1[1], o[6] + a1[2], o[7] + a1[3]};
#pragma unroll
                    for (int k = 0; k < 8; ++k) part += v[k] * v[k];
                    *(u32x4*)(hp + bj * HALF) = pack8(v); }
                part += __shfl_xor(part, 16); part += __shfl_xor(part, 32);
                if (fq == 0) atomicAdd(ssq + row, (unsigned long long)(part * 1048576.f)); }
    }
};
struct EpiQup {
    static constexpr bool PERM = true, PRE = false;
    __device__ __forceinline__ unsigned long long prefetch(int, int) const { return 0ull; }
    __device__ __forceinline__ void stash(unsigned long long, LAS unsigned char*, int, int) const {}
    unsigned char* Q; const float* rc; const float* rs;
    __device__ __forceinline__ void operator()(const f32x4 (&acc)[2][2][4][2], const Unit& u, int wr, int wc, int fr, int fq, LAS unsigned char* lds, int par, int npm, int tid) const {
        const int row0 = u.pm * BM + wr * 64 + fr;
        if (u.pn < 4) {
            unsigned char* d0 = Q + ((size_t)(u.pn * 2) * S_ + row0) * 192 + wc * 32 + 8 * fq;
#pragma unroll
            for (int ai = 0; ai < 2; ++ai)
#pragma unroll
                for (int m = 0; m < 4; ++m)
#pragma unroll
                    for (int bj = 0; bj < 2; ++bj) { const f32x4 v0 = acc[ai][bj][m][0], v1 = acc[ai][bj][m][1];
                        const float f[8] = {v0[0], v0[1], v0[2], v0[3], v1[0], v1[1], v1[2], v1[3]};
                        *(u32x2*)(d0 + (size_t)(ai * HALF + m * 16) * 192 + (size_t)bj * S_ * 192) = pack8_fp8(f); }
        } else {
            const int jj0 = (wc & 1) * 32 + 8 * fq, j0 = jj0 >> 1;
            unsigned char* d0 = Q + ((size_t)((u.pn - 4) * 4 + (wc >> 1)) * S_ + row0) * 192 + 128 + jj0;
            const float* c0 = rc + (size_t)row0 * 32 + j0; const float* s0 = rs + (size_t)row0 * 32 + j0;
            f32x4 cv[2][4], sv[2][4];
#pragma unroll
            for (int ai = 0; ai < 2; ++ai)
#pragma unroll
                for (int m = 0; m < 4; ++m) { const int ro = ai * HALF + m * 16; cv[ai][m] = *(const f32x4*)(c0 + ro * 32); sv[ai][m] = *(const f32x4*)(s0 + ro * 32); }
#pragma unroll
            for (int ai = 0; ai < 2; ++ai)
#pragma unroll
                for (int m = 0; m < 4; ++m) { const int ro = ai * HALF + m * 16; const f32x4 c = cv[ai][m], s = sv[ai][m];
#pragma unroll
                    for (int bj = 0; bj < 2; ++bj) { const f32x4 v0 = acc[ai][bj][m][0], v1 = acc[ai][bj][m][1];
                        const float f[8] = {v0[0] * c[0] - v0[1] * s[0], v0[1] * c[0] + v0[0] * s[0], v0[2] * c[1] - v0[3] * s[1], v0[3] * c[1] + v0[2] * s[1],
                                            v1[0] * c[2] - v1[1] * s[2], v1[1] * c[2] + v1[0] * s[2], v1[2] * c[3] - v1[3] * s[3], v1[3] * c[3] + v1[2] * s[3]};
                        *(u32x2*)(d0 + (size_t)ro * 192 + (size_t)bj * 2 * S_ * 192) = pack8_fp8(f); } }
        }
    }
};
struct EpiKVup {
    static constexpr bool PERM = true, PRE = false;
    __device__ __forceinline__ unsigned long long prefetch(int, int) const { return 0ull; }
    __device__ __forceinline__ void stash(unsigned long long, LAS unsigned char*, int, int) const {}
    unsigned char* Kb; bf16_t* Vb;
    template <int LD> __device__ __forceinline__ void put(const f32x4 (&acc)[2][2][4][2], bf16_t* d0) const {
#pragma unroll
        for (int ai = 0; ai < 2; ++ai)
#pragma unroll
            for (int m = 0; m < 4; ++m)
#pragma unroll
                for (int bj = 0; bj < 2; ++bj) { const f32x4 v0 = acc[ai][bj][m][0], v1 = acc[ai][bj][m][1];
                    u32x4 w; w.x = cvt_pk_bf16(v0[0], v0[1]); w.y = cvt_pk_bf16(v0[2], v0[3]); w.z = cvt_pk_bf16(v1[0], v1[1]); w.w = cvt_pk_bf16(v1[2], v1[3]);
                    *(u32x4*)(d0 + (size_t)(ai * HALF + m * 16) * LD + (size_t)bj * S_ * LD) = w; }
    }
    __device__ __forceinline__ void operator()(const f32x4 (&acc)[2][2][4][2], const Unit& u, int wr, int wc, int fr, int fq, LAS unsigned char* lds, int par, int npm, int tid) const {
        const int row0 = u.pm * BM + wr * 64 + fr;
        if (u.pn < 4) { unsigned char* d0 = Kb + ((size_t)(u.pn * 2) * S_ + row0) * 192 + wc * 32 + 8 * fq;
#pragma unroll
            for (int ai = 0; ai < 2; ++ai)
#pragma unroll
                for (int m = 0; m < 4; ++m)
#pragma unroll
                    for (int bj = 0; bj < 2; ++bj) { const f32x4 v0 = acc[ai][bj][m][0], v1 = acc[ai][bj][m][1];
                        const float f[8] = {v0[0], v0[1], v0[2], v0[3], v1[0], v1[1], v1[2], v1[3]};
                        *(u32x2*)(d0 + (size_t)(ai * HALF + m * 16) * 192 + (size_t)bj * S_ * 192) = pack8_fp8(f); } }
        else put<128>(acc, Vb + ((size_t)((u.pn - 4) * 2) * S_ + row0) * 128 + wc * 32 + 8 * fq);
    }
};
}

namespace att {
constexpr int DQ = 192, DV = 128, NW = 8, QBLK = 32, KVBLK = 64;
constexpr float SCALE = 0.07216878364870322f;
constexpr float THR = 8.f;
#ifndef ATT_SDEPTH
#define ATT_SDEPTH 1
#endif
constexpr int SDEPTH = ATT_SDEPTH;
#ifndef ATT_NQREG
#define ATT_NQREG 12
#endif
constexpr int NQREG = ATT_NQREG;
constexpr int LDQ = 192, LDKK = 192, LDVV = 128, LDO = 2048;
constexpr int SHM_V = KVBLK * DV * 2, SHM_K = KVBLK * 200, SHM_QR = 2 * SHM_V + 2 * SHM_K + NW * 64 * 4, SHM_ATTN = SHM_QR + NW * (12 - NQREG) * 64 * 16;
#define KSWZ(row, colB) ((row) * 200 + (colB))
#define SBAR() __builtin_amdgcn_sched_barrier(0)
__device__ __forceinline__ int crow(int r, int hi) { return (r & 3) + 8 * (r >> 2) + 4 * hi; }
__device__ __forceinline__ void partialSM(f32x16& p0, f32x16& p1, float& m_reg, float& mn, float& alpha) {
  constexpr float C = SCALE * 1.4426950408889634f;
  float pmax = p0[0]; for (int r = 1; r < 16; ++r) pmax = fmaxf(pmax, p0[r]); for (int r = 0; r < 16; ++r) pmax = fmaxf(pmax, p1[r]);
  { auto rr = __builtin_amdgcn_permlane32_swap(__float_as_uint(pmax), __float_as_uint(pmax), false, false);
    pmax = fmaxf(__uint_as_float(rr[0]), __uint_as_float(rr[1])); }
  if (__builtin_expect(__all(pmax - m_reg <= THR / SCALE), 1)) { mn = m_reg; alpha = 1.f; }
  else { mn = fmaxf(m_reg, pmax); alpha = __builtin_amdgcn_exp2f((m_reg - mn) * C); m_reg = mn; }
  float mnC = -mn * C;
  for (int r = 0; r < 16; ++r) p0[r] = fmaf(p0[r], C, mnC); for (int r = 0; r < 16; ++r) p1[r] = fmaf(p1[r], C, mnC);
  for (int r = 0; r < 16; ++r) p0[r] = __builtin_amdgcn_exp2f(p0[r]);
}
__device__ __forceinline__ void finishSM(f32x16& p0, f32x16& p1, float alpha, float& l_reg, bf16x8& pa0, bf16x8& pa1, bf16x8& pa2, bf16x8& pa3) {
  for (int r = 0; r < 16; ++r) p1[r] = __builtin_amdgcn_exp2f(p1[r]);
  float ps = 0; for (int r = 0; r < 16; ++r) ps += p0[r]; for (int r = 0; r < 16; ++r) ps += p1[r];
  { auto rr = __builtin_amdgcn_permlane32_swap(__float_as_uint(ps), __float_as_uint(ps), false, false);
    ps = __uint_as_float(rr[0]) + __uint_as_float(rr[1]); }
  l_reg = l_reg * alpha + ps;
#define PK4(P, BASE, OUT) do { unsigned a0 = cvt_pk_bf16(P[BASE + 0], P[BASE + 1]), a1 = cvt_pk_bf16(P[BASE + 2], P[BASE + 3]);   \
    unsigned b0 = cvt_pk_bf16(P[BASE + 4], P[BASE + 5]), b1 = cvt_pk_bf16(P[BASE + 6], P[BASE + 7]);                              \
    auto r0 = __builtin_amdgcn_permlane32_swap(a0, b0, false, false); auto r1 = __builtin_amdgcn_permlane32_swap(a1, b1, false, false); \
    u32x4 w = {r0[0], r1[0], r0[1], r1[1]}; OUT = *reinterpret_cast<bf16x8*>(&w); } while (0)
  PK4(p0, 0, pa0); PK4(p0, 8, pa1); PK4(p1, 0, pa2); PK4(p1, 8, pa3);
#undef PK4
}
__device__ __forceinline__ void qkt(f32x16& p0, f32x16& p1, const unsigned char* Ks, const long* qr, int r32, int hi) {
  p0 = f32x16{}; p1 = f32x16{};
#pragma unroll
  for (int d0 = 0; d0 < 12; ++d0) { const int cb = d0 * 16 + hi * 8;
    const long b0 = *reinterpret_cast<const long*>(Ks + KSWZ(r32, cb));
    const long b1 = *reinterpret_cast<const long*>(Ks + KSWZ(32 + r32, cb));
    p0 = __builtin_amdgcn_mfma_f32_32x32x16_fp8_fp8(b0, qr[d0], p0, 0, 0, 0);
    p1 = __builtin_amdgcn_mfma_f32_32x32x16_fp8_fp8(b1, qr[d0], p1, 0, 0, 0); }
}
__device__ __forceinline__ int v_st(int k, int c) { const int kk = (k & ~0xC) | ((k & 4) << 1) | ((k & 8) >> 1); return ((kk >> 3) * 4 + (c >> 5)) * 512 + ((kk & 7) * 32 + (c & 31)) * 2; }
__device__ __forceinline__ int v_rd_base(int lane) { return ((lane & 3) << 3) | (((lane >> 2) & 3) << 6) | (((lane >> 4) & 1) << 5) | (((lane >> 5) & 1) << 8); }
constexpr int v_rd_off(int d0, int ks, int half) { return d0 * 512 + ks * 4096 + half * 2048; }
template <int OFF> __device__ __forceinline__ s16x4 tr_read(int vb) {
  s16x4 r; asm volatile("ds_read_b64_tr_b16 %0, %1 offset:%2" : "=&v"(r) : "v"(vb), "i"(OFF) : "memory"); return r;
}
template <int D0> __device__ __forceinline__ void pv_one(f32x16& od, int vb, bf16x8 pa0, bf16x8 pa1, bf16x8 pa2, bf16x8 pa3) {
  const s16x4 l0 = tr_read<v_rd_off(D0, 0, 0)>(vb), h0 = tr_read<v_rd_off(D0, 0, 1)>(vb), l1 = tr_read<v_rd_off(D0, 1, 0)>(vb), h1 = tr_read<v_rd_off(D0, 1, 1)>(vb);
  const s16x4 l2 = tr_read<v_rd_off(D0, 2, 0)>(vb), h2 = tr_read<v_rd_off(D0, 2, 1)>(vb), l3 = tr_read<v_rd_off(D0, 3, 0)>(vb), h3 = tr_read<v_rd_off(D0, 3, 1)>(vb);
  asm volatile("s_waitcnt lgkmcnt(0)" ::: "memory"); SBAR();
#define PK(L, H) (bf16x8){L[0], L[1], L[2], L[3], H[0], H[1], H[2], H[3]}
  od = __builtin_amdgcn_mfma_f32_32x32x16_bf16(pa0, PK(l0, h0), od, 0, 0, 0);
  od = __builtin_amdgcn_mfma_f32_32x32x16_bf16(pa1, PK(l1, h1), od, 0, 0, 0);
  od = __builtin_amdgcn_mfma_f32_32x32x16_bf16(pa2, PK(l2, h2), od, 0, 0, 0);
  od = __builtin_amdgcn_mfma_f32_32x32x16_bf16(pa3, PK(l3, h3), od, 0, 0, 0);
#undef PK
}
__device__ __forceinline__ void pv_d0(f32x16* o, int vb, bf16x8 pa0, bf16x8 pa1, bf16x8 pa2, bf16x8 pa3) {
  pv_one<0>(o[0], vb, pa0, pa1, pa2, pa3); pv_one<1>(o[1], vb, pa0, pa1, pa2, pa3); pv_one<2>(o[2], vb, pa0, pa1, pa2, pa3); pv_one<3>(o[3], vb, pa0, pa1, pa2, pa3);
}
__device__ __forceinline__ void attn_body(const unsigned char* __restrict__ Qb, const unsigned char* __restrict__ Kh, const bf16_t* __restrict__ Vh,
                                          bf16_t* __restrict__ Ob, int seq, char* lds) {
  const int tid = ltid(), wid = tid >> 6, lane = tid & 63, r32 = lane & 31, hi = lane >> 5;
  bf16_t* V_lds = (bf16_t*)lds; unsigned char* K_lds = (unsigned char*)(lds + 2 * SHM_V);
  float* ws = (float*)(lds + 2 * SHM_V + 2 * SHM_K) + wid * 64; float* li_l = ws; float* al_l = ws + 32;
  float m_reg = -1e30f, l_reg = 0; f32x16 o[4] = {}; long qr[12];
  const unsigned char* Qw = Qb + (long)(wid * QBLK + r32) * 192 + hi * 8;
#pragma unroll
  for (int d0 = 0; d0 < 12; ++d0) qr[d0] = *reinterpret_cast<const long*>(Qw + d0 * 16);
  const int sr = tid >> 4, sc = (tid & 15) * 8, vst0 = v_st(sr, sc), vst1 = v_st(32 + sr, sc);
  const int kw0 = KSWZ(tid / 12, (tid % 12) * 16), kw1 = KSWZ((tid + 512) / 12, ((tid + 512) % 12) * 16);
  const bool k2 = tid < 256;
  const int vb0 = (int)(uintptr_t)V_lds + v_rd_base(lane);
  struct { bf16x8 vs0, vs1; u32x4 ks0, ks1; } sr_[SDEPTH];
#define SLOAD(i, k0) do { sr_[i].vs0 = *(const bf16x8*)(&Vh[(long)((k0) + sr) * LDVV + sc]); sr_[i].vs1 = *(const bf16x8*)(&Vh[(long)((k0) + 32 + sr) * LDVV + sc]); \
    { const unsigned char* kt_ = Kh + (size_t)(k0) * 192; sr_[i].ks0 = *(const u32x4*)(kt_ + tid * 16); if (k2) sr_[i].ks1 = *(const u32x4*)(kt_ + 8192 + tid * 16); } } while (0)
#define SWRITE(b, i) do { *(bf16x8*)((char*)V_lds + (b) * SHM_V + vst0) = sr_[i].vs0;          \
    *(bf16x8*)((char*)V_lds + (b) * SHM_V + vst1) = sr_[i].vs1;               \
    { unsigned char* kd_ = K_lds + (b) * SHM_K; u32x2 lo_ = {sr_[i].ks0.x, sr_[i].ks0.y}, hi_ = {sr_[i].ks0.z, sr_[i].ks0.w}; \
      *(u32x2*)(kd_ + kw0) = lo_; *(u32x2*)(kd_ + kw0 + 8) = hi_; \
      if (k2) { u32x2 lo2_ = {sr_[i].ks1.x, sr_[i].ks1.y}, hi2_ = {sr_[i].ks1.z, sr_[i].ks1.w}; *(u32x2*)(kd_ + kw1) = lo2_; *(u32x2*)(kd_ + kw1 + 8) = hi2_; } } } while (0)
#define SWAIT() do { if constexpr (SDEPTH == 2) asm volatile("s_waitcnt vmcnt(5)" ::: "memory"); else asm volatile("s_waitcnt vmcnt(0)" ::: "memory"); } while (0)
#define RESC(a) do { if (__any((a) < 1.f)) { if (hi == 0) al_l[r32] = (a); asm volatile("s_waitcnt lgkmcnt(0)" ::: "memory"); \
    for (int d = 0; d < 4; ++d) for (int r = 0; r < 16; ++r) o[d][r] *= al_l[crow(r, hi)]; } } while (0)
  f32x16 pA0, pA1, pB0, pB1; float mnA, mnB, alA, alB; bf16x8 pa0, pa1, pa2, pa3; const int NT = seq / KVBLK;
  constexpr int SE = 0, SO = SDEPTH - 1;
  SLOAD(SE, 0); asm volatile("s_waitcnt vmcnt(0)" ::: "memory"); SWRITE(0, SE); __syncthreads();
  qkt(pA0, pA1, K_lds, qr, r32, hi); partialSM(pA0, pA1, m_reg, mnA, alA);
  SLOAD(SO, KVBLK); if constexpr (SDEPTH == 2) { if (2 < NT) SLOAD(SE, 2 * KVBLK); }
  SWAIT(); SWRITE(1, SO); __syncthreads();
  for (int j = 1; j + 1 < NT; j += 2) {
    SBAR(); qkt(pB0, pB1, K_lds + SHM_K, qr, r32, hi);
    finishSM(pA0, pA1, alA, l_reg, pa0, pa1, pa2, pa3); SBAR();
    SLOAD(SO, (j + SDEPTH) * KVBLK); SBAR();
    pv_d0(o, vb0, pa0, pa1, pa2, pa3); partialSM(pB0, pB1, m_reg, mnB, alB);
    __syncthreads(); SWAIT(); SWRITE(0, SE);
    RESC(alB); __syncthreads();
    SBAR(); qkt(pA0, pA1, K_lds, qr, r32, hi);
    finishSM(pB0, pB1, alB, l_reg, pa0, pa1, pa2, pa3); SBAR();
    if (SDEPTH == 1 || j + 3 < NT) SLOAD(SE, (j + 1 + SDEPTH) * KVBLK); SBAR();
    pv_d0(o, vb0 + (int)SHM_V, pa0, pa1, pa2, pa3); partialSM(pA0, pA1, m_reg, mnA, alA);
    __syncthreads(); SWAIT(); SWRITE(1, SO);
    RESC(alA); __syncthreads();
  }
  SBAR(); qkt(pB0, pB1, K_lds + SHM_K, qr, r32, hi);
  finishSM(pA0, pA1, alA, l_reg, pa0, pa1, pa2, pa3); SBAR();
  pv_d0(o, vb0, pa0, pa1, pa2, pa3); partialSM(pB0, pB1, m_reg, mnB, alB);
  __syncthreads(); RESC(alB);
  finishSM(pB0, pB1, alB, l_reg, pa0, pa1, pa2, pa3); SBAR();
  pv_d0(o, vb0 + (int)SHM_V, pa0, pa1, pa2, pa3);
  if (hi == 0) li_l[r32] = l_reg; asm volatile("s_waitcnt lgkmcnt(0)" ::: "memory");
  float rli[16];
#pragma unroll
  for (int r = 0; r < 16; ++r) rli[r] = __builtin_amdgcn_rcpf(li_l[crow(r, hi)]);
  bf16_t* Ow = Ob + (long)(wid * QBLK) * LDO;
#pragma unroll
  for (int r = 0; r < 16; ++r) { int orow = crow(r, hi);
    for (int d0 = 0; d0 < 4; ++d0) Ow[(long)orow * LDO + d0 * 32 + r32] = f2bf(o[d0][r] * rli[r]); }
  asm volatile("s_waitcnt vmcnt(0)" ::: "memory");
  __syncthreads();
#undef SLOAD
#undef SWRITE
#undef SWAIT
#undef RESC
}
}

template <int K, int NT>
__device__ __forceinline__ void mma_tile(f32x4 (&acc)[4][NT], const LAS bf16_t* A, int lda, const LAS bf16_t* Bt, int ldb, int wr, int wc, int fr, int fq) {
#pragma unroll 1
    for (int k0 = 0; k0 < K; k0 += 32) {
        bf16x8 a[4], b[NT];
#pragma unroll
        for (int m = 0; m < 4; ++m) a[m] = *(const LAS bf16x8*)(A + (64 * wr + 16 * m + fr) * lda + k0 + fq * 8);
#pragma unroll
        for (int n = 0; n < NT; ++n) b[n] = *(const LAS bf16x8*)(Bt + (16 * NT * wc + 16 * n + fr) * ldb + k0 + fq * 8);
#pragma unroll
        for (int m = 0; m < 4; ++m)
#pragma unroll
            for (int n = 0; n < NT; ++n) acc[m][n] = __builtin_amdgcn_mfma_f32_16x16x32_bf16(a[m], b[n], acc[m][n], 0, 0, 0);
    }
}
template <int NT> __device__ __forceinline__ void zero_acc(f32x4 (&acc)[4][NT]) {
#pragma unroll
    for (int m = 0; m < 4; ++m)
#pragma unroll
        for (int n = 0; n < NT; ++n) acc[m][n] = (f32x4){0.f, 0.f, 0.f, 0.f};
}
template <int R, int C> __device__ __forceinline__ void stage_N(LAS bf16_t* dst, int ld, const bf16_t* __restrict__ src, size_t ldg) {
    constexpr int CH = C / 8;
    for (int idx = ltid(); idx < R * CH; idx += 512) { const int r = idx / CH, c = (idx % CH) * 8;
        *(LAS u32x4*)(dst + r * ld + c) = *(const u32x4*)(src + (size_t)r * ldg + c); }
}
template <int C, bool SCL> __device__ __forceinline__ void stage_T(LAS bf16_t* dst, int ld, const bf16_t* __restrict__ src, size_t ldg, const LAS float* sc) {
    for (int idx = ltid(); idx < 128 * (C / 8); idx += 512) { const int r = idx & 127, c0 = (idx >> 7) * 8;
        const u32x4 w = *(const u32x4*)(src + (size_t)r * ldg + c0); float f[8]; unpack8(w, f);
        float s = 1.f; if (SCL) s = sc[r];
#pragma unroll
        for (int i = 0; i < 8; ++i) dst[(c0 + i) * ld + r] = f2bf(f[i] * s); }
}
template <int R, int C> __device__ __forceinline__ void ld_N(u32x4 (&r)[R * C / 8 / 512], const bf16_t* __restrict__ src, size_t ldg, int tid) {
    constexpr int CH = C / 8;
#pragma unroll
    for (int i = 0; i < R * CH / 512; ++i) { const int idx = tid + 512 * i, rr = idx / CH, c = (idx % CH) * 8; r[i] = *(const u32x4*)(src + (size_t)rr * ldg + c); }
}
template <int R, int C> __device__ __forceinline__ void st_N(LAS bf16_t* dst, int ld, const u32x4 (&r)[R * C / 8 / 512], int tid) {
    constexpr int CH = C / 8;
#pragma unroll
    for (int i = 0; i < R * CH / 512; ++i) { const int idx = tid + 512 * i, rr = idx / CH, c = (idx % CH) * 8; *(LAS u32x4*)(dst + rr * ld + c) = r[i]; }
}
template <int C> __device__ __forceinline__ void ld_T(u32x4 (&r)[128 * C / 8 / 512], const bf16_t* __restrict__ src, size_t ldg, int tid) {
#pragma unroll
    for (int i = 0; i < 128 * C / 8 / 512; ++i) { const int idx = tid + 512 * i, rr = idx & 127, c0 = (idx >> 7) * 8; r[i] = *(const u32x4*)(src + (size_t)rr * ldg + c0); }
}
template <int C, bool SCL> __device__ __forceinline__ void st_T(LAS bf16_t* dst, int ld, const u32x4 (&r)[128 * C / 8 / 512], const LAS float* sc, int tid) {
#pragma unroll
    for (int i = 0; i < 128 * C / 8 / 512; ++i) { const int idx = tid + 512 * i, rr = idx & 127, c0 = (idx >> 7) * 8;
        if (SCL) { float f[8]; unpack8(r[i], f); const float sv = sc[rr];
#pragma unroll
            for (int k = 0; k < 8; ++k) dst[(c0 + k) * ld + rr] = f2bf(f[k] * sv); }
        else { const unsigned w[4] = {r[i].x, r[i].y, r[i].z, r[i].w};
#pragma unroll
            for (int k = 0; k < 4; ++k) { dst[(c0 + 2 * k) * ld + rr] = (bf16_t)(w[k] & 0xffffu); dst[(c0 + 2 * k + 1) * ld + rr] = (bf16_t)(w[k] >> 16); } } }
}
__device__ __forceinline__ float scan_add64(float v, int lane) {
#pragma unroll
    for (int o = 1; o < 64; o <<= 1) { const float t = __shfl_up(v, o); if (lane >= o) v += t; } return v; }
__device__ __forceinline__ float scan_max64(float v, int lane) {
#pragma unroll
    for (int o = 1; o < 64; o <<= 1) { const float t = __shfl_up(v, o); if (lane >= o) v = fmaxf(v, t); } return v; }

constexpr int CB0 = 0, CB1 = 34816, CB2 = 69632, CB3 = 104448, CVEC = 139264;
constexpr int RQB = 0, RKB = 18432, RST_ = 36864, RVT = 71680, RRT = 106496;

struct Bufs {
    bf16_t *Wl, *H, *Y, *QKML, *RQK, *CQN, *CKVN, *CST, *RST, *PROJ, *Q, *K, *V, *ACT;
    float *X, *RC, *RS, *G, *CLOC, *NLOC, *NST, *MLOC, *BLAST, *MST, *RLOC;
};

__device__ __forceinline__ void mlstm_local(const Bufs& B, int item, LAS unsigned char* lds) {
    const int tid = ltid(), wid = tid >> 6, lane = tid & 63, wr = wid >> 2, wc = wid & 3, fr = lane & 15, fq = lane >> 4;
    const int c = item & 63, h = (item >> 6) & 3, dir = item >> 8, s0 = c * 128;
    LAS bf16_t* T0 = (LAS bf16_t*)(lds + CB0); LAS bf16_t* T1 = (LAS bf16_t*)(lds + CB1); LAS float* ve = (LAS float*)(lds + CVEC);
    u32x4 rk[4], rv[4];
    ld_T<128>(rk, B.QKML + (size_t)s0 * 1024 + 512 + h * 128, 1024, tid);
    ld_T<128>(rv, B.PROJ + (size_t)s0 * NPROJP + PC_MLV + h * 128, NPROJP, tid);
    if (wid == 0) {
        const int l0 = 2 * lane, l1 = l0 + 1, p0 = dir ? 127 - l0 : l0, p1 = dir ? 127 - l1 : l1, gi = 8 * dir + h, gf = gi + 4;
        const float li0 = B.G[(size_t)(s0 + p0) * 16 + gi], lf0 = B.G[(size_t)(s0 + p0) * 16 + gf], li1 = B.G[(size_t)(s0 + p1) * 16 + gi], lf1 = B.G[(size_t)(s0 + p1) * 16 + gf];
        const float t = lf0 + lf1, incl = scan_add64(t, lane), b0 = incl - t + lf0, b1 = incl, btot = __shfl(incl, 63);
        const float w0 = btot - b0 + li0, w1 = btot - b1 + li1, mloc = wave_max(fmaxf(w0, w1));
        ve[p0] = __expf(w0 - mloc); ve[p1] = __expf(w1 - mloc);
        if (lane == 0) { B.MLOC[item] = mloc; B.BLAST[item] = btot; }
    }
    st_T<128, false>(T0, 136, rk, ve, tid);
    __syncthreads();
    st_T<128, true>(T1, 136, rv, ve, tid);
    __syncthreads();
    f32x4 acc[4][2]; zero_acc<2>(acc);
    mma_tile<128, 2>(acc, T1, 136, T0, 136, wr, wc, fr, fq);
    float* dst = B.CLOC + (size_t)item * 16384;
#pragma unroll
    for (int m = 0; m < 4; ++m)
#pragma unroll
        for (int n = 0; n < 2; ++n)
#pragma unroll
            for (int j = 0; j < 4; ++j) dst[(64 * wr + 16 * m + 4 * fq + j) * 128 + 32 * wc + 16 * n + fr] = acc[m][n][j];
    { const int dk = tid >> 2, qd = tid & 3; float s = 0.f;
#pragma unroll
        for (int i = 0; i < 4; ++i) { float kv[8]; unpack8(*(const LAS u32x4*)(T0 + dk * 136 + qd * 32 + i * 8), kv);
#pragma unroll
            for (int k = 0; k < 8; ++k) s += kv[k] * ve[qd * 32 + i * 8 + k]; }
        s += __shfl_xor(s, 1); s += __shfl_xor(s, 2);
        if (qd == 0) B.NLOC[(size_t)item * 128 + dk] = s; }
    __syncthreads();
}

__device__ __forceinline__ void ret_local(const Bufs& B, int item, LAS unsigned char* lds) {
    const int tid = ltid(), wid = tid >> 6, lane = tid & 63, wr = wid >> 2, wc = wid & 3, fr = lane & 15, fq = lane >> 4;
    const int c = item & 63, h = (item >> 6) & 3, dir = item >> 8, s0 = c * 128, hd = dir ? 3 - h : h;
    const float lg = log1pf(-exp2f(-5.f - (float)hd));
    LAS bf16_t* T0 = (LAS bf16_t*)(lds + CB0); LAS bf16_t* T1 = (LAS bf16_t*)(lds + CB1); LAS float* vz = (LAS float*)(lds + CVEC);
    u32x4 rk[2], rv[4];
    ld_T<64>(rk, B.RQK + (size_t)s0 * 512 + 256 + h * 64, 512, tid);
    ld_T<128>(rv, B.PROJ + (size_t)s0 * NPROJP + PC_RV + h * 128, NPROJP, tid);
    if (tid < 128) { const int lp = dir ? 127 - tid : tid; vz[tid] = __expf((float)(127 - lp) * lg); }
    st_T<64, false>(T0, 136, rk, vz, tid);
    __syncthreads();
    st_T<128, true>(T1, 136, rv, vz, tid);
    __syncthreads();
    f32x4 acc[4][1]; zero_acc<1>(acc);
    mma_tile<128, 1>(acc, T1, 136, T0, 136, wr, wc, fr, fq);
    float* dst = B.RLOC + (size_t)item * 8192;
#pragma unroll
    for (int m = 0; m < 4; ++m)
#pragma unroll
        for (int j = 0; j < 4; ++j) dst[(64 * wr + 16 * m + 4 * fq + j) * 64 + 16 * wc + fr] = acc[m][0][j];
    __syncthreads();
}

__device__ __forceinline__ void scan_phase(const Bufs& B) {
    const int gt = lbid() * 512 + ltid();
    if (gt < 131072) {
        const int dh = gt >> 14, idx = gt & 16383, dir = dh >> 2;
        float cst = 0.f, nst = 0.f, m = -1e30f;
#pragma unroll 1
        for (int s0 = 0; s0 < 64; s0 += 16) {
            float cl[16], ml[16], bl[16], nl[16];
#pragma unroll
            for (int u = 0; u < 16; ++u) { const int ch = dir ? 63 - (s0 + u) : s0 + u, it = dh * 64 + ch;
                cl[u] = B.CLOC[(size_t)it * 16384 + idx]; ml[u] = B.MLOC[it]; bl[u] = B.BLAST[it]; nl[u] = idx < 128 ? B.NLOC[(size_t)it * 128 + idx] : 0.f; }
#pragma unroll
            for (int u = 0; u < 16; ++u) { const int ch = dir ? 63 - (s0 + u) : s0 + u, it = dh * 64 + ch;
                B.CST[(size_t)it * 16384 + idx] = f2bf(cst);
                if (idx < 128) { B.NST[(size_t)it * 128 + idx] = nst; if (idx == 0) B.MST[it] = m; }
                const float mnew = fmaxf(bl[u] + m, ml[u]), a = __expf(bl[u] + m - mnew), g = __expf(ml[u] - mnew);
                cst = a * cst + g * cl[u]; nst = a * nst + g * nl[u]; m = mnew; }
        }
    }
    if (gt < 65536) {
        const int dh = gt >> 13, idx = gt & 8191, dir = dh >> 2, h = dh & 3, hd = dir ? 3 - h : h;
        const float cd = __expf(128.f * log1pf(-exp2f(-5.f - (float)hd)));
        float r = 0.f;
#pragma unroll 1
        for (int s0 = 0; s0 < 64; s0 += 16) {
            float rl[16];
#pragma unroll
            for (int u = 0; u < 16; ++u) { const int ch = dir ? 63 - (s0 + u) : s0 + u; rl[u] = B.RLOC[(size_t)(dh * 64 + ch) * 8192 + idx]; }
#pragma unroll
            for (int u = 0; u < 16; ++u) { const int ch = dir ? 63 - (s0 + u) : s0 + u; B.RST[(size_t)(dh * 64 + ch) * 8192 + idx] = f2bf(r); r = cd * r + rl[u]; }
        }
    }
}

__device__ __forceinline__ void mlstm_out(const Bufs& B, const float* __restrict__ g_out, int item, LAS unsigned char* lds) {
    const int tid = ltid(), wid = tid >> 6, lane = tid & 63, wr = wid >> 2, wc = wid & 3, fr = lane & 15, fq = lane >> 4;
    const int c = item >> 2, h = item & 3, s0 = c * 128;
    constexpr float SC = 0.08838834764831845f;
    LAS bf16_t* T0 = (LAS bf16_t*)(lds + CB0); LAS bf16_t* T1 = (LAS bf16_t*)(lds + CB1); LAS bf16_t* T2 = (LAS bf16_t*)(lds + CB2); LAS bf16_t* T3 = (LAS bf16_t*)(lds + CB3);
    LAS float* vea = (LAS float*)(lds + CVEC); LAS float* veM = vea + 256; LAS float* vedn = vea + 512; LAS float* vn = vea + 768; LAS float* vqn = vea + 1024;
    LAS float* vrs = vea + 1280; LAS float* vf = vea + 1408; LAS float* vsc = vea + 1536;
    LAS float* HT = (LAS float*)(lds + CB1);
    const float mst0 = B.MST[(0 * 4 + h) * 64 + c], mst1 = B.MST[(1 * 4 + h) * 64 + c];
    { u32x4 rq[4], rk[4], rv[4], rc[4];
        ld_N<128, 128>(rq, B.QKML + (size_t)s0 * 1024 + h * 128, 1024, tid);
        ld_N<128, 128>(rk, B.QKML + (size_t)s0 * 1024 + 512 + h * 128, 1024, tid);
        ld_T<128>(rv, B.PROJ + (size_t)s0 * NPROJP + PC_MLV + h * 128, NPROJP, tid);
        ld_N<128, 128>(rc, B.CST + (size_t)((0 * 4 + h) * 64 + c) * 16384, 128, tid);
        st_N<128, 128>(T0, 136, rq, tid); st_N<128, 128>(T1, 136, rk, tid); st_T<128, false>(T2, 136, rv, vea, tid); st_N<128, 128>(T3, 136, rc, tid); }
    if (wid < 2) {
        const int dir = wid; const float mst = dir ? mst1 : mst0;
        const int l0 = 2 * lane, l1 = l0 + 1, p0 = dir ? 127 - l0 : l0, p1 = dir ? 127 - l1 : l1, gi = 8 * dir + h, gf = gi + 4;
        const float li0 = B.G[(size_t)(s0 + p0) * 16 + gi], lf0 = B.G[(size_t)(s0 + p0) * 16 + gf], li1 = B.G[(size_t)(s0 + p1) * 16 + gi], lf1 = B.G[(size_t)(s0 + p1) * 16 + gf];
        const float t = lf0 + lf1, incl = scan_add64(t, lane), b0 = incl - t + lf0, b1 = incl;
        const float a0 = li0 - b0, a1 = li1 - b1, inm = scan_max64(fmaxf(a0, a1), lane);
        float exm = __shfl_up(inm, 1); if (lane == 0) exm = -3.0e38f;
        const float A0 = fmaxf(exm, a0), A1 = inm, amax = __shfl(inm, 63), cc = fmaxf(amax, mst);
        const float M0 = fmaxf(A0, mst), M1 = fmaxf(A1, mst);
        vea[dir * 128 + p0] = __expf(a0 - cc); vea[dir * 128 + p1] = __expf(a1 - cc);
        veM[dir * 128 + p0] = __expf(cc - M0) * SC; veM[dir * 128 + p1] = __expf(cc - M1) * SC;
        vedn[dir * 128 + p0] = __expf(-(b0 + M0)); vedn[dir * 128 + p1] = __expf(-(b1 + M1));
        if (lane == 0) vsc[dir] = __expf(mst - cc);
    }
    if (tid < 256) { const int dir = tid >> 7, d = tid & 127; vn[tid] = B.NST[(size_t)((dir * 4 + h) * 64 + c) * 128 + d]; }
    __syncthreads();
    f32x4 accS[4][2]; zero_acc<2>(accS);
    mma_tile<128, 2>(accS, T1, 136, T0, 136, wr, wc, fr, fq);
    { const int row = tid >> 2, qd = tid & 3; float q0 = 0.f, q1 = 0.f;
#pragma unroll
        for (int i = 0; i < 4; ++i) { float qv[8]; unpack8(*(const LAS u32x4*)(T0 + row * 136 + qd * 32 + i * 8), qv);
            const f32x4 n0a = *(const LAS f32x4*)(vn + qd * 32 + i * 8), n0b = *(const LAS f32x4*)(vn + qd * 32 + i * 8 + 4);
            const f32x4 n1a = *(const LAS f32x4*)(vn + 128 + qd * 32 + i * 8), n1b = *(const LAS f32x4*)(vn + 128 + qd * 32 + i * 8 + 4);
#pragma unroll
            for (int k = 0; k < 4; ++k) { q0 += qv[k] * n0a[k] + qv[4 + k] * n0b[k]; q1 += qv[k] * n1a[k] + qv[4 + k] * n1b[k]; } }
        q0 += __shfl_xor(q0, 1); q0 += __shfl_xor(q0, 2); q1 += __shfl_xor(q1, 1); q1 += __shfl_xor(q1, 2);
        if (qd == 0) { vqn[row] = q0; vqn[128 + row] = q1; } }
    __syncthreads();
    f32x4 hacc[4][2]; zero_acc<2>(hacc);
    u32x4 rc1[4]; ld_N<128, 128>(rc1, B.CST + (size_t)((1 * 4 + h) * 64 + c) * 16384, 128, tid);
#pragma unroll 1
    for (int dir = 0; dir < 2; ++dir) {
        if (dir == 1) st_N<128, 128>(T3, 136, rc1, tid);
        const float r = vsc[dir];
#pragma unroll
        for (int m = 0; m < 4; ++m)
#pragma unroll
            for (int n = 0; n < 2; ++n) { const int l = 32 * wc + 16 * n + fr, sb = 64 * wr + 16 * m + 4 * fq;
                const f32x4 e4 = *(const LAS f32x4*)(vea + dir * 128 + sb); float v[4];
#pragma unroll
                for (int j = 0; j < 4; ++j) { const int s = sb + j; const bool ok = dir ? (s >= l) : (s <= l); v[j] = ok ? accS[m][n][j] * e4[j] : 0.f; }
                u32x2 w; w.x = cvt_pk_bf16(v[0], v[1]); w.y = cvt_pk_bf16(v[2], v[3]);
                *(LAS u32x2*)(T1 + l * 136 + sb) = w; }
        __syncthreads();
        { const int row = tid >> 2, qd = tid & 3; float s = 0.f;
#pragma unroll
            for (int i = 0; i < 4; ++i) { float sv[8]; unpack8(*(const LAS u32x4*)(T1 + row * 136 + qd * 32 + i * 8), sv);
#pragma unroll
                for (int k = 0; k < 8; ++k) s += sv[k]; }
            s += __shfl_xor(s, 1); s += __shfl_xor(s, 2);
            if (qd == 0) { const float eM = veM[dir * 128 + row], den = eM * (s + r * vqn[dir * 128 + row]);
                vf[row] = eM / fmaxf(fabsf(den), vedn[dir * 128 + row]); } }
        f32x4 accN[4][2]; zero_acc<2>(accN);
        mma_tile<128, 2>(accN, T0, 136, T3, 136, wr, wc, fr, fq);
#pragma unroll
        for (int m = 0; m < 4; ++m)
#pragma unroll
            for (int n = 0; n < 2; ++n) accN[m][n] *= r;
        mma_tile<128, 2>(accN, T1, 136, T2, 136, wr, wc, fr, fq);
        __syncthreads();
#pragma unroll
        for (int m = 0; m < 4; ++m) { const f32x4 f4 = *(const LAS f32x4*)(vf + 64 * wr + 16 * m + 4 * fq);
#pragma unroll
            for (int n = 0; n < 2; ++n) hacc[m][n] += accN[m][n] * f4; }
        __syncthreads();
    }
    const int erow = tid >> 2, eqd = tid & 3, es = s0 + erow;
    u32x4 og4[4]; f32x4 gp4[8];
    { const bf16_t* og = B.PROJ + (size_t)es * NPROJP + PC_MLO + h * 128 + eqd * 32; const float* gp = g_out + h * 128 + eqd * 32;
#pragma unroll
        for (int i = 0; i < 4; ++i) og4[i] = *(const u32x4*)(og + i * 8);
#pragma unroll
        for (int i = 0; i < 8; ++i) gp4[i] = *(const f32x4*)(gp + i * 4); }
#pragma unroll
    for (int m = 0; m < 4; ++m)
#pragma unroll
        for (int n = 0; n < 2; ++n)
#pragma unroll
            for (int j = 0; j < 4; ++j) HT[(64 * wr + 16 * m + 4 * fq + j) * 132 + 32 * wc + 16 * n + fr] = hacc[m][n][j];
    __syncthreads();
    { float ssq = 0.f; f32x4 x4[8];
#pragma unroll
        for (int i = 0; i < 8; ++i) { x4[i] = *(const LAS f32x4*)(HT + erow * 132 + eqd * 32 + i * 4);
            ssq += x4[i][0] * x4[i][0] + x4[i][1] * x4[i][1] + x4[i][2] * x4[i][2] + x4[i][3] * x4[i][3]; }
        ssq += __shfl_xor(ssq, 1); ssq += __shfl_xor(ssq, 2);
        const float rstd = rsqrtf(ssq * (1.f / 128.f) + EPS_);
        bf16_t* yo = B.Y + (size_t)es * DM + h * 128 + eqd * 32;
#pragma unroll
        for (int i = 0; i < 4; ++i) { float o8[8]; unpack8(og4[i], o8); float r8[8];
#pragma unroll
            for (int k = 0; k < 8; ++k) { const float sg = __builtin_amdgcn_rcpf(1.f + __expf(-o8[k])); r8[k] = sg * x4[2 * i + (k >> 2)][k & 3] * rstd * gp4[2 * i + (k >> 2)][k & 3]; }
            *(u32x4*)(yo + i * 8) = pack8(r8); } }
    __syncthreads();
}

__device__ __forceinline__ void ret_out(const Bufs& B, const float* __restrict__ g_out, int item, LAS unsigned char* lds) {
    const int tid = ltid(), wid = tid >> 6, lane = tid & 63, wr = wid >> 2, wc = wid & 3, fr = lane & 15, fq = lane >> 4;
    const int c = item >> 2, h = item & 3, s0 = c * 128;
    LAS bf16_t* QB = (LAS bf16_t*)(lds + RQB); LAS bf16_t* KB = (LAS bf16_t*)(lds + RKB); LAS bf16_t* ST = (LAS bf16_t*)(lds + RST_); LAS bf16_t* VT = (LAS bf16_t*)(lds + RVT); LAS bf16_t* RT = (LAS bf16_t*)(lds + RRT);
    LAS float* HT = (LAS float*)(lds + RST_); LAS float* vcs = (LAS float*)(lds + CVEC); LAS float* vrw = vcs + 256;
    u32x4 rr1[2];
    { u32x4 rq[2], rk[2], rv[4], rr0[2];
        ld_N<128, 64>(rq, B.RQK + (size_t)s0 * 512 + h * 64, 512, tid);
        ld_N<128, 64>(rk, B.RQK + (size_t)s0 * 512 + 256 + h * 64, 512, tid);
        ld_T<128>(rv, B.PROJ + (size_t)s0 * NPROJP + PC_RV + h * 128, NPROJP, tid);
        ld_N<128, 64>(rr0, B.RST + (size_t)((0 * 4 + h) * 64 + c) * 8192, 64, tid);
        ld_N<128, 64>(rr1, B.RST + (size_t)((1 * 4 + h) * 64 + c) * 8192, 64, tid);
        st_N<128, 64>(QB, 72, rq, tid); st_N<128, 64>(KB, 72, rk, tid); st_T<128, false>(VT, 136, rv, HT, tid); st_N<128, 64>(RT, 72, rr0, tid); }
    if (tid < 256) { const int dir = tid >> 7, p = tid & 127, lp = dir ? 127 - p : p, hd = dir ? 3 - h : h; const float lg = log1pf(-exp2f(-5.f - (float)hd));
        vcs[tid] = __expf(-(float)lp * lg); vrw[tid] = __expf((float)lp * lg); }
    __syncthreads();
    f32x4 accS[4][2]; zero_acc<2>(accS);
    mma_tile<64, 2>(accS, KB, 72, QB, 72, wr, wc, fr, fq);
    f32x4 yacc[4][2]; zero_acc<2>(yacc);
#pragma unroll 1
    for (int dir = 0; dir < 2; ++dir) {
        const int hd = dir ? 3 - h : h; const float gam = 1.f - exp2f(-5.f - (float)hd);
        if (dir == 1) st_N<128, 64>(RT, 72, rr1, tid);
#pragma unroll
        for (int m = 0; m < 4; ++m)
#pragma unroll
            for (int n = 0; n < 2; ++n) { const int l = 32 * wc + 16 * n + fr, sb = 64 * wr + 16 * m + 4 * fq;
                const f32x4 c4 = *(const LAS f32x4*)(vcs + dir * 128 + sb); float v[4];
#pragma unroll
                for (int j = 0; j < 4; ++j) { const int s = sb + j; const bool ok = dir ? (s >= l) : (s <= l); v[j] = ok ? accS[m][n][j] * c4[j] : 0.f; }
                u32x2 w; w.x = cvt_pk_bf16(v[0], v[1]); w.y = cvt_pk_bf16(v[2], v[3]);
                *(LAS u32x2*)(ST + l * 136 + sb) = w; }
        __syncthreads();
        f32x4 accR[4][2]; zero_acc<2>(accR);
        mma_tile<64, 2>(accR, QB, 72, RT, 72, wr, wc, fr, fq);
#pragma unroll
        for (int m = 0; m < 4; ++m)
#pragma unroll
            for (int n = 0; n < 2; ++n) accR[m][n] *= gam;
        mma_tile<128, 2>(accR, ST, 136, VT, 136, wr, wc, fr, fq);
        __syncthreads();
#pragma unroll
        for (int m = 0; m < 4; ++m) { const f32x4 r4 = *(const LAS f32x4*)(vrw + dir * 128 + 64 * wr + 16 * m + 4 * fq);
#pragma unroll
            for (int n = 0; n < 2; ++n) yacc[m][n] += accR[m][n] * r4; }
    }
    const int erow = tid >> 2, eqd = tid & 3, es = s0 + erow;
    u32x4 og4[4]; f32x4 gp4[8];
    { const bf16_t* gg = B.PROJ + (size_t)es * NPROJP + PC_RG + h * 128 + eqd * 32; const float* gp = g_out + h * 128 + eqd * 32;
#pragma unroll
        for (int i = 0; i < 4; ++i) og4[i] = *(const u32x4*)(gg + i * 8);
#pragma unroll
        for (int i = 0; i < 8; ++i) gp4[i] = *(const f32x4*)(gp + i * 4); }
#pragma unroll
    for (int m = 0; m < 4; ++m)
#pragma unroll
        for (int n = 0; n < 2; ++n)
#pragma unroll
            for (int j = 0; j < 4; ++j) HT[(64 * wr + 16 * m + 4 * fq + j) * 132 + 32 * wc + 16 * n + fr] = yacc[m][n][j];
    __syncthreads();
    { float ssq = 0.f; f32x4 x4[8];
#pragma unroll
        for (int i = 0; i < 8; ++i) { x4[i] = *(const LAS f32x4*)(HT + erow * 132 + eqd * 32 + i * 4);
            ssq += x4[i][0] * x4[i][0] + x4[i][1] * x4[i][1] + x4[i][2] * x4[i][2] + x4[i][3] * x4[i][3]; }
        ssq += __shfl_xor(ssq, 1); ssq += __shfl_xor(ssq, 2);
        const float rstd = rsqrtf(ssq * (1.f / 128.f) + EPS_);
        bf16_t* yo = B.Y + (size_t)es * DM + 512 + h * 128 + eqd * 32;
#pragma unroll
        for (int i = 0; i < 4; ++i) { float o8[8]; unpack8(og4[i], o8); float r8[8];
#pragma unroll
            for (int k = 0; k < 8; ++k) { const float sl = o8[k] * __builtin_amdgcn_rcpf(1.f + __expf(-o8[k])); r8[k] = sl * x4[2 * i + (k >> 2)][k & 3] * rstd * gp4[2 * i + (k >> 2)][k & 3]; }
            *(u32x4*)(yo + i * 8) = pack8(r8); } }
    __syncthreads();
}

__device__ __forceinline__ int map_col(int n, int mode) {
    if (mode == 1) { const int h = n / 192, d = n % 192; if (d < 128) return h * 128 + d; const int jj = d - 128; return 1024 + h * 64 + 2 * (jj & 31) + (jj >> 5); }
    if (mode == 2) { const int h = n >> 8, d = n & 255; return d < 128 ? h * 128 + d : 1024 + h * 128 + (d - 128); }
    return n;
}
struct CvtTile { const float* W; bf16_t* dst; const float* gk; int K, N, kt, nt, mode; };
constexpr int TILES_L = 576 + 48 + 32 + 256 + 1024 + 1024;
__device__ __forceinline__ CvtTile cvt_get(const Params& p, int t) {
    const int l = t / TILES_L; int r = t % TILES_L; unsigned char* Wl = p.ws + OFF_W + (size_t)l * SZ_WL; CvtTile c; int nT; c.mode = 0; c.gk = nullptr;
    if (r < 576) { c.W = p.w_in + (size_t)l * DM * NPROJ; c.K = DM; c.N = NPROJ; nT = 18; c.dst = (bf16_t*)(Wl + WO_IN); c.gk = p.g_mix + l * DM; }
    else if ((r -= 576) < 48) { c.W = p.w_q_up + (size_t)l * 512 * 1536; c.K = 512; c.N = 1536; nT = 6; c.mode = 1; c.dst = (bf16_t*)(Wl + WO_Q); }
    else if ((r -= 48) < 32) { c.W = p.w_kv_up + (size_t)l * 256 * 2048; c.K = 256; c.N = 2048; nT = 8; c.mode = 2; c.dst = (bf16_t*)(Wl + WO_KV); }
    else if ((r -= 32) < 256) { c.W = p.w_out + (size_t)l * DM * DM; c.K = DM; c.N = DM; nT = 8; c.dst = (bf16_t*)(Wl + WO_OUT); }
    else if ((r -= 256) < 1024) { c.W = p.w_ff1 + (size_t)l * DM * DFF; c.K = DM; c.N = DFF; nT = 32; c.dst = (bf16_t*)(Wl + WO_1); c.gk = p.g_ffn + l * DM; }
    else { r -= 1024; c.W = p.w_ff2 + (size_t)l * DFF * DM; c.K = DFF; c.N = DM; nT = 8; c.dst = (bf16_t*)(Wl + WO_2); }
    c.kt = r / nT; c.nt = r % nT; return c;
}
__device__ __forceinline__ void cvt_load(const CvtTile& c, f32x4 (&v)[8], int tid) {
#pragma unroll
    for (int i = 0; i < 8; ++i) { const int k = (tid >> 6) + 8 * i, gn = c.nt * 256 + (tid & 63) * 4;
        v[i] = (f32x4){0.f, 0.f, 0.f, 0.f};
        if (gn < c.N) { v[i] = __builtin_nontemporal_load((const f32x4*)(c.W + (size_t)(c.kt * 64 + k) * c.N + gn)); if (c.gk) v[i] = v[i] * c.gk[c.kt * 64 + k]; } }
}
__device__ __forceinline__ void convert_phase(const Params& p, LAS unsigned char* lds) {
    LAS float* T = (LAS float*)lds;
    const int tid = ltid(), G = gridDim.x;
    int t = lbid();
    f32x4 v[8]; CvtTile c;
    if (t < NLAYER * TILES_L) { c = cvt_get(p, t); cvt_load(c, v, tid); }
    while (t < NLAYER * TILES_L) {
#pragma unroll
        for (int i = 0; i < 8; ++i) { const int k = (tid >> 6) + 8 * i, n4 = (tid & 63) * 4;
            T[k * 257 + n4] = v[i][0]; T[k * 257 + n4 + 1] = v[i][1]; T[k * 257 + n4 + 2] = v[i][2]; T[k * 257 + n4 + 3] = v[i][3]; }
        __syncthreads();
        const CvtTile cur = c; const int tn = t + G;
        if (tn < NLAYER * TILES_L) { c = cvt_get(p, tn); cvt_load(c, v, tid); }
#pragma unroll
        for (int i = 0; i < 4; ++i) { const int ch = tid + 512 * i, n = ch >> 3, k8 = (ch & 7) * 8, gn = cur.nt * 256 + n;
            if (gn < cur.N) { float f[8];
#pragma unroll
                for (int j = 0; j < 8; ++j) f[j] = T[(k8 + j) * 257 + n];
                *(u32x4*)(cur.dst + (size_t)map_col(gn, cur.mode) * cur.K + cur.kt * 64 + k8) = pack8(f); } }
        __syncthreads();
        t = tn;
    }
    constexpr int PADV = (NPROJP - NPROJ) * DM * 2 / 16;
    for (int i = lbid() * 512 + tid; i < NLAYER * PADV; i += G * 512) { const int l = i / PADV, j = i % PADV;
        ((u32x4*)(p.ws + OFF_W + (size_t)l * SZ_WL + WO_IN + (size_t)NPROJ * DM * 2))[j] = (u32x4){0u, 0u, 0u, 0u}; }
    for (int i = lbid() * 512 + tid; i < S_ * 32; i += G * 512) { const int s = i >> 5, j = i & 31;
        const float inv = powf(10000.f, -(float)j * (1.f / 32.f)); const float ang = (float)p.pos[s] * inv;
        const double a = (double)ang, tw = 6.283185307179586476925; const double r = a - tw * rint(a / tw); const float rf = (float)r;
        ((float*)(p.ws + OFF_ROPE))[i] = __cosf(rf); ((float*)(p.ws + OFF_ROPE))[S_ * 32 + i] = __sinf(rf); }
    { const int wid = tid >> 6, lane = tid & 63; bf16_t* H = (bf16_t*)(p.ws + OFF_H); unsigned long long* ssqa = (unsigned long long*)(p.ws + OFF_SSQA);
        for (int row = lbid() * 8 + wid; row < S_; row += G * 8) { const float* xr = p.x + (size_t)row * DM; float ssq = 0.f;
#pragma unroll
            for (int i = 0; i < 8; ++i) { const int col = (i * 64 + lane) * 4; const f32x4 x = *(const f32x4*)(xr + col);
                ssq += x[0] * x[0] + x[1] * x[1] + x[2] * x[2] + x[3] * x[3];
                u32x2 w; w.x = cvt_pk_bf16(x[0], x[1]); w.y = cvt_pk_bf16(x[2], x[3]); *(u32x2*)(H + (size_t)row * DM + col) = w; }
            ssq = wave_sum(ssq); if (lane == 0) ssqa[row] = (unsigned long long)(ssq * 1048576.f); } }
}

template <int MODE>
__device__ __forceinline__ void rms_phase(const float* __restrict__ src, const float* __restrict__ g, bf16_t* __restrict__ H, float* __restrict__ Xcopy, float* __restrict__ outf) {
    const int wid = ltid() >> 6, lane = ltid() & 63;
    for (int row = lbid() * 8 + wid; row < S_; row += gridDim.x * 8) {
        const float* xr = src + (size_t)row * DM; f32x4 v[8]; float ssq = 0.f;
#pragma unroll
        for (int i = 0; i < 8; ++i) { v[i] = *(const f32x4*)(xr + (i * 64 + lane) * 4); ssq += v[i][0] * v[i][0] + v[i][1] * v[i][1] + v[i][2] * v[i][2] + v[i][3] * v[i][3]; }
        ssq = wave_sum(ssq);
        const float rstd = rsqrtf(ssq * (1.f / DM) + EPS_);
#pragma unroll
        for (int i = 0; i < 8; ++i) { const int col = (i * 64 + lane) * 4; const f32x4 gv = *(const f32x4*)(g + col);
            const f32x4 y = v[i] * rstd * gv;
            if (MODE == 0) { u32x2 w; w.x = cvt_pk_bf16(y[0], y[1]); w.y = cvt_pk_bf16(y[2], y[3]); *(u32x2*)(H + (size_t)row * DM + col) = w;
                if (Xcopy) *(f32x4*)(Xcopy + (size_t)row * DM + col) = v[i]; }
            else *(f32x4*)(outf + (size_t)row * DM + col) = y; }
    }
}

__device__ __forceinline__ void final_phase(const bf16_t* __restrict__ H, const float* __restrict__ g, float* __restrict__ outf) {
    const int tid = ltid(), wid = tid >> 6, lane = tid & 63;
    for (int row = lbid() * 8 + wid; row < S_; row += gridDim.x * 8) {
        float v[32]; float ssq = 0.f;
#pragma unroll
        for (int i = 0; i < 4; ++i) { float f[8]; unpack8(*(const u32x4*)(H + (size_t)row * DM + (i * 64 + lane) * 8), f);
#pragma unroll
            for (int k = 0; k < 8; ++k) { v[i * 8 + k] = f[k]; ssq += f[k] * f[k]; } }
        ssq = wave_sum(ssq);
        const float rstd = rsqrtf(ssq * (1.f / DM) + EPS_);
#pragma unroll
        for (int i = 0; i < 4; ++i) { const int col = (i * 64 + lane) * 8;
#pragma unroll
            for (int q = 0; q < 2; ++q) { const f32x4 gv = *(const f32x4*)(g + col + q * 4); f32x4 y;
#pragma unroll
                for (int k = 0; k < 4; ++k) y[k] = v[i * 8 + q * 4 + k] * rstd * gv[k];
                *(f32x4*)(outf + (size_t)row * DM + col + q * 4) = y; } }
    }
}

__device__ __forceinline__ void prep_phase(const Params& p, const Bufs& B, int l) {
    const int wid = ltid() >> 6, lane = ltid() & 63;
    const float* wconv = p.w_conv + (size_t)l * 3 * 1024; const float* bg = p.b_gates + l * 16;
    const float* gq = p.g_q_norm + l * 512; const float* gkv = p.g_kv_norm + l * 256;
    for (int s = lbid() * 8 + wid; s < S_; s += gridDim.x * 8) {
        const bf16_t* pr = B.PROJ + (size_t)s * NPROJP;
        const u32x4 z4 = (u32x4){0u, 0u, 0u, 0u};
        u32x4 cm[2], cc[2], cp[2];
#pragma unroll
        for (int hf = 0; hf < 2; ++hf) { const int c0 = lane * 16 + hf * 8;
            cm[hf] = s > 0 ? *(const u32x4*)(pr - NPROJP + c0) : z4; cc[hf] = *(const u32x4*)(pr + c0); cp[hf] = s < S_ - 1 ? *(const u32x4*)(pr + NPROJP + c0) : z4; }
        const int tensor = lane >> 5, head = (lane & 31) >> 3, j0 = (lane & 7) * 4, base = PC_RQ + tensor * 256 + head * 64;
        const u32x2 w1 = *(const u32x2*)(pr + base + j0), w2 = *(const u32x2*)(pr + base + 32 + j0);
        const f32x4 rc4 = *(const f32x4*)(B.RC + (size_t)s * 32 + j0), rs4 = *(const f32x4*)(B.RS + (size_t)s * 32 + j0);
        const u32x4 cqv = *(const u32x4*)(pr + PC_CQ + lane * 8); const u32x2 ckvv = *(const u32x2*)(pr + PC_CKV + lane * 4);
        const int l32 = lane & 31, l16 = lane & 15;
        const bf16_t kr1 = pr[PC_KR + l32], kr2 = pr[PC_KR + 32 + l32]; const float krc = B.RC[(size_t)s * 32 + l32], krs = B.RS[(size_t)s * 32 + l32];
        const bf16_t gt = pr[PC_GATE + l16]; const float bgl = bg[l16];
#pragma unroll
        for (int hf = 0; hf < 2; ++hf) { const int c0 = lane * 16 + hf * 8; float xm[8], x0[8], xp[8], r[8];
            unpack8(cm[hf], xm); unpack8(cc[hf], x0); unpack8(cp[hf], xp);
#pragma unroll
            for (int i = 0; i < 8; ++i) { const float v = xm[i] * wconv[c0 + i] + x0[i] * wconv[1024 + c0 + i] + xp[i] * wconv[2048 + c0 + i]; r[i] = v * __builtin_amdgcn_rcpf(1.f + __expf(-v)); }
            *(u32x4*)(B.QKML + (size_t)s * 1024 + c0) = pack8(r); }
        { const float x1[4] = {bflo(w1.x), bfhi(w1.x), bflo(w1.y), bfhi(w1.y)}, x2[4] = {bflo(w2.x), bfhi(w2.x), bflo(w2.y), bfhi(w2.y)};
            const float sc = tensor ? 0.125f : 1.f; float o1[4], o2[4];
#pragma unroll
            for (int i = 0; i < 4; ++i) { o1[i] = (x1[i] * rc4[i] - x2[i] * rs4[i]) * sc; o2[i] = (x2[i] * rc4[i] + x1[i] * rs4[i]) * sc; }
            u32x2 a, b2; a.x = cvt_pk_bf16(o1[0], o1[1]); a.y = cvt_pk_bf16(o1[2], o1[3]); b2.x = cvt_pk_bf16(o2[0], o2[1]); b2.y = cvt_pk_bf16(o2[2], o2[3]);
            bf16_t* d = B.RQK + (size_t)s * 512 + tensor * 256 + head * 64 + j0; *(u32x2*)d = a; *(u32x2*)(d + 32) = b2; }
        { float f[8]; unpack8(cqv, f); float g4[4] = {bflo(ckvv.x), bfhi(ckvv.x), bflo(ckvv.y), bfhi(ckvv.y)};
            float ssq = 0.f, ssk = g4[0] * g4[0] + g4[1] * g4[1] + g4[2] * g4[2] + g4[3] * g4[3];
#pragma unroll
            for (int i = 0; i < 8; ++i) ssq += f[i] * f[i];
#pragma unroll
            for (int o = 32; o > 0; o >>= 1) { ssq += __shfl_xor(ssq, o); ssk += __shfl_xor(ssk, o); }
            const float rstd = rsqrtf(ssq * (1.f / 512.f) + EPS_), rstk = rsqrtf(ssk * (1.f / 256.f) + EPS_);
#pragma unroll
            for (int i = 0; i < 8; ++i) f[i] = f[i] * rstd * gq[lane * 8 + i];
            *(u32x4*)(B.CQN + (size_t)s * 512 + lane * 8) = pack8(f);
#pragma unroll
            for (int i = 0; i < 4; ++i) g4[i] = g4[i] * rstk * gkv[lane * 4 + i];
            u32x2 o; o.x = cvt_pk_bf16(g4[0], g4[1]); o.y = cvt_pk_bf16(g4[2], g4[3]); *(u32x2*)(B.CKVN + (size_t)s * 256 + lane * 4) = o; }
        if (lane < 32) { const float x1 = bf2f(kr1), x2 = bf2f(kr2);
            const unsigned short w = (unsigned short)(__builtin_amdgcn_cvt_pk_fp8_f32(x1 * krc - x2 * krs, x2 * krc + x1 * krs, 0, false) & 0xffff);
#pragma unroll
            for (int h = 0; h < 8; ++h) *(unsigned short*)((unsigned char*)B.K + ((size_t)h * S_ + s) * 192 + 128 + 2 * lane) = w; }
        if (lane < 16) { float v = bf2f(gt) + bgl;
            if ((lane >> 2) & 1) v = fminf(v, 0.f) - log1pf(__expf(-fabsf(v)));
            B.G[(size_t)s * 16 + lane] = v; }
    }
}

constexpr int NSUB = 8;
constexpr int NPHASE = 2 + NLAYER * NSUB;
__global__ void __launch_bounds__(512) mega_fwd(Params p) {
    extern __shared__ __attribute__((aligned(16))) unsigned char lds_raw[];
    LAS unsigned char* lds = (LAS unsigned char*)lds_raw;
    cg::grid_group grid = cg::this_grid();
    const int G = gridDim.x;
    volatile LAS unsigned* xst = (volatile LAS unsigned*)(lds + LDS_BYTES - 16);
    if (threadIdx.x == 0) { xst[0] = 0u; xst[1] = 0u; }
    if (blockIdx.x == 0) { unsigned* bw = (unsigned*)(p.ws + OFF_BAR); for (int i = threadIdx.x; i < XCD_BAR_WORDS; i += 512) bw[i] = 0u; __threadfence(); }
    __syncthreads();
    XcdBarrier xbar; xbar.bar = (unsigned*)(p.ws + OFF_BAR); xbar.x = 0; xbar.st = xst;
    for (int ph = p.ph_lo; ph < p.ph_hi; ++ph) {
        if (ph > p.ph_lo) { if (ph == p.ph_lo + 1) { grid.sync(); xbar = xcd_barrier_post((unsigned*)(p.ws + OFF_BAR), xst); } else xcd_barrier(xbar); }
        const int bx = lbid();
        unsigned char* ws = p.ws; asm volatile("" : "+s"(ws));
        Bufs B;
        B.H = (bf16_t*)(ws + OFF_H); B.Y = (bf16_t*)(ws + OFF_Y); B.QKML = (bf16_t*)(ws + OFF_QKML); B.RQK = (bf16_t*)(ws + OFF_RQK); B.CQN = (bf16_t*)(ws + OFF_CQN);
        B.CKVN = (bf16_t*)(ws + OFF_CKVN); B.CST = (bf16_t*)(ws + OFF_CST); B.RST = (bf16_t*)(ws + OFF_RST); B.PROJ = (bf16_t*)(ws + OFF_PROJ);
        B.Q = (bf16_t*)(ws + OFF_Q); B.K = (bf16_t*)(ws + OFF_K); B.V = (bf16_t*)(ws + OFF_V); B.ACT = (bf16_t*)(ws + OFF_ACT);
        B.X = (float*)(ws + OFF_X); B.RC = (float*)(ws + OFF_ROPE); B.RS = B.RC + S_ * 32; B.G = (float*)(ws + OFF_G); B.CLOC = (float*)(ws + OFF_CLOC);
        B.NLOC = (float*)(ws + OFF_NLOC); B.NST = (float*)(ws + OFF_NST); B.MLOC = (float*)(ws + OFF_MLOC); B.BLAST = (float*)(ws + OFF_BLAST); B.MST = (float*)(ws + OFF_MST);
        B.RLOC = (float*)(ws + OFF_RLOC); B.Wl = nullptr;
        unsigned long long* ssqa = (unsigned long long*)(ws + OFF_SSQA); unsigned long long* ssqb = (unsigned long long*)(ws + OFF_SSQB);
        if (ph == 0) { convert_phase(p, lds); continue; }
        if (ph == NPHASE - 1) { final_phase(B.H, p.g_final, p.out); continue; }
        const int l = (ph - 1) / NSUB, sub = (ph - 1) % NSUB;
        unsigned char* Wl = ws + OFF_W + (size_t)l * SZ_WL;
        pg8::StaticOrder so;
        switch (sub) {
        case 0: { so.init(S_, NPROJP - 512, G, bx, 6, 2); pg8::Gemm g{B.H, (const bf16_t*)(Wl + WO_IN), S_, NPROJP, DM}; pg8::EpiBf16<0> e{B.PROJ, NPROJP, ssqa}; pg8::gemm_phase(lds, g, so, e); } break;
        case 1: prep_phase(p, B, l); break;
        case 2: {
            if (bx < 192) { so.init(S_, 1536, 192, bx); pg8::Gemm g{B.CQN, (const bf16_t*)(Wl + WO_Q), S_, 1536, 512}; pg8::EpiQup e{(unsigned char*)B.Q, B.RC, B.RS}; pg8::gemm_phase(lds, g, so, e); }
            else { so.init(S_, 512, 64, bx - 192, 0, 6); pg8::Gemm g{B.H, (const bf16_t*)(Wl + WO_IN), S_, NPROJP, DM}; pg8::EpiBf16<0> e{B.PROJ, NPROJP, ssqa}; pg8::gemm_phase(lds, g, so, e); }
            { so.init(S_, 2048, G, bx); pg8::Gemm g{B.CKVN, (const bf16_t*)(Wl + WO_KV), S_, 2048, 256}; pg8::EpiKVup e{(unsigned char*)B.K, B.V}; pg8::gemm_phase(lds, g, so, e); }
            if (bx < 192) for (int it = bx; it < 1024; it += 192) { if (it < 512) mlstm_local(B, it, lds); else ret_local(B, it - 512, lds); }
        } break;
        case 3: { scan_phase(B);
            for (int i = bx * 512 + ltid(); i < S_; i += G * 512) { ssqa[i] = 0ull; ssqb[i] = 0ull; } } break;
        case 4: {
            for (int it = bx; it < 256; it += G) mlstm_out(B, p.g_ml_out + l * 512, it, lds);
            for (int it = bx; it < 256; it += G) ret_out(B, p.g_ret_out + l * 512, it, lds);
            for (int it = bx; it < 256; it += G) { const int h = it & 7, qb = it >> 3;
                att::attn_body((const unsigned char*)B.Q + ((size_t)h * S_ + qb * 256) * 192, (const unsigned char*)B.K + (size_t)h * S_ * 192, B.V + (size_t)h * S_ * 128,
                               B.Y + (size_t)(qb * 256) * DM + 1024 + h * 128, S_, (char*)lds_raw); }
        } break;
        case 5: { so.init(S_, DM, G, bx); pg8::Gemm g{B.Y, (const bf16_t*)(Wl + WO_OUT), S_, DM, DM};
 pg8::EpiResid e{B.H, ssqb, DM}; pg8::gemm_phase(lds, g, so, e); } break;
        case 6: { so.init(S_, DFF, G, bx); pg8::Gemm g{B.H, (const bf16_t*)(Wl + WO_1), S_, DFF, DM}; pg8::EpiBf16<1> e{B.ACT, DFF, ssqb}; pg8::gemm_phase(lds, g, so, e); } break;
        case 7: { so.init(S_, DM, G, bx); pg8::Gemm g{B.ACT, (const bf16_t*)(Wl + WO_2), S_, DM, DFF};
            pg8::EpiResid e{B.H, ssqa, DM}; pg8::gemm_phase(lds, g, so, e); } break;
        }
    }
}

#ifndef MK_MULTI
#define MK_MULTI 0
#endif
extern "C" void kernel_launch(void* const* d_in, const int* in_sizes, int n_in, void* d_out, int out_size, void* d_ws, size_t ws_size, hipStream_t stream) {
    static int grid = 0;
    if (grid == 0) {
        if (n_in != 17 || out_size != S_ * DM || ws_size < WS_END) { fprintf(stderr, "kernel_launch: unexpected shapes: n_in %d out %d ws %zu (need %zu)\n", n_in, out_size, ws_size, (size_t)WS_END); grid = -1; return; }
        int dev = 0, cus = 0, per_cu = 0;
        hipGetDevice(&dev); hipDeviceGetAttribute(&cus, hipDeviceAttributeMultiprocessorCount, dev);
        if (hipFuncSetAttribute((const void*)mega_fwd, hipFuncAttributeMaxDynamicSharedMemorySize, LDS_BYTES) != hipSuccess) { fprintf(stderr, "kernel_launch: hipFuncSetAttribute failed\n"); grid = -1; return; }
        if (hipOccupancyMaxActiveBlocksPerMultiprocessor(&per_cu, (const void*)mega_fwd, 512, LDS_BYTES) != hipSuccess || per_cu < 1) { fprintf(stderr, "kernel_launch: occupancy query says %d\n", per_cu); per_cu = 1; }
        (void)hipGetLastError();
        grid = cus * 1;
        fprintf(stderr, "kernel_launch: cus %d per_cu %d grid %d\n", cus, per_cu, grid);
    }
    if (grid < 0) return;
    Params p{};
    p.x = (const float*)d_in[0]; p.pos = (const int*)d_in[1]; p.g_mix = (const float*)d_in[2]; p.w_in = (const float*)d_in[3]; p.b_gates = (const float*)d_in[4];
    p.w_conv = (const float*)d_in[5]; p.g_ml_out = (const float*)d_in[6]; p.g_ret_out = (const float*)d_in[7]; p.g_q_norm = (const float*)d_in[8]; p.w_q_up = (const float*)d_in[9];
    p.g_kv_norm = (const float*)d_in[10]; p.w_kv_up = (const float*)d_in[11]; p.w_out = (const float*)d_in[12]; p.g_ffn = (const float*)d_in[13]; p.w_ff1 = (const float*)d_in[14];
    p.w_ff2 = (const float*)d_in[15]; p.g_final = (const float*)d_in[16]; p.out = (float*)d_out; p.ws = (unsigned char*)d_ws;
#if MK_MULTI
    for (int ph = 0; ph < NPHASE; ++ph) { p.ph_lo = ph; p.ph_hi = ph + 1; hipLaunchKernelGGL(mega_fwd, dim3(grid), dim3(512), LDS_BYTES, stream, p); }
#else
    p.ph_lo = 0; p.ph_hi = NPHASE;
    void* args[] = {&p};
    hipError_t e = hipLaunchCooperativeKernel((const void*)mega_fwd, dim3(grid), dim3(512), args, LDS_BYTES, stream);
    if (e != hipSuccess) fprintf(stderr, "kernel_launch: cooperative launch failed: %s (grid %d)\n", hipGetErrorString(e), grid);
#endif
}
```

```cpp
#include <hip/hip_runtime.h>
#include <hip/hip_cooperative_groups.h>
#include <cstdio>
#include <cstdint>
namespace cg = cooperative_groups;

typedef unsigned short bf16_t;
typedef short bf16x8 __attribute__((ext_vector_type(8)));
typedef short s16x4 __attribute__((ext_vector_type(4)));
typedef float f32x4 __attribute__((ext_vector_type(4)));
typedef float f32x16 __attribute__((ext_vector_type(16)));
typedef unsigned u32x4 __attribute__((ext_vector_type(4)));
typedef unsigned u32x2 __attribute__((ext_vector_type(2)));
typedef int i32x8 __attribute__((ext_vector_type(8)));
#define LAS __attribute__((address_space(3)))

constexpr int S_ = 8192, DM = 2048, NPROJ = 4432, NPROJP = 4608, DFF = 8192, NLAYER = 4;
constexpr float EPS_ = 1e-6f;
constexpr int LDS_BYTES = 147456;

constexpr int PC_MLQ = 0, PC_MLK = 512, PC_MLV = 1024, PC_MLO = 1536, PC_GATE = 2048, PC_RQ = 2064, PC_RK = 2320, PC_RV = 2576, PC_RG = 3088,
              PC_CQ = 3600, PC_CKV = 4112, PC_KR = 4368;

constexpr size_t SZ_WIN = (size_t)NPROJP * DM * 2, SZ_WQ = (size_t)1536 * 512 * 2, SZ_WKV = (size_t)2048 * 256 * 2, SZ_WOUT = (size_t)DM * DM * 2,
                 SZ_W1 = (size_t)DFF * DM * 2, SZ_W2 = (size_t)DM * DFF * 2;
constexpr size_t WO_IN = 0, WO_Q = WO_IN + SZ_WIN, WO_KV = WO_Q + SZ_WQ, WO_OUT = WO_KV + SZ_WKV, WO_1 = WO_OUT + SZ_WOUT, WO_2 = WO_1 + SZ_W1, SZ_WL = WO_2 + SZ_W2;
constexpr size_t OFF_W = 0;
constexpr size_t OFF_X = OFF_W + NLAYER * SZ_WL;
constexpr size_t OFF_H = OFF_X + (size_t)S_ * DM * 4;
constexpr size_t OFF_Y = OFF_H + (size_t)S_ * DM * 2;
constexpr size_t OFF_ROPE = OFF_Y + (size_t)S_ * DM * 2;
constexpr size_t OFF_G = OFF_ROPE + (size_t)S_ * 32 * 4 * 2;
constexpr size_t OFF_QKML = OFF_G + (size_t)S_ * 16 * 4;
constexpr size_t OFF_RQK = OFF_QKML + (size_t)S_ * 1024 * 2;
constexpr size_t OFF_CQN = OFF_RQK + (size_t)S_ * 512 * 2;
constexpr size_t OFF_CKVN = OFF_CQN + (size_t)S_ * 512 * 2;
constexpr size_t OFF_CLOC = OFF_CKVN + (size_t)S_ * 256 * 2;
constexpr size_t OFF_CST = OFF_CLOC + (size_t)512 * 16384 * 4;
constexpr size_t OFF_NLOC = OFF_CST + (size_t)512 * 16384 * 2;
constexpr size_t OFF_NST = OFF_NLOC + (size_t)512 * 128 * 4;
constexpr size_t OFF_MLOC = OFF_NST + (size_t)512 * 128 * 4;
constexpr size_t OFF_BLAST = OFF_MLOC + 2048;
constexpr size_t OFF_MST = OFF_BLAST + 2048;
constexpr size_t OFF_RLOC = OFF_MST + 2048;
constexpr size_t OFF_RST = OFF_RLOC + (size_t)512 * 8192 * 4;
constexpr size_t OFF_BAR = OFF_RST + (size_t)512 * 8192 * 2;
constexpr size_t OFF_SSQA = OFF_BAR + 16384;
constexpr size_t OFF_SSQB = OFF_SSQA + (size_t)S_ * 8;
constexpr size_t OFF_MIX = OFF_SSQB + (size_t)S_ * 8;
constexpr size_t OFF_PROJ = OFF_MIX;
constexpr size_t OFF_Q = OFF_PROJ + (size_t)S_ * NPROJP * 2;
constexpr size_t OFF_K = OFF_Q + (size_t)8 * S_ * 192 * 2;
constexpr size_t OFF_V = OFF_K + (size_t)8 * S_ * 192 * 2;
constexpr size_t OFF_END0 = OFF_V + (size_t)8 * S_ * 128 * 2;
constexpr size_t OFF_ACT = OFF_MIX;
constexpr size_t OFF_END1 = OFF_ACT + (size_t)S_ * DFF * 2;
constexpr size_t WS_END = OFF_END0 > OFF_END1 ? OFF_END0 : OFF_END1;

struct Params {
    const float* x; const int* pos; const float* g_mix; const float* w_in; const float* b_gates; const float* w_conv;
    const float* g_ml_out; const float* g_ret_out; const float* g_q_norm; const float* w_q_up; const float* g_kv_norm; const float* w_kv_up;
    const float* w_out; const float* g_ffn; const float* w_ff1; const float* w_ff2; const float* g_final;
    float* out; unsigned char* ws;
    int ph_lo, ph_hi;
};

__device__ __forceinline__ unsigned cvt_pk_bf16(float lo, float hi) { unsigned r; asm volatile("v_cvt_pk_bf16_f32 %0, %1, %2" : "=v"(r) : "v"(lo), "v"(hi)); return r; }
__device__ __forceinline__ int ltid() { int t = threadIdx.x; asm volatile("" : "+v"(t)); return t; }
__device__ __forceinline__ int lbid() { int t = blockIdx.x; asm volatile("" : "+s"(t)); return t; }
__device__ __forceinline__ float bf2f(bf16_t b) { return __uint_as_float(((unsigned)b) << 16); }
__device__ __forceinline__ float bflo(unsigned w) { return __uint_as_float(w << 16); }
__device__ __forceinline__ float bfhi(unsigned w) { return __uint_as_float(w & 0xffff0000u); }
__device__ __forceinline__ bf16_t f2bf(float f) { return (bf16_t)(cvt_pk_bf16(f, 0.f) & 0xffffu); }
__device__ __forceinline__ float wave_sum(float v) { for (int o = 32; o > 0; o >>= 1) v += __shfl_xor(v, o); return v; }
__device__ __forceinline__ float wave_max(float v) { for (int o = 32; o > 0; o >>= 1) v = fmaxf(v, __shfl_xor(v, o)); return v; }
__device__ __forceinline__ void unpack8(u32x4 w, float* f) { f[0] = bflo(w.x); f[1] = bfhi(w.x); f[2] = bflo(w.y); f[3] = bfhi(w.y); f[4] = bflo(w.z); f[5] = bfhi(w.z); f[6] = bflo(w.w); f[7] = bfhi(w.w); }
__device__ __forceinline__ u32x2 pack8_fp8(const float* f) { int a = 0, b = 0;
    a = __builtin_amdgcn_cvt_pk_fp8_f32(f[0], f[1], a, false); a = __builtin_amdgcn_cvt_pk_fp8_f32(f[2], f[3], a, true);
    b = __builtin_amdgcn_cvt_pk_fp8_f32(f[4], f[5], b, false); b = __builtin_amdgcn_cvt_pk_fp8_f32(f[6], f[7], b, true);
    u32x2 w; w.x = (unsigned)a; w.y = (unsigned)b; return w; }
__device__ __forceinline__ u32x4 pack8(const float* f) { u32x4 w; w.x = cvt_pk_bf16(f[0], f[1]); w.y = cvt_pk_bf16(f[2], f[3]); w.z = cvt_pk_bf16(f[4], f[5]); w.w = cvt_pk_bf16(f[6], f[7]); return w; }


#define XB_TMO      128
#define XB_XCNT(j)  (256  + 64 * (j))
#define XB_XSUB(j)  (1280 + 64 * (j))
#define XB_XGEN(j)  (2304 + 64 * (j))
#define XB_TOP      3328
#define XB_TOPGEN   3392
#define XCD_BAR_WORDS 3456
#define XB_SPIN_CAP (1u << 18)

__device__ __forceinline__ unsigned xb_ld(unsigned* p)              { return __hip_atomic_load(p, __ATOMIC_RELAXED, __HIP_MEMORY_SCOPE_AGENT); }
__device__ __forceinline__ unsigned xb_add(unsigned* p, unsigned v) { return __hip_atomic_fetch_add(p, v, __ATOMIC_RELAXED, __HIP_MEMORY_SCOPE_AGENT); }
__device__ __forceinline__ unsigned xb_xcc_id() { return (unsigned)__builtin_amdgcn_s_getreg((3 << 11) | 20) & 0xFu; }
#define XB_SPIN(cond, bar) do { unsigned _sp = 0; while (cond) { __builtin_amdgcn_s_sleep(1); \
    if ((++_sp & 255u) == 0u) { if (xb_ld(&(bar)[XB_TMO])) break; if (_sp > XB_SPIN_CAP) { atomicAdd(&(bar)[XB_TMO], 1u); break; } } } } while (0)

struct XcdBarrier {
    unsigned* bar; unsigned x;
    volatile LAS unsigned* st;
};

__device__ __forceinline__ XcdBarrier xcd_barrier_post(unsigned* bar, volatile LAS unsigned* st) {
    XcdBarrier b; b.bar = bar; b.x = xb_xcc_id(); b.st = st;
    if (threadIdx.x == 0) (void)xb_add(&bar[XB_XCNT(b.x)], 1u);
    return b;
}
__device__ __forceinline__ void xcd_barrier_complete(unsigned* bar, unsigned x, unsigned& nloc, unsigned& nx) {
    const unsigned G = gridDim.x * gridDim.y * gridDim.z;
    unsigned sum, cnt, mine, sp = 0u;
    for (;;) {
        sum = 0u; cnt = 0u; mine = 0u;
#pragma unroll
        for (unsigned j = 0; j < 16; ++j) { const unsigned c = xb_ld(&bar[XB_XCNT(j)]); sum += c; cnt += (c > 0u) ? 1u : 0u; mine = (j == x) ? c : mine; }
        if (sum == G) break;
        __builtin_amdgcn_s_sleep(1);
        if ((++sp & 255u) == 0u) { if (xb_ld(&bar[XB_TMO])) break; if (sp > XB_SPIN_CAP) { atomicAdd(&bar[XB_TMO], 1u); break; } }
    }
    nloc = mine > 0u ? mine : 1u; nx = cnt > 0u ? cnt : 1u;
}

__device__ __forceinline__ void xcd_barrier(const XcdBarrier& b) {
    asm volatile("s_waitcnt vmcnt(0)" ::: "memory");
    __syncthreads();
    if (threadIdx.x == 0) {
        unsigned* bar = b.bar;
        __builtin_amdgcn_s_waitcnt(0);
        unsigned nloc = b.st[0], nx = b.st[1];
        if (nloc == 0u) { xcd_barrier_complete(bar, b.x, nloc, nx); b.st[0] = nloc; b.st[1] = nx; }
        const unsigned old = xb_add(&bar[XB_XSUB(b.x)], 1u);
        const unsigned gen = old / nloc;
        if (old + 1u == (gen + 1u) * nloc) {
            __builtin_amdgcn_fence(__ATOMIC_RELEASE, "agent");
            asm volatile("s_waitcnt vmcnt(0)" ::: "memory");
            const unsigned og = xb_add(&bar[XB_TOP], 1u);
            const unsigned tg = og / nx;
            if (og + 1u == (tg + 1u) * nx) xb_add(&bar[XB_TOPGEN], 1u);
            else XB_SPIN(xb_ld(&bar[XB_TOPGEN]) == tg, bar);
            __builtin_amdgcn_fence(__ATOMIC_ACQUIRE, "agent");
            xb_add(&bar[XB_XGEN(b.x)], 1u);
            asm volatile("s_waitcnt vmcnt(0)" ::: "memory");
        } else {
            XB_SPIN(xb_ld(&bar[XB_XGEN(b.x)]) == gen, bar);
            __builtin_amdgcn_fence(__ATOMIC_ACQUIRE, "agent");
            asm volatile("s_waitcnt vmcnt(0)" ::: "memory");
        }
    }
    __syncthreads();
}

namespace pg8 {
constexpr int BM = 256, BK = 64, HALF = 128, HTB = HALF * BK * 2, STAGE_BYTES = 8 * HTB, NXCD = 8, WGM = 8;
__host__ __device__ __forceinline__ int lds_byte(int r, int c) { const int st = (r >> 4) * 2 + (c >> 5), rr = r & 15, cc = c & 31, ob = rr * 64 + cc * 2; return st * 1024 + (ob ^ (((ob >> 9) & 1) << 5)); }
__host__ __device__ __forceinline__ void stage_rc(int b, int& R, int& C) { const int st = b / 1024, sb = b % 1024, swz = sb ^ (((sb >> 9) & 1) << 5); R = (st >> 1) * 16 + swz / 64; C = (st & 1) * 32 + (swz % 64) / 2; }
__host__ __device__ __forceinline__ int perm32(int rho) { const int n = rho >> 4, i = rho & 15; return 8 * (i >> 2) + 4 * n + (i & 3); }
struct Unit { int pm, pn; };
struct Gemm { const bf16_t* A; const bf16_t* Bt; int M, N, K; };
struct StaticOrder {
    int nM, nN, nwg, G, c, skip_lo, skip_n, ioff = 0, icnt = 1 << 20;
    __device__ void init(int M, int N, int G_, int c_, int slo = 1 << 20, int sn = 0) { nM = M / BM; nN = N / BM; nwg = nM * nN; G = G_; c = c_; skip_lo = slo; skip_n = sn; }
    __device__ bool next(int i, Unit& u) const {
        if (i >= icnt) return false; const long L = (long)(i + ioff) * G + c; if (L >= nwg) return false;
        int wgid = (int)L; { const int q = nwg / NXCD, r = nwg % NXCD, xcd = wgid % NXCD, off = wgid / NXCD; wgid = (xcd < r ? xcd * (q + 1) : r * (q + 1) + (xcd - r) * q) + off; }
        const int nig = WGM * nN, gid = wgid / nig, fm = gid * WGM, gsz = (nM - fm) < WGM ? (nM - fm) : WGM;
        u.pm = fm + ((wgid % nig) % gsz); u.pn = (wgid % nig) / gsz; if (u.pn >= skip_lo) u.pn += skip_n; return true;
    }
};
template <class Epi>
__device__ __forceinline__ void gemm_phase(LAS unsigned char* lds, const Gemm g, const StaticOrder& S, const Epi& E) {
    const int tid = ltid(), wid = __builtin_amdgcn_readfirstlane(tid >> 6), lane = tid & 63, wr = wid >> 2, wc = wid & 3, fr = lane & 15, fq = lane >> 4;
    int K = g.K; asm volatile("" : "+s"(K)); const int nt = K / BK;
    unsigned voffA[2], voffB[2];
#pragma unroll
    for (int i = 0; i < 2; ++i) { int R, C; stage_rc(tid * 16 + i * 8192, R, C); const int Rb = Epi::PERM ? ((R & ~31) + perm32(R & 31)) : R;
        voffA[i] = (unsigned)(R * K + C) * 2u; voffB[i] = (unsigned)(Rb * K + C) * 2u; }
    const size_t kstep = (size_t)(BK * 2);
    const size_t hstep = (size_t)HALF * K * 2;
    const size_t tstep = 2 * hstep;
    const unsigned ldsw = (unsigned)wid * 1024u;
    const int aoff = lds_byte(wr * 64 + fr, fq * 8), boff = lds_byte(wc * 32 + fr, fq * 8);
#define PG8_SA(b, h) (((b) * 2 + (h)) * HTB)
#define PG8_SB(b, h) ((4 + (b) * 2 + (h)) * HTB)
#define PG8_STAGE(bufoff, gbase, voff) do { _Pragma("unroll") for (int _i = 0; _i < 2; ++_i) \
        __builtin_amdgcn_global_load_lds((const unsigned*)((const char*)(gbase) + (voff)[_i]), (LAS unsigned*)(lds + (bufoff) + ldsw + _i * 8192), 16, 0, 0); } while (0)
#define PG8_LDA(dst, b, h) do { _Pragma("unroll") for (int m = 0; m < 4; ++m) _Pragma("unroll") for (int k = 0; k < 2; ++k) dst[m][k] = *(const LAS bf16x8*)(lds + PG8_SA(b, h) + aoff + m * 2048 + k * 1024); } while (0)
#define PG8_LDB(dst, b, h) do { _Pragma("unroll") for (int n = 0; n < 2; ++n) _Pragma("unroll") for (int k = 0; k < 2; ++k) dst[n][k] = *(const LAS bf16x8*)(lds + PG8_SB(b, h) + boff + n * 2048 + k * 1024); } while (0)
#define PG8_MMA(ai, bj, At, Bt) do { __builtin_amdgcn_s_setprio(1); _Pragma("unroll") for (int m = 0; m < 4; ++m) _Pragma("unroll") for (int n = 0; n < 2; ++n) _Pragma("unroll") for (int k = 0; k < 2; ++k) \
        acc[ai][bj][m][n] = __builtin_amdgcn_mfma_f32_16x16x32_bf16(Bt[n][k], At[m][k], acc[ai][bj][m][n], 0, 0, 0); __builtin_amdgcn_s_setprio(0); } while (0)
#define PG8_WAIT_V(n) asm volatile("s_waitcnt vmcnt(" #n ")" ::: "memory")
#define PG8_WAIT_L(n) asm volatile("s_waitcnt lgkmcnt(" #n ")" ::: "memory")
#define PG8_BAR __builtin_amdgcn_s_barrier()
#define PG8_SCHED __builtin_amdgcn_sched_barrier(0)
    Unit cur, nxt; int ui = 0;
    if (!S.next(0, cur)) return;
    f32x4 acc[2][2][4][2];
#pragma unroll
    for (int a = 0; a < 2; ++a)
#pragma unroll
        for (int b = 0; b < 2; ++b)
#pragma unroll
            for (int m = 0; m < 4; ++m)
#pragma unroll
                for (int n = 0; n < 2; ++n) acc[a][b][m][n] = (f32x4){0.f, 0.f, 0.f, 0.f};
    bf16x8 At[4][2], B0[2][2], B1[2][2];
    const char* cA = (const char*)g.A + (size_t)cur.pm * tstep; const char* cB = (const char*)g.Bt + (size_t)cur.pn * tstep;
    if (Epi::PRE) E.stash(E.prefetch(cur.pm, tid), lds, 0, tid);
    PG8_STAGE(PG8_SB(0, 0), cB, voffB); PG8_STAGE(PG8_SA(0, 0), cA, voffA); PG8_STAGE(PG8_SB(0, 1), cB + hstep, voffB); PG8_STAGE(PG8_SA(0, 1), cA + hstep, voffA);
    if (wr == 1) PG8_BAR;
    PG8_WAIT_V(4); PG8_BAR;
    PG8_STAGE(PG8_SB(1, 0), cB + kstep, voffB); PG8_STAGE(PG8_SA(1, 0), cA + kstep, voffA); PG8_STAGE(PG8_SB(1, 1), cB + hstep + kstep, voffB);
    PG8_WAIT_V(6); PG8_BAR;
    for (;;) {
        const bool has_next = S.next(ui + 1, nxt);
        const char* nA = has_next ? (const char*)g.A + (size_t)nxt.pm * tstep : cA; const char* nB = has_next ? (const char*)g.Bt + (size_t)nxt.pn * tstep : cB;
        for (int t = 0; t < nt; t += 2) {
            const bool last = (t == nt - 2);
            const char* a1 = cA + (size_t)(t + 1) * kstep;
            const char* a2 = last ? nA : cA + (size_t)(t + 2) * kstep; const char* b2 = last ? nB : cB + (size_t)(t + 2) * kstep;
            const char* a3 = a2 + kstep; const char* b3 = b2 + kstep;
            PG8_LDB(B0, 0, 0); PG8_SCHED; PG8_LDA(At, 0, 0); PG8_STAGE(PG8_SA(1, 1), a1 + hstep, voffA);
            PG8_WAIT_L(8); PG8_BAR; PG8_WAIT_L(0); PG8_MMA(0, 0, At, B0); PG8_BAR; PG8_SCHED;
            PG8_LDB(B1, 0, 1); PG8_STAGE(PG8_SB(0, 0), b2, voffB);
            PG8_BAR; PG8_WAIT_L(0); PG8_MMA(0, 1, At, B1); PG8_BAR;
            PG8_LDA(At, 0, 1); PG8_STAGE(PG8_SA(0, 0), a2, voffA);
            PG8_BAR; PG8_WAIT_L(0); PG8_MMA(1, 0, At, B0); PG8_BAR; PG8_SCHED;
            PG8_STAGE(PG8_SB(0, 1), b2 + hstep, voffB);
            PG8_WAIT_V(6); PG8_BAR; PG8_MMA(1, 1, At, B1); PG8_BAR;
            PG8_LDB(B0, 1, 0); PG8_SCHED; PG8_LDA(At, 1, 0); PG8_STAGE(PG8_SA(0, 1), a2 + hstep, voffA);
            PG8_WAIT_L(8); PG8_BAR; PG8_WAIT_L(0); PG8_MMA(0, 0, At, B0); PG8_BAR; PG8_SCHED;
            PG8_LDB(B1, 1, 1); PG8_STAGE(PG8_SB(1, 0), b3, voffB);
            PG8_BAR; PG8_WAIT_L(0); PG8_MMA(0, 1, At, B1); PG8_BAR;
            PG8_LDA(At, 1, 1); PG8_STAGE(PG8_SA(1, 0), a3, voffA);
            PG8_BAR; PG8_WAIT_L(0); PG8_MMA(1, 0, At, B0); PG8_BAR; PG8_SCHED;
            PG8_STAGE(PG8_SB(1, 1), b3 + hstep, voffB);
            PG8_WAIT_V(6); PG8_BAR; PG8_MMA(1, 1, At, B1); PG8_BAR;
        }
        E(acc, cur, wr, wc, fr, fq, lds, ui & 1, has_next ? nxt.pm : -1, tid);
        if (!has_next) break;
#pragma unroll
        for (int a = 0; a < 2; ++a)
#pragma unroll
            for (int b = 0; b < 2; ++b)
#pragma unroll
                for (int m = 0; m < 4; ++m)
#pragma unroll
                    for (int n = 0; n < 2; ++n) acc[a][b][m][n] = (f32x4){0.f, 0.f, 0.f, 0.f};
        cur = nxt; cA = nA; cB = nB; ++ui;
    }
    PG8_WAIT_V(0);
    if (wr == 0) PG8_BAR;
    PG8_BAR;
#undef PG8_SA
#undef PG8_SB
#undef PG8_STAGE
#undef PG8_LDA
#undef PG8_LDB
#undef PG8_MMA
#undef PG8_WAIT_V
#undef PG8_WAIT_L
#undef PG8_BAR
#undef PG8_SCHED
}

template <int ACT> struct EpiBf16 {
    static constexpr bool PERM = true, PRE = true;
    bf16_t* O; int ldc; const unsigned long long* ssq;
    __device__ __forceinline__ unsigned long long prefetch(int pm, int tid) const { return tid < 256 ? ssq[pm * BM + tid] : 0ull; }
    __device__ __forceinline__ void stash(unsigned long long v, LAS unsigned char* lds, int par, int tid) const { if (tid < 256) *(LAS float*)(lds + 131072 + par * 1024 + tid * 4) = rsqrtf((float)v * (1.f / (1048576.f * DM)) + EPS_); }
    __device__ __forceinline__ void operator()(const f32x4 (&acc)[2][2][4][2], const Unit& u, int wr, int wc, int fr, int fq, LAS unsigned char* lds, int par, int npm, int tid) const {
        const int row0 = u.pm * BM + wr * 64 + fr, col0 = u.pn * BM + wc * 32 + 8 * fq;
        unsigned long long nx = 0ull; if (npm >= 0) nx = prefetch(npm, tid);
#pragma unroll
        for (int ai = 0; ai < 2; ++ai)
#pragma unroll
            for (int m = 0; m < 4; ++m) { const int row = row0 + ai * HALF + m * 16; bf16_t* rowp = O + (size_t)row * ldc + col0;
                const float rstd = *(const LAS float*)(lds + 131072 + par * 1024 + (wr * 64 + fr + ai * HALF + m * 16) * 4);
#pragma unroll
                for (int bj = 0; bj < 2; ++bj) { f32x4 v0 = acc[ai][bj][m][0] * rstd, v1 = acc[ai][bj][m][1] * rstd;
                    if (ACT == 1) {
#pragma unroll
                        for (int j = 0; j < 4; ++j) { const float a = fmaxf(v0[j], 0.f), b = fmaxf(v1[j], 0.f); v0[j] = a * a; v1[j] = b * b; } }
                    u32x4 w; w.x = cvt_pk_bf16(v0[0], v0[1]); w.y = cvt_pk_bf16(v0[2], v0[3]); w.z = cvt_pk_bf16(v1[0], v1[1]); w.w = cvt_pk_bf16(v1[2], v1[3]);
                    *(u32x4*)(rowp + bj * HALF) = w; } }
        if (npm >= 0) stash(nx, lds, par ^ 1, tid);
    }
};
struct EpiResid {
    static constexpr bool PERM = true, PRE = false;
    __device__ __forceinline__ unsigned long long prefetch(int, int) const { return 0ull; }
    __device__ __forceinline__ void stash(unsigned long long, LAS unsigned char*, int, int) const {}
    bf16_t* Hb; unsigned long long* ssq; int ldc;
    __device__ __forceinline__ void operator()(const f32x4 (&acc)[2][2][4][2], const Unit& u, int wr, int wc, int fr, int fq, LAS unsigned char* lds, int par, int npm, int tid) const {
        const int row0 = u.pm * BM + wr * 64 + fr, col0 = u.pn * BM + wc * 32 + 8 * fq;
        u32x4 old[2][4][2];
#pragma unroll
        for (int ai = 0; ai < 2; ++ai)
#pragma unroll
            for (int m = 0; m < 4; ++m)
#pragma unroll
                for (int bj = 0; bj < 2; ++bj) old[ai][m][bj] = *(const u32x4*)(Hb + (size_t)(row0 + ai * HALF + m * 16) * ldc + col0 + bj * HALF);
#pragma unroll
        for (int ai = 0; ai < 2; ++ai)
#pragma unroll
            for (int m = 0; m < 4; ++m) { const int row = row0 + ai * HALF + m * 16; bf16_t* hp = Hb + (size_t)row * ldc + col0;
                float part = 0.f;
#pragma unroll
                for (int bj = 0; bj < 2; ++bj) { float o[8]; unpack8(old[ai][m][bj], o);
                    const f32x4 a0 = acc[ai][bj][m][0], a1 = acc[ai][bj][m][1];
                    float v[8] = {o[0] + a0[0], o[1] + a0[1], o[2] + a0[2], o[3] + a0[3], o[4] + a1[0], o[5] + a1[1], o[6] + a1[2], o[7] + a1[3]};
#pragma unroll
                    for (int k = 0; k < 8; ++k) part += v[k] * v[k];
                    *(u32x4*)(hp + bj * HALF) = pack8(v); }
                part += __shfl_xor(part, 16); part += __shfl_xor(part, 32);
                if (fq == 0) atomicAdd(ssq + row, (unsigned long long)(part * 1048576.f)); }
    }
};
struct EpiQup {
    static constexpr bool PERM = true, PRE = false;
    __device__ __forceinline__ unsigned long long prefetch(int, int) const { return 0ull; }
    __device__ __forceinline__ void stash(unsigned long long, LAS unsigned char*, int, int) const {}
    unsigned char* Q; const float* rc; const float* rs;
    __device__ __forceinline__ void operator()(const f32x4 (&acc)[2][2][4][2], const Unit& u, int wr, int wc, int fr, int fq, LAS unsigned char* lds, int par, int npm, int tid) const {
        const int row0 = u.pm * BM + wr * 64 + fr;
        if (u.pn < 4) {
            unsigned char* d0 = Q + ((size_t)(u.pn * 2) * S_ + row0) * 192 + wc * 32 + 8 * fq;
#pragma unroll
            for (int ai = 0; ai < 2; ++ai)
#pragma unroll
                for (int m = 0; m < 4; ++m)
#pragma unroll
                    for (int bj = 0; bj < 2; ++bj) { const f32x4 v0 = acc[ai][bj][m][0], v1 = acc[ai][bj][m][1];
                        const float f[8] = {v0[0], v0[1], v0[2], v0[3], v1[0], v1[1], v1[2], v1[3]};
                        *(u32x2*)(d0 + (size_t)(ai * HALF + m * 16) * 192 + (size_t)bj * S_ * 192) = pack8_fp8(f); }
        } else {
            const int jj0 = (wc & 1) * 32 + 8 * fq, j0 = jj0 >> 1;
            unsigned char* d0 = Q + ((size_t)((u.pn - 4) * 4 + (wc >> 1)) * S_ + row0) * 192 + 128 + jj0;
            const float* c0 = rc + (size_t)row0 * 32 + j0; const float* s0 = rs + (size_t)row0 * 32 + j0;
            f32x4 cv[2][4], sv[2][4];
#pragma unroll
            for (int ai = 0; ai < 2; ++ai)
#pragma unroll
                for (int m = 0; m < 4; ++m) { const int ro = ai * HALF + m * 16; cv[ai][m] = *(const f32x4*)(c0 + ro * 32); sv[ai][m] = *(const f32x4*)(s0 + ro * 32); }
#pragma unroll
            for (int ai = 0; ai < 2; ++ai)
#pragma unroll
                for (int m = 0; m < 4; ++m) { const int ro = ai * HALF + m * 16; const f32x4 c = cv[ai][m], s = sv[ai][m];
#pragma unroll
                    for (int bj = 0; bj < 2; ++bj) { const f32x4 v0 = acc[ai][bj][m][0], v1 = acc[ai][bj][m][1];
                        const float f[8] = {v0[0] * c[0] - v0[1] * s[0], v0[1] * c[0] + v0[0] * s[0], v0[2] * c[1] - v0[3] * s[1], v0[3] * c[1] + v0[2] * s[1],
                                            v1[0] * c[2] - v1[1] * s[2], v1[1] * c[2] + v1[0] * s[2], v1[2] * c[3] - v1[3] * s[3], v1[3] * c[3] + v1[2] * s[3]};
                        *(u32x2*)(d0 + (size_t)ro * 192 + (size_t)bj * 2 * S_ * 192) = pack8_fp8(f); } }
        }
    }
};
struct EpiKVup {
    static constexpr bool PERM = true, PRE = false;
    __device__ __forceinline__ unsigned long long prefetch(int, int) const { return 0ull; }
    __device__ __forceinline__ void stash(unsigned long long, LAS unsigned char*, int, int) const {}
    unsigned char* Kb; bf16_t* Vb;
    template <int LD> __device__ __forceinline__ void put(const f32x4 (&acc)[2][2][4][2], bf16_t* d0) const {
#pragma unroll
        for (int ai = 0; ai < 2; ++ai)
#pragma unroll
            for (int m = 0; m < 4; ++m)
#pragma unroll
                for (int bj = 0; bj < 2; ++bj) { const f32x4 v0 = acc[ai][bj][m][0], v1 = acc[ai][bj][m][1];
                    u32x4 w; w.x = cvt_pk_bf16(v0[0], v0[1]); w.y = cvt_pk_bf16(v0[2], v0[3]); w.z = cvt_pk_bf16(v1[0], v1[1]); w.w = cvt_pk_bf16(v1[2], v1[3]);
                    *(u32x4*)(d0 + (size_t)(ai * HALF + m * 16) * LD + (size_t)bj * S_ * LD) = w; }
    }
    __device__ __forceinline__ void operator()(const f32x4 (&acc)[2][2][4][2], const Unit& u, int wr, int wc, int fr, int fq, LAS unsigned char* lds, int par, int npm, int tid) const {
        const int row0 = u.pm * BM + wr * 64 + fr;
        if (u.pn < 4) { unsigned char* d0 = Kb + ((size_t)(u.pn * 2) * S_ + row0) * 192 + wc * 32 + 8 * fq;
#pragma unroll
            for (int ai = 0; ai < 2; ++ai)
#pragma unroll
                for (int m = 0; m < 4; ++m)
#pragma unroll
                    for (int bj = 0; bj < 2; ++bj) { const f32x4 v0 = acc[ai][bj][m][0], v1 = acc[ai][bj][m][1];
                        const float f[8] = {v0[0], v0[1], v0[2], v0[3], v1[0], v1[1], v1[2], v1[3]};
                        *(u32x2*)(d0 + (size_t)(ai * HALF + m * 16) * 192 + (size_t)bj * S_ * 192) = pack8_fp8(f); } }
        else put<128>(acc, Vb + ((size_t)((u.pn - 4) * 2) * S_ + row0) * 128 + wc * 32 + 8 * fq);
    }
};
}

namespace att {
constexpr int DQ = 192, DV = 128, NW = 8, QBLK = 32, KVBLK = 64;
constexpr float SCALE = 0.07216878364870322f;
constexpr float THR = 8.f;
#ifndef ATT_SDEPTH
#define ATT_SDEPTH 1
#endif
constexpr int SDEPTH = ATT_SDEPTH;
#ifndef ATT_NQREG
#define ATT_NQREG 12
#endif
constexpr int NQREG = ATT_NQREG;
constexpr int LDQ = 192, LDKK = 192, LDVV = 128, LDO = 2048;
constexpr int SHM_V = KVBLK * DV * 2, SHM_K = KVBLK * 208, SHM_QR = 2 * SHM_V + 2 * SHM_K + NW * 64 * 4, SHM_ATTN = SHM_QR + NW * (12 - NQREG) * 64 * 16;
#define KSWZ(row, colB) ((row) * 208 + (colB))
#define SBAR() __builtin_amdgcn_sched_barrier(0)
__device__ __forceinline__ int crow(int r, int hi) { return (r & 3) + 8 * (r >> 2) + 4 * hi; }
__device__ __forceinline__ void partialSM(f32x16& p0, f32x16& p1, float& m_reg, float& mn, float& alpha) {
  constexpr float C = SCALE * 1.4426950408889634f;
  float pmax = p0[0]; for (int r = 1; r < 16; ++r) pmax = fmaxf(pmax, p0[r]); for (int r = 0; r < 16; ++r) pmax = fmaxf(pmax, p1[r]);
  { auto rr = __builtin_amdgcn_permlane32_swap(__float_as_uint(pmax), __float_as_uint(pmax), false, false);
    pmax = fmaxf(__uint_as_float(rr[0]), __uint_as_float(rr[1])); }
  if (__builtin_expect(__all(pmax - m_reg <= THR / SCALE), 1)) { mn = m_reg; alpha = 1.f; }
  else { mn = fmaxf(m_reg, pmax); alpha = __builtin_amdgcn_exp2f((m_reg - mn) * C); m_reg = mn; }
  float mnC = -mn * C;
  for (int r = 0; r < 16; ++r) p0[r] = fmaf(p0[r], C, mnC); for (int r = 0; r < 16; ++r) p1[r] = fmaf(p1[r], C, mnC);
  for (int r = 0; r < 16; ++r) p0[r] = __builtin_amdgcn_exp2f(p0[r]);
}
__device__ __forceinline__ void finishSM(f32x16& p0, f32x16& p1, float alpha, float& l_reg, bf16x8& pa0, bf16x8& pa1, bf16x8& pa2, bf16x8& pa3) {
  for (int r = 0; r < 16; ++r) p1[r] = __builtin_amdgcn_exp2f(p1[r]);
  float ps = 0; for (int r = 0; r < 16; ++r) ps += p0[r]; for (int r = 0; r < 16; ++r) ps += p1[r];
  { auto rr = __builtin_amdgcn_permlane32_swap(__float_as_uint(ps), __float_as_uint(ps), false, false);
    ps = __uint_as_float(rr[0]) + __uint_as_float(rr[1]); }
  l_reg = l_reg * alpha + ps;
#define PK4(P, BASE, OUT) do { unsigned a0 = cvt_pk_bf16(P[BASE + 0], P[BASE + 1]), a1 = cvt_pk_bf16(P[BASE + 2], P[BASE + 3]);   \
    unsigned b0 = cvt_pk_bf16(P[BASE + 4], P[BASE + 5]), b1 = cvt_pk_bf16(P[BASE + 6], P[BASE + 7]);                              \
    auto r0 = __builtin_amdgcn_permlane32_swap(a0, b0, false, false); auto r1 = __builtin_amdgcn_permlane32_swap(a1, b1, false, false); \
    u32x4 w = {r0[0], r1[0], r0[1], r1[1]}; OUT = *reinterpret_cast<bf16x8*>(&w); } while (0)
  PK4(p0, 0, pa0); PK4(p0, 8, pa1); PK4(p1, 0, pa2); PK4(p1, 8, pa3);
#undef PK4
}
__device__ __forceinline__ void qkt(f32x16& p0, f32x16& p1, const unsigned char* Ks, const i32x8* qr, int r32, int hi) {
  p0 = f32x16{}; p1 = f32x16{};
#pragma unroll
  for (int m = 0; m < 3; ++m) { const int cb = m * 64 + hi * 32;
    const u32x4 a0 = *reinterpret_cast<const u32x4*>(Ks + KSWZ(r32, cb)), a1 = *reinterpret_cast<const u32x4*>(Ks + KSWZ(r32, cb) + 16);
    const u32x4 c0 = *reinterpret_cast<const u32x4*>(Ks + KSWZ(32 + r32, cb)), c1 = *reinterpret_cast<const u32x4*>(Ks + KSWZ(32 + r32, cb) + 16);
    const i32x8 b0 = {(int)a0.x, (int)a0.y, (int)a0.z, (int)a0.w, (int)a1.x, (int)a1.y, (int)a1.z, (int)a1.w};
    const i32x8 b1 = {(int)c0.x, (int)c0.y, (int)c0.z, (int)c0.w, (int)c1.x, (int)c1.y, (int)c1.z, (int)c1.w};
    p0 = __builtin_amdgcn_mfma_scale_f32_32x32x64_f8f6f4(b0, qr[m], p0, 0, 0, 0, 0x7F7F7F7F, 0, 0x7F7F7F7F);
    p1 = __builtin_amdgcn_mfma_scale_f32_32x32x64_f8f6f4(b1, qr[m], p1, 0, 0, 0, 0x7F7F7F7F, 0, 0x7F7F7F7F); }
}
__device__ __forceinline__ int v_st(int k, int c) { const int kk = (k & ~0xC) | ((k & 4) << 1) | ((k & 8) >> 1); return ((kk >> 3) * 4 + (c >> 5)) * 512 + ((kk & 7) * 32 + (c & 31)) * 2; }
__device__ __forceinline__ int v_rd_base(int lane) { return ((lane & 3) << 3) | (((lane >> 2) & 3) << 6) | (((lane >> 4) & 1) << 5) | (((lane >> 5) & 1) << 8); }
constexpr int v_rd_off(int d0, int ks, int half) { return d0 * 512 + ks * 4096 + half * 2048; }
template <int OFF> __device__ __forceinline__ s16x4 tr_read(int vb) {
  s16x4 r; asm volatile("ds_read_b64_tr_b16 %0, %1 offset:%2" : "=&v"(r) : "v"(vb), "i"(OFF) : "memory"); return r;
}
template <int D0> __device__ __forceinline__ void pv_one(f32x16& od, int vb, bf16x8 pa0, bf16x8 pa1, bf16x8 pa2, bf16x8 pa3) {
  const s16x4 l0 = tr_read<v_rd_off(D0, 0, 0)>(vb), h0 = tr_read<v_rd_off(D0, 0, 1)>(vb), l1 = tr_read<v_rd_off(D0, 1, 0)>(vb), h1 = tr_read<v_rd_off(D0, 1, 1)>(vb);
  const s16x4 l2 = tr_read<v_rd_off(D0, 2, 0)>(vb), h2 = tr_read<v_rd_off(D0, 2, 1)>(vb), l3 = tr_read<v_rd_off(D0, 3, 0)>(vb), h3 = tr_read<v_rd_off(D0, 3, 1)>(vb);
  asm volatile("s_waitcnt lgkmcnt(0)" ::: "memory"); SBAR();
#define PK(L, H) (bf16x8){L[0], L[1], L[2], L[3], H[0], H[1], H[2], H[3]}
  od = __builtin_amdgcn_mfma_f32_32x32x16_bf16(pa0, PK(l0, h0), od, 0, 0, 0);
  od = __builtin_amdgcn_mfma_f32_32x32x16_bf16(pa1, PK(l1, h1), od, 0, 0, 0);
  od = __builtin_amdgcn_mfma_f32_32x32x16_bf16(pa2, PK(l2, h2), od, 0, 0, 0);
  od = __builtin_amdgcn_mfma_f32_32x32x16_bf16(pa3, PK(l3, h3), od, 0, 0, 0);
#undef PK
}
__device__ __forceinline__ void pv_d0(f32x16* o, int vb, bf16x8 pa0, bf16x8 pa1, bf16x8 pa2, bf16x8 pa3) {
  pv_one<0>(o[0], vb, pa0, pa1, pa2, pa3); pv_one<1>(o[1], vb, pa0, pa1, pa2, pa3); pv_one<2>(o[2], vb, pa0, pa1, pa2, pa3); pv_one<3>(o[3], vb, pa0, pa1, pa2, pa3);
}
__device__ __forceinline__ void attn_body(const unsigned char* __restrict__ Qb, const unsigned char* __restrict__ Kh, const bf16_t* __restrict__ Vh,
                                          bf16_t* __restrict__ Ob, int seq, char* lds) {
  const int tid = ltid(), wid = tid >> 6, lane = tid & 63, r32 = lane & 31, hi = lane >> 5;
  bf16_t* V_lds = (bf16_t*)lds; unsigned char* K_lds = (unsigned char*)(lds + 2 * SHM_V);
  float* ws = (float*)(lds + 2 * SHM_V + 2 * SHM_K) + wid * 64; float* li_l = ws; float* al_l = ws + 32;
  float m_reg = -1e30f, l_reg = 0; f32x16 o[4] = {}; i32x8 qr[3];
  const unsigned char* Qw = Qb + (long)(wid * QBLK + r32) * 192 + hi * 32;
#pragma unroll
  for (int m = 0; m < 3; ++m) { const u32x4 a0 = *reinterpret_cast<const u32x4*>(Qw + m * 64), a1 = *reinterpret_cast<const u32x4*>(Qw + m * 64 + 16);
    qr[m] = (i32x8){(int)a0.x, (int)a0.y, (int)a0.z, (int)a0.w, (int)a1.x, (int)a1.y, (int)a1.z, (int)a1.w}; }
  const int sr = tid >> 4, sc = (tid & 15) * 8, vst0 = v_st(sr, sc), vst1 = v_st(32 + sr, sc);
  const int kw0 = KSWZ(tid / 12, (tid % 12) * 16), kw1 = KSWZ((tid + 512) / 12, ((tid + 512) % 12) * 16);
  const bool k2 = tid < 256;
  const int vb0 = (int)(uintptr_t)V_lds + v_rd_base(lane);
  struct { bf16x8 vs0, vs1; u32x4 ks0, ks1; } sr_[SDEPTH];
#define SLOAD(i, k0) do { sr_[i].vs0 = *(const bf16x8*)(&Vh[(long)((k0) + sr) * LDVV + sc]); sr_[i].vs1 = *(const bf16x8*)(&Vh[(long)((k0) + 32 + sr) * LDVV + sc]); \
    { const unsigned char* kt_ = Kh + (size_t)(k0) * 192; sr_[i].ks0 = *(const u32x4*)(kt_ + tid * 16); if (k2) sr_[i].ks1 = *(const u32x4*)(kt_ + 8192 + tid * 16); } } while (0)
#define SWRITE(b, i) do { *(bf16x8*)((char*)V_lds + (b) * SHM_V + vst0) = sr_[i].vs0;          \
    *(bf16x8*)((char*)V_lds + (b) * SHM_V + vst1) = sr_[i].vs1;               \
    { unsigned char* kd_ = K_lds + (b) * SHM_K; u32x2 lo_ = {sr_[i].ks0.x, sr_[i].ks0.y}, hi_ = {sr_[i].ks0.z, sr_[i].ks0.w}; \
      *(u32x2*)(kd_ + kw0) = lo_; *(u32x2*)(kd_ + kw0 + 8) = hi_; \
      if (k2) { u32x2 lo2_ = {sr_[i].ks1.x, sr_[i].ks1.y}, hi2_ = {sr_[i].ks1.z, sr_[i].ks1.w}; *(u32x2*)(kd_ + kw1) = lo2_; *(u32x2*)(kd_ + kw1 + 8) = hi2_; } } } while (0)
#define SWAIT() do { if constexpr (SDEPTH == 2) asm volatile("s_waitcnt vmcnt(5)" ::: "memory"); else asm volatile("s_waitcnt vmcnt(0)" ::: "memory"); } while (0)
#define RESC(a) do { if (__any((a) < 1.f)) { if (hi == 0) al_l[r32] = (a); asm volatile("s_waitcnt lgkmcnt(0)" ::: "memory"); \
    for (int d = 0; d < 4; ++d) for (int r = 0; r < 16; ++r) o[d][r] *= al_l[crow(r, hi)]; } } while (0)
  f32x16 pA0, pA1, pB0, pB1; float mnA, mnB, alA, alB; bf16x8 pa0, pa1, pa2, pa3; const int NT = seq / KVBLK;
  constexpr int SE = 0, SO = SDEPTH - 1;
  SLOAD(SE, 0); asm volatile("s_waitcnt vmcnt(0)" ::: "memory"); SWRITE(0, SE); __syncthreads();
  qkt(pA0, pA1, K_lds, qr, r32, hi); partialSM(pA0, pA1, m_reg, mnA, alA);
  SLOAD(SO, KVBLK); if constexpr (SDEPTH == 2) { if (2 < NT) SLOAD(SE, 2 * KVBLK); }
  SWAIT(); SWRITE(1, SO); __syncthreads();
  for (int j = 1; j + 1 < NT; j += 2) {
    SBAR(); qkt(pB0, pB1, K_lds + SHM_K, qr, r32, hi);
    finishSM(pA0, pA1, alA, l_reg, pa0, pa1, pa2, pa3); SBAR();
    SLOAD(SO, (j + SDEPTH) * KVBLK); SBAR();
    pv_d0(o, vb0, pa0, pa1, pa2, pa3); partialSM(pB0, pB1, m_reg, mnB, alB);
    __syncthreads(); SWAIT(); SWRITE(0, SE);
    RESC(alB); __syncthreads();
    SBAR(); qkt(pA0, pA1, K_lds, qr, r32, hi);
    finishSM(pB0, pB1, alB, l_reg, pa0, pa1, pa2, pa3); SBAR();
    if (SDEPTH == 1 || j + 3 < NT) SLOAD(SE, (j + 1 + SDEPTH) * KVBLK); SBAR();
    pv_d0(o, vb0 + (int)SHM_V, pa0, pa1, pa2, pa3); partialSM(pA0, pA1, m_reg, mnA, alA);
    __syncthreads(); SWAIT(); SWRITE(1, SO);
    RESC(alA); __syncthreads();
  }
  SBAR(); qkt(pB0, pB1, K_lds + SHM_K, qr, r32, hi);
  finishSM(pA0, pA1, alA, l_reg, pa0, pa1, pa2, pa3); SBAR();
  pv_d0(o, vb0, pa0, pa1, pa2, pa3); partialSM(pB0, pB1, m_reg, mnB, alB);
  __syncthreads(); RESC(alB);
  finishSM(pB0, pB1, alB, l_reg, pa0, pa1, pa2, pa3); SBAR();
  pv_d0(o, vb0 + (int)SHM_V, pa0, pa1, pa2, pa3);
  if (hi == 0) li_l[r32] = l_reg; asm volatile("s_waitcnt lgkmcnt(0)" ::: "memory");
  float rli[16];
#pragma unroll
  for (int r = 0; r < 16; ++r) rli[r] = __builtin_amdgcn_rcpf(li_l[crow(r, hi)]);
  bf16_t* Ow = Ob + (long)(wid * QBLK) * LDO;
#pragma unroll
  for (int r = 0; r < 16; ++r) { int orow = crow(r, hi);
    for (int d0 = 0; d0 < 4; ++d0) Ow[(long)orow * LDO + d0 * 32 + r32] = f2bf(o[d0][r] * rli[r]); }
  asm volatile("s_waitcnt vmcnt(0)" ::: "memory");
  __syncthreads();
#undef SLOAD
#undef SWRITE
#undef SWAIT
#undef RESC
}
}

template <int K, int NT>
__device__ __forceinline__ void mma_tile(f32x4 (&acc)[4][NT], const LAS bf16_t* A, int lda, const LAS bf16_t* Bt, int ldb, int wr, int wc, int fr, int fq) {
#pragma unroll 1
    for (int k0 = 0; k0 < K; k0 += 32) {
        bf16x8 a[4], b[NT];
#pragma unroll
        for (int m = 0; m < 4; ++m) a[m] = *(const LAS bf16x8*)(A + (64 * wr + 16 * m + fr) * lda + k0 + fq * 8);
#pragma unroll
        for (int n = 0; n < NT; ++n) b[n] = *(const LAS bf16x8*)(Bt + (16 * NT * wc + 16 * n + fr) * ldb + k0 + fq * 8);
#pragma unroll
        for (int m = 0; m < 4; ++m)
#pragma unroll
            for (int n = 0; n < NT; ++n) acc[m][n] = __builtin_amdgcn_mfma_f32_16x16x32_bf16(a[m], b[n], acc[m][n], 0, 0, 0);
    }
}
template <int NT> __device__ __forceinline__ void zero_acc(f32x4 (&acc)[4][NT]) {
#pragma unroll
    for (int m = 0; m < 4; ++m)
#pragma unroll
        for (int n = 0; n < NT; ++n) acc[m][n] = (f32x4){0.f, 0.f, 0.f, 0.f};
}
template <int R, int C> __device__ __forceinline__ void stage_N(LAS bf16_t* dst, int ld, const bf16_t* __restrict__ src, size_t ldg) {
    constexpr int CH = C / 8;
    for (int idx = ltid(); idx < R * CH; idx += 512) { const int r = idx / CH, c = (idx % CH) * 8;
        *(LAS u32x4*)(dst + r * ld + c) = *(const u32x4*)(src + (size_t)r * ldg + c); }
}
template <int C, bool SCL> __device__ __forceinline__ void stage_T(LAS bf16_t* dst, int ld, const bf16_t* __restrict__ src, size_t ldg, const LAS float* sc) {
    for (int idx = ltid(); idx < 128 * (C / 8); idx += 512) { const int r = idx & 127, c0 = (idx >> 7) * 8;
        const u32x4 w = *(const u32x4*)(src + (size_t)r * ldg + c0); float f[8]; unpack8(w, f);
        float s = 1.f; if (SCL) s = sc[r];
#pragma unroll
        for (int i = 0; i < 8; ++i) dst[(c0 + i) * ld + r] = f2bf(f[i] * s); }
}
template <int R, int C> __device__ __forceinline__ void ld_N(u32x4 (&r)[R * C / 8 / 512], const bf16_t* __restrict__ src, size_t ldg, int tid) {
    constexpr int CH = C / 8;
#pragma unroll
    for (int i = 0; i < R * CH / 512; ++i) { const int idx = tid + 512 * i, rr = idx / CH, c = (idx % CH) * 8; r[i] = *(const u32x4*)(src + (size_t)rr * ldg + c); }
}
template <int R, int C> __device__ __forceinline__ void st_N(LAS bf16_t* dst, int ld, const u32x4 (&r)[R * C / 8 / 512], int tid) {
    constexpr int CH = C / 8;
#pragma unroll
    for (int i = 0; i < R * CH / 512; ++i) { const int idx = tid + 512 * i, rr = idx / CH, c = (idx % CH) * 8; *(LAS u32x4*)(dst + rr * ld + c) = r[i]; }
}
template <int C> __device__ __forceinline__ void ld_T(u32x4 (&r)[128 * C / 8 / 512], const bf16_t* __restrict__ src, size_t ldg, int tid) {
#pragma unroll
    for (int i = 0; i < 128 * C / 8 / 512; ++i) { const int idx = tid + 512 * i, rr = idx & 127, c0 = (idx >> 7) * 8; r[i] = *(const u32x4*)(src + (size_t)rr * ldg + c0); }
}
template <int C, bool SCL> __device__ __forceinline__ void st_T(LAS bf16_t* dst, int ld, const u32x4 (&r)[128 * C / 8 / 512], const LAS float* sc, int tid) {
#pragma unroll
    for (int i = 0; i < 128 * C / 8 / 512; ++i) { const int idx = tid + 512 * i, rr = idx & 127, c0 = (idx >> 7) * 8;
        if (SCL) { float f[8]; unpack8(r[i], f); const float sv = sc[rr];
#pragma unroll
            for (int k = 0; k < 8; ++k) dst[(c0 + k) * ld + rr] = f2bf(f[k] * sv); }
        else { const unsigned w[4] = {r[i].x, r[i].y, r[i].z, r[i].w};
#pragma unroll
            for (int k = 0; k < 4; ++k) { dst[(c0 + 2 * k) * ld + rr] = (bf16_t)(w[k] & 0xffffu); dst[(c0 + 2 * k + 1) * ld + rr] = (bf16_t)(w[k] >> 16); } } }
}
__device__ __forceinline__ float scan_add64(float v, int lane) {
#pragma unroll
    for (int o = 1; o < 64; o <<= 1) { const float t = __shfl_up(v, o); if (lane >= o) v += t; } return v; }
__device__ __forceinline__ float scan_max64(float v, int lane) {
#pragma unroll
    for (int o = 1; o < 64; o <<= 1) { const float t = __shfl_up(v, o); if (lane >= o) v = fmaxf(v, t); } return v; }

constexpr int CB0 = 0, CB1 = 34816, CB2 = 69632, CB3 = 104448, CVEC = 139264;
constexpr int RQB = 0, RKB = 18432, RST_ = 36864, RVT = 71680, RRT = 106496;

struct Bufs {
    bf16_t *Wl, *H, *Y, *QKML, *RQK, *CQN, *CKVN, *CST, *RST, *PROJ, *Q, *K, *V, *ACT;
    float *X, *RC, *RS, *G, *CLOC, *NLOC, *NST, *MLOC, *BLAST, *MST, *RLOC;
};

__device__ __forceinline__ void mlstm_local(const Bufs& B, int item, LAS unsigned char* lds) {
    const int tid = ltid(), wid = tid >> 6, lane = tid & 63, wr = wid >> 2, wc = wid & 3, fr = lane & 15, fq = lane >> 4;
    const int c = item & 63, h = (item >> 6) & 3, dir = item >> 8, s0 = c * 128;
    LAS bf16_t* T0 = (LAS bf16_t*)(lds + CB0); LAS bf16_t* T1 = (LAS bf16_t*)(lds + CB1); LAS float* ve = (LAS float*)(lds + CVEC);
    u32x4 rk[4], rv[4];
    ld_T<128>(rk, B.QKML + (size_t)s0 * 1024 + 512 + h * 128, 1024, tid);
    ld_T<128>(rv, B.PROJ + (size_t)s0 * NPROJP + PC_MLV + h * 128, NPROJP, tid);
    if (wid == 0) {
        const int l0 = 2 * lane, l1 = l0 + 1, p0 = dir ? 127 - l0 : l0, p1 = dir ? 127 - l1 : l1, gi = 8 * dir + h, gf = gi + 4;
        const float li0 = B.G[(size_t)(s0 + p0) * 16 + gi], lf0 = B.G[(size_t)(s0 + p0) * 16 + gf], li1 = B.G[(size_t)(s0 + p1) * 16 + gi], lf1 = B.G[(size_t)(s0 + p1) * 16 + gf];
        const float t = lf0 + lf1, incl = scan_add64(t, lane), b0 = incl - t + lf0, b1 = incl, btot = __shfl(incl, 63);
        const float w0 = btot - b0 + li0, w1 = btot - b1 + li1, mloc = wave_max(fmaxf(w0, w1));
        ve[p0] = __expf(w0 - mloc); ve[p1] = __expf(w1 - mloc);
        if (lane == 0) { B.MLOC[item] = mloc; B.BLAST[item] = btot; }
    }
    st_T<128, false>(T0, 136, rk, ve, tid);
    __syncthreads();
    st_T<128, true>(T1, 136, rv, ve, tid);
    __syncthreads();
    f32x4 acc[4][2]; zero_acc<2>(acc);
    mma_tile<128, 2>(acc, T1, 136, T0, 136, wr, wc, fr, fq);
    float* dst = B.CLOC + (size_t)item * 16384;
#pragma unroll
    for (int m = 0; m < 4; ++m)
#pragma unroll
        for (int n = 0; n < 2; ++n)
#pragma unroll
            for (int j = 0; j < 4; ++j) dst[(64 * wr + 16 * m + 4 * fq + j) * 128 + 32 * wc + 16 * n + fr] = acc[m][n][j];
    { const int dk = tid >> 2, qd = tid & 3; float s = 0.f;
#pragma unroll
        for (int i = 0; i < 4; ++i) { float kv[8]; unpack8(*(const LAS u32x4*)(T0 + dk * 136 + qd * 32 + i * 8), kv);
#pragma unroll
            for (int k = 0; k < 8; ++k) s += kv[k] * ve[qd * 32 + i * 8 + k]; }
        s += __shfl_xor(s, 1); s += __shfl_xor(s, 2);
        if (qd == 0) B.NLOC[(size_t)item * 128 + dk] = s; }
    __syncthreads();
}

__device__ __forceinline__ void ret_local(const Bufs& B, int item, LAS unsigned char* lds) {
    const int tid = ltid(), wid = tid >> 6, lane = tid & 63, wr = wid >> 2, wc = wid & 3, fr = lane & 15, fq = lane >> 4;
    const int c = item & 63, h = (item >> 6) & 3, dir = item >> 8, s0 = c * 128, hd = dir ? 3 - h : h;
    const float lg = log1pf(-exp2f(-5.f - (float)hd));
    LAS bf16_t* T0 = (LAS bf16_t*)(lds + CB0); LAS bf16_t* T1 = (LAS bf16_t*)(lds + CB1); LAS float* vz = (LAS float*)(lds + CVEC);
    u32x4 rk[2], rv[4];
    ld_T<64>(rk, B.RQK + (size_t)s0 * 512 + 256 + h * 64, 512, tid);
    ld_T<128>(rv, B.PROJ + (size_t)s0 * NPROJP + PC_RV + h * 128, NPROJP, tid);
    if (tid < 128) { const int lp = dir ? 127 - tid : tid; vz[tid] = __expf((float)(127 - lp) * lg); }
    st_T<64, false>(T0, 136, rk, vz, tid);
    __syncthreads();
    st_T<128, true>(T1, 136, rv, vz, tid);
    __syncthreads();
    f32x4 acc[4][1]; zero_acc<1>(acc);
    mma_tile<128, 1>(acc, T1, 136, T0, 136, wr, wc, fr, fq);
    float* dst = B.RLOC + (size_t)item * 8192;
#pragma unroll
    for (int m = 0; m < 4; ++m)
#pragma unroll
        for (int j = 0; j < 4; ++j) dst[(64 * wr + 16 * m + 4 * fq + j) * 64 + 16 * wc + fr] = acc[m][0][j];
    __syncthreads();
}

__device__ __forceinline__ void scan_phase(const Bufs& B) {
    const int gt = lbid() * 512 + ltid();
    if (gt < 131072) {
        const int dh = gt >> 14, idx = gt & 16383, dir = dh >> 2;
        float cst = 0.f, nst = 0.f, m = -1e30f;
#pragma unroll 1
        for (int s0 = 0; s0 < 64; s0 += 16) {
            float cl[16], ml[16], bl[16], nl[16];
#pragma unroll
            for (int u = 0; u < 16; ++u) { const int ch = dir ? 63 - (s0 + u) : s0 + u, it = dh * 64 + ch;
                cl[u] = B.CLOC[(size_t)it * 16384 + idx]; ml[u] = B.MLOC[it]; bl[u] = B.BLAST[it]; nl[u] = idx < 128 ? B.NLOC[(size_t)it * 128 + idx] : 0.f; }
#pragma unroll
            for (int u = 0; u < 16; ++u) { const int ch = dir ? 63 - (s0 + u) : s0 + u, it = dh * 64 + ch;
                B.CST[(size_t)it * 16384 + idx] = f2bf(cst);
                if (idx < 128) { B.NST[(size_t)it * 128 + idx] = nst; if (idx == 0) B.MST[it] = m; }
                const float mnew = fmaxf(bl[u] + m, ml[u]), a = __expf(bl[u] + m - mnew), g = __expf(ml[u] - mnew);
                cst = a * cst + g * cl[u]; nst = a * nst + g * nl[u]; m = mnew; }
        }
    }
    if (gt < 65536) {
        const int dh = gt >> 13, idx = gt & 8191, dir = dh >> 2, h = dh & 3, hd = dir ? 3 - h : h;
        const float cd = __expf(128.f * log1pf(-exp2f(-5.f - (float)hd)));
        float r = 0.f;
#pragma unroll 1
        for (int s0 = 0; s0 < 64; s0 += 16) {
            float rl[16];
#pragma unroll
            for (int u = 0; u < 16; ++u) { const int ch = dir ? 63 - (s0 + u) : s0 + u; rl[u] = B.RLOC[(size_t)(dh * 64 + ch) * 8192 + idx]; }
#pragma unroll
            for (int u = 0; u < 16; ++u) { const int ch = dir ? 63 - (s0 + u) : s0 + u; B.RST[(size_t)(dh * 64 + ch) * 8192 + idx] = f2bf(r); r = cd * r + rl[u]; }
        }
    }
}

__device__ __forceinline__ void mlstm_out(const Bufs& B, const float* __restrict__ g_out, int item, LAS unsigned char* lds) {
    const int tid = ltid(), wid = tid >> 6, lane = tid & 63, wr = wid >> 2, wc = wid & 3, fr = lane & 15, fq = lane >> 4;
    const int c = item >> 2, h = item & 3, s0 = c * 128;
    constexpr float SC = 0.08838834764831845f;
    LAS bf16_t* T0 = (LAS bf16_t*)(lds + CB0); LAS bf16_t* T1 = (LAS bf16_t*)(lds + CB1); LAS bf16_t* T2 = (LAS bf16_t*)(lds + CB2); LAS bf16_t* T3 = (LAS bf16_t*)(lds + CB3);
    LAS float* vea = (LAS float*)(lds + CVEC); LAS float* veM = vea + 256; LAS float* vedn = vea + 512; LAS float* vn = vea + 768; LAS float* vqn = vea + 1024;
    LAS float* vrs = vea + 1280; LAS float* vf = vea + 1408; LAS float* vsc = vea + 1536;
    LAS float* HT = (LAS float*)(lds + CB1);
    const float mst0 = B.MST[(0 * 4 + h) * 64 + c], mst1 = B.MST[(1 * 4 + h) * 64 + c];
    { u32x4 rq[4], rk[4], rv[4], rc[4];
        ld_N<128, 128>(rq, B.QKML + (size_t)s0 * 1024 + h * 128, 1024, tid);
        ld_N<128, 128>(rk, B.QKML + (size_t)s0 * 1024 + 512 + h * 128, 1024, tid);
        ld_T<128>(rv, B.PROJ + (size_t)s0 * NPROJP + PC_MLV + h * 128, NPROJP, tid);
        ld_N<128, 128>(rc, B.CST + (size_t)((0 * 4 + h) * 64 + c) * 16384, 128, tid);
        st_N<128, 128>(T0, 136, rq, tid); st_N<128, 128>(T1, 136, rk, tid); st_T<128, false>(T2, 136, rv, vea, tid); st_N<128, 128>(T3, 136, rc, tid); }
    if (wid < 2) {
        const int dir = wid; const float mst = dir ? mst1 : mst0;
        const int l0 = 2 * lane, l1 = l0 + 1, p0 = dir ? 127 - l0 : l0, p1 = dir ? 127 - l1 : l1, gi = 8 * dir + h, gf = gi + 4;
        const float li0 = B.G[(size_t)(s0 + p0) * 16 + gi], lf0 = B.G[(size_t)(s0 + p0) * 16 + gf], li1 = B.G[(size_t)(s0 + p1) * 16 + gi], lf1 = B.G[(size_t)(s0 + p1) * 16 + gf];
        const float t = lf0 + lf1, incl = scan_add64(t, lane), b0 = incl - t + lf0, b1 = incl;
        const float a0 = li0 - b0, a1 = li1 - b1, inm = scan_max64(fmaxf(a0, a1), lane);
        float exm = __shfl_up(inm, 1); if (lane == 0) exm = -3.0e38f;
        const float A0 = fmaxf(exm, a0), A1 = inm, amax = __shfl(inm, 63), cc = fmaxf(amax, mst);
        const float M0 = fmaxf(A0, mst), M1 = fmaxf(A1, mst);
        vea[dir * 128 + p0] = __expf(a0 - cc); vea[dir * 128 + p1] = __expf(a1 - cc);
        veM[dir * 128 + p0] = __expf(cc - M0) * SC; veM[dir * 128 + p1] = __expf(cc - M1) * SC;
        vedn[dir * 128 + p0] = __expf(-(b0 + M0)); vedn[dir * 128 + p1] = __expf(-(b1 + M1));
        if (lane == 0) vsc[dir] = __expf(mst - cc);
    }
    if (tid < 256) { const int dir = tid >> 7, d = tid & 127; vn[tid] = B.NST[(size_t)((dir * 4 + h) * 64 + c) * 128 + d]; }
    __syncthreads();
    f32x4 accS[4][2]; zero_acc<2>(accS);
    mma_tile<128, 2>(accS, T1, 136, T0, 136, wr, wc, fr, fq);
    { const int row = tid >> 2, qd = tid & 3; float q0 = 0.f, q1 = 0.f;
#pragma unroll
        for (int i = 0; i < 4; ++i) { float qv[8]; unpack8(*(const LAS u32x4*)(T0 + row * 136 + qd * 32 + i * 8), qv);
            const f32x4 n0a = *(const LAS f32x4*)(vn + qd * 32 + i * 8), n0b = *(const LAS f32x4*)(vn + qd * 32 + i * 8 + 4);
            const f32x4 n1a = *(const LAS f32x4*)(vn + 128 + qd * 32 + i * 8), n1b = *(const LAS f32x4*)(vn + 128 + qd * 32 + i * 8 + 4);
#pragma unroll
            for (int k = 0; k < 4; ++k) { q0 += qv[k] * n0a[k] + qv[4 + k] * n0b[k]; q1 += qv[k] * n1a[k] + qv[4 + k] * n1b[k]; } }
        q0 += __shfl_xor(q0, 1); q0 += __shfl_xor(q0, 2); q1 += __shfl_xor(q1, 1); q1 += __shfl_xor(q1, 2);
        if (qd == 0) { vqn[row] = q0; vqn[128 + row] = q1; } }
    __syncthreads();
    f32x4 hacc[4][2]; zero_acc<2>(hacc);
    u32x4 rc1[4]; ld_N<128, 128>(rc1, B.CST + (size_t)((1 * 4 + h) * 64 + c) * 16384, 128, tid);
#pragma unroll 1
    for (int dir = 0; dir < 2; ++dir) {
        if (dir == 1) st_N<128, 128>(T3, 136, rc1, tid);
        const float r = vsc[dir];
#pragma unroll
        for (int m = 0; m < 4; ++m)
#pragma unroll
            for (int n = 0; n < 2; ++n) { const int l = 32 * wc + 16 * n + fr, sb = 64 * wr + 16 * m + 4 * fq;
                const f32x4 e4 = *(const LAS f32x4*)(vea + dir * 128 + sb); float v[4];
#pragma unroll
                for (int j = 0; j < 4; ++j) { const int s = sb + j; const bool ok = dir ? (s >= l) : (s <= l); v[j] = ok ? accS[m][n][j] * e4[j] : 0.f; }
                u32x2 w; w.x = cvt_pk_bf16(v[0], v[1]); w.y = cvt_pk_bf16(v[2], v[3]);
                *(LAS u32x2*)(T1 + l * 136 + sb) = w; }
        __syncthreads();
        { const int row = tid >> 2, qd = tid & 3; float s = 0.f;
#pragma unroll
            for (int i = 0; i < 4; ++i) { float sv[8]; unpack8(*(const LAS u32x4*)(T1 + row * 136 + qd * 32 + i * 8), sv);
#pragma unroll
                for (int k = 0; k < 8; ++k) s += sv[k]; }
            s += __shfl_xor(s, 1); s += __shfl_xor(s, 2);
            if (qd == 0) { const float eM = veM[dir * 128 + row], den = eM * (s + r * vqn[dir * 128 + row]);
                vf[row] = eM / fmaxf(fabsf(den), vedn[dir * 128 + row]); } }
        f32x4 accN[4][2]; zero_acc<2>(accN);
        mma_tile<128, 2>(accN, T0, 136, T3, 136, wr, wc, fr, fq);
#pragma unroll
        for (int m = 0; m < 4; ++m)
#pragma unroll
            for (int n = 0; n < 2; ++n) accN[m][n] *= r;
        mma_tile<128, 2>(accN, T1, 136, T2, 136, wr, wc, fr, fq);
        __syncthreads();
#pragma unroll
        for (int m = 0; m < 4; ++m) { const f32x4 f4 = *(const LAS f32x4*)(vf + 64 * wr + 16 * m + 4 * fq);
#pragma unroll
            for (int n = 0; n < 2; ++n) hacc[m][n] += accN[m][n] * f4; }
        __syncthreads();
    }
    const int erow = tid >> 2, eqd = tid & 3, es = s0 + erow;
    u32x4 og4[4]; f32x4 gp4[8];
    { const bf16_t* og = B.PROJ + (size_t)es * NPROJP + PC_MLO + h * 128 + eqd * 32; const float* gp = g_out + h * 128 + eqd * 32;
#pragma unroll
        for (int i = 0; i < 4; ++i) og4[i] = *(const u32x4*)(og + i * 8);
#pragma unroll
        for (int i = 0; i < 8; ++i) gp4[i] = *(const f32x4*)(gp + i * 4); }
#pragma unroll
    for (int m = 0; m < 4; ++m)
#pragma unroll
        for (int n = 0; n < 2; ++n)
#pragma unroll
            for (int j = 0; j < 4; ++j) HT[(64 * wr + 16 * m + 4 * fq + j) * 132 + 32 * wc + 16 * n + fr] = hacc[m][n][j];
    __syncthreads();
    { float ssq = 0.f; f32x4 x4[8];
#pragma unroll
        for (int i = 0; i < 8; ++i) { x4[i] = *(const LAS f32x4*)(HT + erow * 132 + eqd * 32 + i * 4);
            ssq += x4[i][0] * x4[i][0] + x4[i][1] * x4[i][1] + x4[i][2] * x4[i][2] + x4[i][3] * x4[i][3]; }
        ssq += __shfl_xor(ssq, 1); ssq += __shfl_xor(ssq, 2);
        const float rstd = rsqrtf(ssq * (1.f / 128.f) + EPS_);
        bf16_t* yo = B.Y + (size_t)es * DM + h * 128 + eqd * 32;
#pragma unroll
        for (int i = 0; i < 4; ++i) { float o8[8]; unpack8(og4[i], o8); float r8[8];
#pragma unroll
            for (int k = 0; k < 8; ++k) { const float sg = __builtin_amdgcn_rcpf(1.f + __expf(-o8[k])); r8[k] = sg * x4[2 * i + (k >> 2)][k & 3] * rstd * gp4[2 * i + (k >> 2)][k & 3]; }
            *(u32x4*)(yo + i * 8) = pack8(r8); } }
    __syncthreads();
}

__device__ __forceinline__ void ret_out(const Bufs& B, const float* __restrict__ g_out, int item, LAS unsigned char* lds) {
    const int tid = ltid(), wid = tid >> 6, lane = tid & 63, wr = wid >> 2, wc = wid & 3, fr = lane & 15, fq = lane >> 4;
    const int c = item >> 2, h = item & 3, s0 = c * 128;
    LAS bf16_t* QB = (LAS bf16_t*)(lds + RQB); LAS bf16_t* KB = (LAS bf16_t*)(lds + RKB); LAS bf16_t* ST = (LAS bf16_t*)(lds + RST_); LAS bf16_t* VT = (LAS bf16_t*)(lds + RVT); LAS bf16_t* RT = (LAS bf16_t*)(lds + RRT);
    LAS float* HT = (LAS float*)(lds + RST_); LAS float* vcs = (LAS float*)(lds + CVEC); LAS float* vrw = vcs + 256;
    u32x4 rr1[2];
    { u32x4 rq[2], rk[2], rv[4], rr0[2];
        ld_N<128, 64>(rq, B.RQK + (size_t)s0 * 512 + h * 64, 512, tid);
        ld_N<128, 64>(rk, B.RQK + (size_t)s0 * 512 + 256 + h * 64, 512, tid);
        ld_T<128>(rv, B.PROJ + (size_t)s0 * NPROJP + PC_RV + h * 128, NPROJP, tid);
        ld_N<128, 64>(rr0, B.RST + (size_t)((0 * 4 + h) * 64 + c) * 8192, 64, tid);
        ld_N<128, 64>(rr1, B.RST + (size_t)((1 * 4 + h) * 64 + c) * 8192, 64, tid);
        st_N<128, 64>(QB, 72, rq, tid); st_N<128, 64>(KB, 72, rk, tid); st_T<128, false>(VT, 136, rv, HT, tid); st_N<128, 64>(RT, 72, rr0, tid); }
    if (tid < 256) { const int dir = tid >> 7, p = tid & 127, lp = dir ? 127 - p : p, hd = dir ? 3 - h : h; const float lg = log1pf(-exp2f(-5.f - (float)hd));
        vcs[tid] = __expf(-(float)lp * lg); vrw[tid] = __expf((float)lp * lg); }
    __syncthreads();
    f32x4 accS[4][2]; zero_acc<2>(accS);
    mma_tile<64, 2>(accS, KB, 72, QB, 72, wr, wc, fr, fq);
    f32x4 yacc[4][2]; zero_acc<2>(yacc);
#pragma unroll 1
    for (int dir = 0; dir < 2; ++dir) {
        const int hd = dir ? 3 - h : h; const float gam = 1.f - exp2f(-5.f - (float)hd);
        if (dir == 1) st_N<128, 64>(RT, 72, rr1, tid);
#pragma unroll
        for (int m = 0; m < 4; ++m)
#pragma unroll
            for (int n = 0; n < 2; ++n) { const int l = 32 * wc + 16 * n + fr, sb = 64 * wr + 16 * m + 4 * fq;
                const f32x4 c4 = *(const LAS f32x4*)(vcs + dir * 128 + sb); float v[4];
#pragma unroll
                for (int j = 0; j < 4; ++j) { const int s = sb + j; const bool ok = dir ? (s >= l) : (s <= l); v[j] = ok ? accS[m][n][j] * c4[j] : 0.f; }
                u32x2 w; w.x = cvt_pk_bf16(v[0], v[1]); w.y = cvt_pk_bf16(v[2], v[3]);
                *(LAS u32x2*)(ST + l * 136 + sb) = w; }
        __syncthreads();
        f32x4 accR[4][2]; zero_acc<2>(accR);
        mma_tile<64, 2>(accR, QB, 72, RT, 72, wr, wc, fr, fq);
#pragma unroll
        for (int m = 0; m < 4; ++m)
#pragma unroll
            for (int n = 0; n < 2; ++n) accR[m][n] *= gam;
        mma_tile<128, 2>(accR, ST, 136, VT, 136, wr, wc, fr, fq);
        __syncthreads();
#pragma unroll
        for (int m = 0; m < 4; ++m) { const f32x4 r4 = *(const LAS f32x4*)(vrw + dir * 128 + 64 * wr + 16 * m + 4 * fq);
#pragma unroll
            for (int n = 0; n < 2; ++n) yacc[m][n] += accR[m][n] * r4; }
    }
    const int erow = tid >> 2, eqd = tid & 3, es = s0 + erow;
    u32x4 og4[4]; f32x4 gp4[8];
    { const bf16_t* gg = B.PROJ + (size_t)es * NPROJP + PC_RG + h * 128 + eqd * 32; const float* gp = g_out + h * 128 + eqd * 32;
#pragma unroll
        for (int i = 0; i < 4; ++i) og4[i] = *(const u32x4*)(gg + i * 8);
#pragma unroll
        for (int i = 0; i < 8; ++i) gp4[i] = *(const f32x4*)(gp + i * 4); }
#pragma unroll
    for (int m = 0; m < 4; ++m)
#pragma unroll
        for (int n = 0; n < 2; ++n)
#pragma unroll
            for (int j = 0; j < 4; ++j) HT[(64 * wr + 16 * m + 4 * fq + j) * 132 + 32 * wc + 16 * n + fr] = yacc[m][n][j];
    __syncthreads();
    { float ssq = 0.f; f32x4 x4[8];
#pragma unroll
        for (int i = 0; i < 8; ++i) { x4[i] = *(const LAS f32x4*)(HT + erow * 132 + eqd * 32 + i * 4);
            ssq += x4[i][0] * x4[i][0] + x4[i][1] * x4[i][1] + x4[i][2] * x4[i][2] + x4[i][3] * x4[i][3]; }
        ssq += __shfl_xor(ssq, 1); ssq += __shfl_xor(ssq, 2);
        const float rstd = rsqrtf(ssq * (1.f / 128.f) + EPS_);
        bf16_t* yo = B.Y + (size_t)es * DM + 512 + h * 128 + eqd * 32;
#pragma unroll
        for (int i = 0; i < 4; ++i) { float o8[8]; unpack8(og4[i], o8); float r8[8];
#pragma unroll
            for (int k = 0; k < 8; ++k) { const float sl = o8[k] * __builtin_amdgcn_rcpf(1.f + __expf(-o8[k])); r8[k] = sl * x4[2 * i + (k >> 2)][k & 3] * rstd * gp4[2 * i + (k >> 2)][k & 3]; }
            *(u32x4*)(yo + i * 8) = pack8(r8); } }
    __syncthreads();
}

__device__ __forceinline__ int map_col(int n, int mode) {
    if (mode == 1) { const int h = n / 192, d = n % 192; if (d < 128) return h * 128 + d; const int jj = d - 128; return 1024 + h * 64 + 2 * (jj & 31) + (jj >> 5); }
    if (mode == 2) { const int h = n >> 8, d = n & 255; return d < 128 ? h * 128 + d : 1024 + h * 128 + (d - 128); }
    return n;
}
struct CvtTile { const float* W; bf16_t* dst; const float* gk; int K, N, kt, nt, mode; };
constexpr int TILES_L = 576 + 48 + 32 + 256 + 1024 + 1024;
__device__ __forceinline__ CvtTile cvt_get(const Params& p, int t) {
    const int l = t / TILES_L; int r = t % TILES_L; unsigned char* Wl = p.ws + OFF_W + (size_t)l * SZ_WL; CvtTile c; int nT; c.mode = 0; c.gk = nullptr;
    if (r < 576) { c.W = p.w_in + (size_t)l * DM * NPROJ; c.K = DM; c.N = NPROJ; nT = 18; c.dst = (bf16_t*)(Wl + WO_IN); c.gk = p.g_mix + l * DM; }
    else if ((r -= 576) < 48) { c.W = p.w_q_up + (size_t)l * 512 * 1536; c.K = 512; c.N = 1536; nT = 6; c.mode = 1; c.dst = (bf16_t*)(Wl + WO_Q); }
    else if ((r -= 48) < 32) { c.W = p.w_kv_up + (size_t)l * 256 * 2048; c.K = 256; c.N = 2048; nT = 8; c.mode = 2; c.dst = (bf16_t*)(Wl + WO_KV); }
    else if ((r -= 32) < 256) { c.W = p.w_out + (size_t)l * DM * DM; c.K = DM; c.N = DM; nT = 8; c.dst = (bf16_t*)(Wl + WO_OUT); }
    else if ((r -= 256) < 1024) { c.W = p.w_ff1 + (size_t)l * DM * DFF; c.K = DM; c.N = DFF; nT = 32; c.dst = (bf16_t*)(Wl + WO_1); c.gk = p.g_ffn + l * DM; }
    else { r -= 1024; c.W = p.w_ff2 + (size_t)l * DFF * DM; c.K = DFF; c.N = DM; nT = 8; c.dst = (bf16_t*)(Wl + WO_2); }
    c.kt = r / nT; c.nt = r % nT; return c;
}
__device__ __forceinline__ void cvt_load(const CvtTile& c, f32x4 (&v)[8], int tid) {
#pragma unroll
    for (int i = 0; i < 8; ++i) { const int k = (tid >> 6) + 8 * i, gn = c.nt * 256 + (tid & 63) * 4;
        v[i] = (f32x4){0.f, 0.f, 0.f, 0.f};
        if (gn < c.N) { v[i] = __builtin_nontemporal_load((const f32x4*)(c.W + (size_t)(c.kt * 64 + k) * c.N + gn)); if (c.gk) v[i] = v[i] * c.gk[c.kt * 64 + k]; } }
}
__device__ __forceinline__ void convert_phase(const Params& p, LAS unsigned char* lds) {
    LAS float* T = (LAS float*)lds;
    const int tid = ltid(), G = gridDim.x;
    int t = lbid();
    f32x4 v[8]; CvtTile c;
    if (t < NLAYER * TILES_L) { c = cvt_get(p, t); cvt_load(c, v, tid); }
    while (t < NLAYER * TILES_L) {
#pragma unroll
        for (int i = 0; i < 8; ++i) { const int k = (tid >> 6) + 8 * i, n4 = (tid & 63) * 4;
            T[k * 257 + n4] = v[i][0]; T[k * 257 + n4 + 1] = v[i][1]; T[k * 257 + n4 + 2] = v[i][2]; T[k * 257 + n4 + 3] = v[i][3]; }
        __syncthreads();
        const CvtTile cur = c; const int tn = t + G;
        if (tn < NLAYER * TILES_L) { c = cvt_get(p, tn); cvt_load(c, v, tid); }
#pragma unroll
        for (int i = 0; i < 4; ++i) { const int ch = tid + 512 * i, n = ch >> 3, k8 = (ch & 7) * 8, gn = cur.nt * 256 + n;
            if (gn < cur.N) { float f[8];
#pragma unroll
                for (int j = 0; j < 8; ++j) f[j] = T[(k8 + j) * 257 + n];
                *(u32x4*)(cur.dst + (size_t)map_col(gn, cur.mode) * cur.K + cur.kt * 64 + k8) = pack8(f); } }
        __syncthreads();
        t = tn;
    }
    constexpr int PADV = (NPROJP - NPROJ) * DM * 2 / 16;
    for (int i = lbid() * 512 + tid; i < NLAYER * PADV; i += G * 512) { const int l = i / PADV, j = i % PADV;
        ((u32x4*)(p.ws + OFF_W + (size_t)l * SZ_WL + WO_IN + (size_t)NPROJ * DM * 2))[j] = (u32x4){0u, 0u, 0u, 0u}; }
    for (int i = lbid() * 512 + tid; i < S_ * 32; i += G * 512) { const int s = i >> 5, j = i & 31;
        const float inv = powf(10000.f, -(float)j * (1.f / 32.f)); const float ang = (float)p.pos[s] * inv;
        const double a = (double)ang, tw = 6.283185307179586476925; const double r = a - tw * rint(a / tw); const float rf = (float)r;
        ((float*)(p.ws + OFF_ROPE))[i] = __cosf(rf); ((float*)(p.ws + OFF_ROPE))[S_ * 32 + i] = __sinf(rf); }
    { const int wid = tid >> 6, lane = tid & 63; bf16_t* H = (bf16_t*)(p.ws + OFF_H); unsigned long long* ssqa = (unsigned long long*)(p.ws + OFF_SSQA);
        for (int row = lbid() * 8 + wid; row < S_; row += G * 8) { const float* xr = p.x + (size_t)row * DM; float ssq = 0.f;
#pragma unroll
            for (int i = 0; i < 8; ++i) { const int col = (i * 64 + lane) * 4; const f32x4 x = *(const f32x4*)(xr + col);
                ssq += x[0] * x[0] + x[1] * x[1] + x[2] * x[2] + x[3] * x[3];
                u32x2 w; w.x = cvt_pk_bf16(x[0], x[1]); w.y = cvt_pk_bf16(x[2], x[3]); *(u32x2*)(H + (size_t)row * DM + col) = w; }
            ssq = wave_sum(ssq); if (lane == 0) ssqa[row] = (unsigned long long)(ssq * 1048576.f); } }
}

template <int MODE>
__device__ __forceinline__ void rms_phase(const float* __restrict__ src, const float* __restrict__ g, bf16_t* __restrict__ H, float* __restrict__ Xcopy, float* __restrict__ outf) {
    const int wid = ltid() >> 6, lane = ltid() & 63;
    for (int row = lbid() * 8 + wid; row < S_; row += gridDim.x * 8) {
        const float* xr = src + (size_t)row * DM; f32x4 v[8]; float ssq = 0.f;
#pragma unroll
        for (int i = 0; i < 8; ++i) { v[i] = *(const f32x4*)(xr + (i * 64 + lane) * 4); ssq += v[i][0] * v[i][0] + v[i][1] * v[i][1] + v[i][2] * v[i][2] + v[i][3] * v[i][3]; }
        ssq = wave_sum(ssq);
        const float rstd = rsqrtf(ssq * (1.f / DM) + EPS_);
#pragma unroll
        for (int i = 0; i < 8; ++i) { const int col = (i * 64 + lane) * 4; const f32x4 gv = *(const f32x4*)(g + col);
            const f32x4 y = v[i] * rstd * gv;
            if (MODE == 0) { u32x2 w; w.x = cvt_pk_bf16(y[0], y[1]); w.y = cvt_pk_bf16(y[2], y[3]); *(u32x2*)(H + (size_t)row * DM + col) = w;
                if (Xcopy) *(f32x4*)(Xcopy + (size_t)row * DM + col) = v[i]; }
            else *(f32x4*)(outf + (size_t)row * DM + col) = y; }
    }
}

__device__ __forceinline__ void final_phase(const bf16_t* __restrict__ H, const float* __restrict__ g, float* __restrict__ outf) {
    const int tid = ltid(), wid = tid >> 6, lane = tid & 63;
    for (int row = lbid() * 8 + wid; row < S_; row += gridDim.x * 8) {
        float v[32]; float ssq = 0.f;
#pragma unroll
        for (int i = 0; i < 4; ++i) { float f[8]; unpack8(*(const u32x4*)(H + (size_t)row * DM + (i * 64 + lane) * 8), f);
#pragma unroll
            for (int k = 0; k < 8; ++k) { v[i * 8 + k] = f[k]; ssq += f[k] * f[k]; } }
        ssq = wave_sum(ssq);
        const float rstd = rsqrtf(ssq * (1.f / DM) + EPS_);
#pragma unroll
        for (int i = 0; i < 4; ++i) { const int col = (i * 64 + lane) * 8;
#pragma unroll
            for (int q = 0; q < 2; ++q) { const f32x4 gv = *(const f32x4*)(g + col + q * 4); f32x4 y;
#pragma unroll
                for (int k = 0; k < 4; ++k) y[k] = v[i * 8 + q * 4 + k] * rstd * gv[k];
                *(f32x4*)(outf + (size_t)row * DM + col + q * 4) = y; } }
    }
}

__device__ __forceinline__ void prep_phase(const Params& p, const Bufs& B, int l) {
    const int wid = ltid() >> 6, lane = ltid() & 63;
    const float* wconv = p.w_conv + (size_t)l * 3 * 1024; const float* bg = p.b_gates + l * 16;
    const float* gq = p.g_q_norm + l * 512; const float* gkv = p.g_kv_norm + l * 256;
    for (int s = lbid() * 8 + wid; s < S_; s += gridDim.x * 8) {
        const bf16_t* pr = B.PROJ + (size_t)s * NPROJP;
        const u32x4 z4 = (u32x4){0u, 0u, 0u, 0u};
        u32x4 cm[2], cc[2], cp[2];
#pragma unroll
        for (int hf = 0; hf < 2; ++hf) { const int c0 = lane * 16 + hf * 8;
            cm[hf] = s > 0 ? *(const u32x4*)(pr - NPROJP + c0) : z4; cc[hf] = *(const u32x4*)(pr + c0); cp[hf] = s < S_ - 1 ? *(const u32x4*)(pr + NPROJP + c0) : z4; }
        const int tensor = lane >> 5, head = (lane & 31) >> 3, j0 = (lane & 7) * 4, base = PC_RQ + tensor * 256 + head * 64;
        const u32x2 w1 = *(const u32x2*)(pr + base + j0), w2 = *(const u32x2*)(pr + base + 32 + j0);
        const f32x4 rc4 = *(const f32x4*)(B.RC + (size_t)s * 32 + j0), rs4 = *(const f32x4*)(B.RS + (size_t)s * 32 + j0);
        const u32x4 cqv = *(const u32x4*)(pr + PC_CQ + lane * 8); const u32x2 ckvv = *(const u32x2*)(pr + PC_CKV + lane * 4);
        const int l32 = lane & 31, l16 = lane & 15;
        const bf16_t kr1 = pr[PC_KR + l32], kr2 = pr[PC_KR + 32 + l32]; const float krc = B.RC[(size_t)s * 32 + l32], krs = B.RS[(size_t)s * 32 + l32];
        const bf16_t gt = pr[PC_GATE + l16]; const float bgl = bg[l16];
#pragma unroll
        for (int hf = 0; hf < 2; ++hf) { const int c0 = lane * 16 + hf * 8; float xm[8], x0[8], xp[8], r[8];
            unpack8(cm[hf], xm); unpack8(cc[hf], x0); unpack8(cp[hf], xp);
#pragma unroll
            for (int i = 0; i < 8; ++i) { const float v = xm[i] * wconv[c0 + i] + x0[i] * wconv[1024 + c0 + i] + xp[i] * wconv[2048 + c0 + i]; r[i] = v * __builtin_amdgcn_rcpf(1.f + __expf(-v)); }
            *(u32x4*)(B.QKML + (size_t)s * 1024 + c0) = pack8(r); }
        { const float x1[4] = {bflo(w1.x), bfhi(w1.x), bflo(w1.y), bfhi(w1.y)}, x2[4] = {bflo(w2.x), bfhi(w2.x), bflo(w2.y), bfhi(w2.y)};
            const float sc = tensor ? 0.125f : 1.f; float o1[4], o2[4];
#pragma unroll
            for (int i = 0; i < 4; ++i) { o1[i] = (x1[i] * rc4[i] - x2[i] * rs4[i]) * sc; o2[i] = (x2[i] * rc4[i] + x1[i] * rs4[i]) * sc; }
            u32x2 a, b2; a.x = cvt_pk_bf16(o1[0], o1[1]); a.y = cvt_pk_bf16(o1[2], o1[3]); b2.x = cvt_pk_bf16(o2[0], o2[1]); b2.y = cvt_pk_bf16(o2[2], o2[3]);
            bf16_t* d = B.RQK + (size_t)s * 512 + tensor * 256 + head * 64 + j0; *(u32x2*)d = a; *(u32x2*)(d + 32) = b2; }
        { float f[8]; unpack8(cqv, f); float g4[4] = {bflo(ckvv.x), bfhi(ckvv.x), bflo(ckvv.y), bfhi(ckvv.y)};
            float ssq = 0.f, ssk = g4[0] * g4[0] + g4[1] * g4[1] + g4[2] * g4[2] + g4[3] * g4[3];
#pragma unroll
            for (int i = 0; i < 8; ++i) ssq += f[i] * f[i];
#pragma unroll
            for (int o = 32; o > 0; o >>= 1) { ssq += __shfl_xor(ssq, o); ssk += __shfl_xor(ssk, o); }
            const float rstd = rsqrtf(ssq * (1.f / 512.f) + EPS_), rstk = rsqrtf(ssk * (1.f / 256.f) + EPS_);
#pragma unroll
            for (int i = 0; i < 8; ++i) f[i] = f[i] * rstd * gq[lane * 8 + i];
            *(u32x4*)(B.CQN + (size_t)s * 512 + lane * 8) = pack8(f);
#pragma unroll
            for (int i = 0; i < 4; ++i) g4[i] = g4[i] * rstk * gkv[lane * 4 + i];
            u32x2 o; o.x = cvt_pk_bf16(g4[0], g4[1]); o.y = cvt_pk_bf16(g4[2], g4[3]); *(u32x2*)(B.CKVN + (size_t)s * 256 + lane * 4) = o; }
        if (lane < 32) { const float x1 = bf2f(kr1), x2 = bf2f(kr2);
            const unsigned short w = (unsigned short)(__builtin_amdgcn_cvt_pk_fp8_f32(x1 * krc - x2 * krs, x2 * krc + x1 * krs, 0, false) & 0xffff);
#pragma unroll
            for (int h = 0; h < 8; ++h) *(unsigned short*)((unsigned char*)B.K + ((size_t)h * S_ + s) * 192 + 128 + 2 * lane) = w; }
        if (lane < 16) { float v = bf2f(gt) + bgl;
            if ((lane >> 2) & 1) v = fminf(v, 0.f) - log1pf(__expf(-fabsf(v)));
            B.G[(size_t)s * 16 + lane] = v; }
    }
}

constexpr int NSUB = 8;
constexpr int NPHASE = 2 + NLAYER * NSUB;
__global__ void __launch_bounds__(512) mega_fwd(Params p) {
    extern __shared__ __attribute__((aligned(16))) unsigned char lds_raw[];
    LAS unsigned char* lds = (LAS unsigned char*)lds_raw;
    cg::grid_group grid = cg::this_grid();
    const int G = gridDim.x;
    volatile LAS unsigned* xst = (volatile LAS unsigned*)(lds + LDS_BYTES - 16);
    if (threadIdx.x == 0) { xst[0] = 0u; xst[1] = 0u; }
    if (blockIdx.x == 0) { unsigned* bw = (unsigned*)(p.ws + OFF_BAR); for (int i = threadIdx.x; i < XCD_BAR_WORDS; i += 512) bw[i] = 0u; __threadfence(); }
    __syncthreads();
    XcdBarrier xbar; xbar.bar = (unsigned*)(p.ws + OFF_BAR); xbar.x = 0; xbar.st = xst;
    for (int ph = p.ph_lo; ph < p.ph_hi; ++ph) {
        if (ph > p.ph_lo) { if (ph == p.ph_lo + 1) { grid.sync(); xbar = xcd_barrier_post((unsigned*)(p.ws + OFF_BAR), xst); } else xcd_barrier(xbar); }
        const int bx = lbid();
        unsigned char* ws = p.ws; asm volatile("" : "+s"(ws));
        Bufs B;
        B.H = (bf16_t*)(ws + OFF_H); B.Y = (bf16_t*)(ws + OFF_Y); B.QKML = (bf16_t*)(ws + OFF_QKML); B.RQK = (bf16_t*)(ws + OFF_RQK); B.CQN = (bf16_t*)(ws + OFF_CQN);
        B.CKVN = (bf16_t*)(ws + OFF_CKVN); B.CST = (bf16_t*)(ws + OFF_CST); B.RST = (bf16_t*)(ws + OFF_RST); B.PROJ = (bf16_t*)(ws + OFF_PROJ);
        B.Q = (bf16_t*)(ws + OFF_Q); B.K = (bf16_t*)(ws + OFF_K); B.V = (bf16_t*)(ws + OFF_V); B.ACT = (bf16_t*)(ws + OFF_ACT);
        B.X = (float*)(ws + OFF_X); B.RC = (float*)(ws + OFF_ROPE); B.RS = B.RC + S_ * 32; B.G = (float*)(ws + OFF_G); B.CLOC = (float*)(ws + OFF_CLOC);
        B.NLOC = (float*)(ws + OFF_NLOC); B.NST = (float*)(ws + OFF_NST); B.MLOC = (float*)(ws + OFF_MLOC); B.BLAST = (float*)(ws + OFF_BLAST); B.MST = (float*)(ws + OFF_MST);
        B.RLOC = (float*)(ws + OFF_RLOC); B.Wl = nullptr;
        unsigned long long* ssqa = (unsigned long long*)(ws + OFF_SSQA); unsigned long long* ssqb = (unsigned long long*)(ws + OFF_SSQB);
        if (ph == 0) { convert_phase(p, lds); continue; }
        if (ph == NPHASE - 1) { final_phase(B.H, p.g_final, p.out); continue; }
        const int l = (ph - 1) / NSUB, sub = (ph - 1) % NSUB;
        unsigned char* Wl = ws + OFF_W + (size_t)l * SZ_WL;
        pg8::StaticOrder so;
        switch (sub) {
        case 0: { so.init(S_, NPROJP - 512, G, bx, 6, 2); pg8::Gemm g{B.H, (const bf16_t*)(Wl + WO_IN), S_, NPROJP, DM}; pg8::EpiBf16<0> e{B.PROJ, NPROJP, ssqa}; pg8::gemm_phase(lds, g, so, e); } break;
        case 1: prep_phase(p, B, l); break;
        case 2: {
            if (bx < 192) { so.init(S_, 1536, 192, bx); pg8::Gemm g{B.CQN, (const bf16_t*)(Wl + WO_Q), S_, 1536, 512}; pg8::EpiQup e{(unsigned char*)B.Q, B.RC, B.RS}; pg8::gemm_phase(lds, g, so, e); }
            else { so.init(S_, 512, 64, bx - 192, 0, 6); pg8::Gemm g{B.H, (const bf16_t*)(Wl + WO_IN), S_, NPROJP, DM}; pg8::EpiBf16<0> e{B.PROJ, NPROJP, ssqa}; pg8::gemm_phase(lds, g, so, e); }
            { so.init(S_, 2048, G, bx); pg8::Gemm g{B.CKVN, (const bf16_t*)(Wl + WO_KV), S_, 2048, 256}; pg8::EpiKVup e{(unsigned char*)B.K, B.V}; pg8::gemm_phase(lds, g, so, e); }
            if (bx < 192) for (int it = bx; it < 1024; it += 192) { if (it < 512) mlstm_local(B, it, lds); else ret_local(B, it - 512, lds); }
        } break;
        case 3: { scan_phase(B);
            for (int i = bx * 512 + ltid(); i < S_; i += G * 512) { ssqa[i] = 0ull; ssqb[i] = 0ull; } } break;
        case 4: {
            for (int it = bx; it < 256; it += G) mlstm_out(B, p.g_ml_out + l * 512, it, lds);
            for (int it = bx; it < 256; it += G) ret_out(B, p.g_ret_out + l * 512, it, lds);
            for (int it = bx; it < 256; it += G) { const int h = it & 7, qb = it >> 3;
                att::attn_body((const unsigned char*)B.Q + ((size_t)h * S_ + qb * 256) * 192, (const unsigned char*)B.K + (size_t)h * S_ * 192, B.V + (size_t)h * S_ * 128,
                               B.Y + (size_t)(qb * 256) * DM + 1024 + h * 128, S_, (char*)lds_raw); }
        } break;
        case 5: { so.init(S_, DM, G, bx); pg8::Gemm g{B.Y, (const bf16_t*)(Wl + WO_OUT), S_, DM, DM};
 pg8::EpiResid e{B.H, ssqb, DM}; pg8::gemm_phase(lds, g, so, e); } break;
        case 6: { so.init(S_, DFF, G, bx); pg8::Gemm g{B.H, (const bf16_t*)(Wl + WO_1), S_, DFF, DM}; pg8::EpiBf16<1> e{B.ACT, DFF, ssqb}; pg8::gemm_phase(lds, g, so, e); } break;
        case 7: { so.init(S_, DM, G, bx); pg8::Gemm g{B.ACT, (const bf16_t*)(Wl + WO_2), S_, DM, DFF};
            pg8::EpiResid e{B.H, ssqa, DM}; pg8::gemm_phase(lds, g, so, e); } break;
        }
    }
}

#ifndef MK_MULTI
#define MK_MULTI 0
#endif
extern "C" void kernel_launch(void* const* d_in, const int* in_sizes, int n_in, void* d_out, int out_size, void* d_ws, size_t ws_size, hipStream_t stream) {
    static int grid = 0;
    if (grid == 0) {
        if (n_in != 17 || out_size != S_ * DM || ws_size < WS_END) { fprintf(stderr, "kernel_launch: unexpected shapes: n_in %d out %d ws %zu (need %zu)\n", n_in, out_size, ws_size, (size_t)WS_END); grid = -1; return; }
        int dev = 0, cus = 0, per_cu = 0;
        hipGetDevice(&dev); hipDeviceGetAttribute(&cus, hipDeviceAttributeMultiprocessorCount, dev);
        if (hipFuncSetAttribute((const void*)mega_fwd, hipFuncAttributeMaxDynamicSharedMemorySize, LDS_BYTES) != hipSuccess) { fprintf(stderr, "kernel_launch: hipFuncSetAttribute failed\n"); grid = -1; return; }
        if (hipOccupancyMaxActiveBlocksPerMultiprocessor(&per_cu, (const void*)mega_fwd, 512, LDS_BYTES) != hipSuccess || per_cu < 1) { fprintf(stderr, "kernel_launch: occupancy query says %d\n", per_cu); per_cu = 1; }
        (void)hipGetLastError();
        grid = cus * 1;
        fprintf(stderr, "kernel_launch: cus %d per_cu %d grid %d\n", cus, per_cu, grid);
    }
    if (grid < 0) return;
    Params p{};
    p.x = (const float*)d_in[0]; p.pos = (const int*)d_in[1]; p.g_mix = (const float*)d_in[2]; p.w_in = (const float*)d_in[3]; p.b_gates = (const float*)d_in[4];
    p.w_conv = (const float*)d_in[5]; p.g_ml_out = (const float*)d_in[6]; p.g_ret_out = (const float*)d_in[7]; p.g_q_norm = (const float*)d_in[8]; p.w_q_up = (const float*)d_in[9];
    p.g_kv_norm = (const float*)d_in[10]; p.w_kv_up = (const float*)d_in[11]; p.w_out = (const float*)d_in[12]; p.g_ffn = (const float*)d_in[13]; p.w_ff1 = (const float*)d_in[14];
    p.w_ff2 = (const float*)d_in[15]; p.g_final = (const float*)d_in[16]; p.out = (float*)d_out; p.ws = (unsigned char*)d_ws;
#if MK_MULTI
    for (int ph = 0; ph < NPHASE; ++ph) { p.ph_lo = ph; p.ph_hi = ph + 1; hipLaunchKernelGGL(mega_fwd, dim3(grid), dim3(512), LDS_BYTES, stream, p); }
#else
    p.ph_lo = 0; p.ph_hi = NPHASE;
    void* args[] = {&p};
    hipError_t e = hipLaunchCooperativeKernel((const void*)mega_fwd, dim3(grid), dim3(512), args, LDS_BYTES, stream);
    if (e != hipSuccess) fprintf(stderr, "kernel_launch: cooperative launch failed: %s (grid %d)\n", hipGetErrorString(e), grid);
#endif
}
```

```cpp
#include <hip/hip_runtime.h>
#include <hip/hip_cooperative_groups.h>
#include <cstdio>
#include <cstdint>
namespace cg = cooperative_groups;

typedef unsigned short bf16_t;
typedef short bf16x8 __attribute__((ext_vector_type(8)));
typedef short s16x4 __attribute__((ext_vector_type(4)));
typedef float f32x4 __attribute__((ext_vector_type(4)));
typedef float f32x16 __attribute__((ext_vector_type(16)));
typedef unsigned u32x4 __attribute__((ext_vector_type(4)));
typedef unsigned u32x2 __attribute__((ext_vector_type(2)));
typedef int i32x8 __attribute__((ext_vector_type(8)));
#define LAS __attribute__((address_space(3)))

constexpr int S_ = 8192, DM = 2048, NPROJ = 4432, NPROJP = 4608, DFF = 8192, NLAYER = 4;
constexpr float EPS_ = 1e-6f;
constexpr int LDS_BYTES = 147456;

constexpr int PC_MLQ = 0, PC_MLK = 512, PC_MLV = 1024, PC_MLO = 1536, PC_GATE = 2048, PC_RQ = 2064, PC_RK = 2320, PC_RV = 2576, PC_RG = 3088,
              PC_CQ = 3600, PC_CKV = 4112, PC_KR = 4368;

constexpr size_t SZ_WIN = (size_t)NPROJP * DM * 2, SZ_WQ = (size_t)1536 * 512 * 2, SZ_WKV = (size_t)2048 * 256 * 2, SZ_WOUT = (size_t)DM * DM * 2,
                 SZ_W1 = (size_t)DFF * DM * 2, SZ_W2 = (size_t)DM * DFF * 2;
constexpr size_t WO_IN = 0, WO_Q = WO_IN + SZ_WIN, WO_KV = WO_Q + SZ_WQ, WO_OUT = WO_KV + SZ_WKV, WO_1 = WO_OUT + SZ_WOUT, WO_2 = WO_1 + SZ_W1, SZ_WL = WO_2 + SZ_W2;
constexpr size_t OFF_W = 0;
constexpr size_t OFF_X = OFF_W + NLAYER * SZ_WL;
constexpr size_t OFF_H = OFF_X + (size_t)S_ * DM * 4;
constexpr size_t OFF_Y = OFF_H + (size_t)S_ * DM * 2;
constexpr size_t OFF_ROPE = OFF_Y + (size_t)S_ * DM * 2;
constexpr size_t OFF_G = OFF_ROPE + (size_t)S_ * 32 * 4 * 2;
constexpr size_t OFF_QKML = OFF_G + (size_t)S_ * 16 * 4;
constexpr size_t OFF_RQK = OFF_QKML + (size_t)S_ * 1024 * 2;
constexpr size_t OFF_CQN = OFF_RQK + (size_t)S_ * 512 * 2;
constexpr size_t OFF_CKVN = OFF_CQN + (size_t)S_ * 512 * 2;
constexpr size_t OFF_CLOC = OFF_CKVN + (size_t)S_ * 256 * 2;
constexpr size_t OFF_CST = OFF_CLOC + (size_t)512 * 16384 * 4;
constexpr size_t OFF_NLOC = OFF_CST + (size_t)512 * 16384 * 2;
constexpr size_t OFF_NST = OFF_NLOC + (size_t)512 * 128 * 4;
constexpr size_t OFF_MLOC = OFF_NST + (size_t)512 * 128 * 4;
constexpr size_t OFF_BLAST = OFF_MLOC + 2048;
constexpr size_t OFF_MST = OFF_BLAST + 2048;
constexpr size_t OFF_RLOC = OFF_MST + 2048;
constexpr size_t OFF_RST = OFF_RLOC + (size_t)512 * 8192 * 4;
constexpr size_t OFF_BAR = OFF_RST + (size_t)512 * 8192 * 2;
constexpr size_t OFF_SSQA = OFF_BAR + 16384;
constexpr size_t OFF_SSQB = OFF_SSQA + (size_t)S_ * 8;
constexpr size_t OFF_MIX = OFF_SSQB + (size_t)S_ * 8;
constexpr size_t OFF_PROJ = OFF_MIX;
constexpr size_t OFF_Q = OFF_PROJ + (size_t)S_ * NPROJP * 2;
constexpr size_t OFF_K = OFF_Q + (size_t)8 * S_ * 192 * 2;
constexpr size_t OFF_V = OFF_K + (size_t)8 * S_ * 192 * 2;
constexpr size_t OFF_END0 = OFF_V + (size_t)8 * S_ * 128 * 2;
constexpr size_t OFF_ACT = OFF_MIX;
constexpr size_t OFF_END1 = OFF_ACT + (size_t)S_ * DFF * 2;
constexpr size_t WS_END = OFF_END0 > OFF_END1 ? OFF_END0 : OFF_END1;

struct Params {
    const float* x; const int* pos; const float* g_mix; const float* w_in; const float* b_gates; const float* w_conv;
    const float* g_ml_out; const float* g_ret_out; const float* g_q_norm; const float* w_q_up; const float* g_kv_norm; const float* w_kv_up;
    const float* w_out; const float* g_ffn; const float* w_ff1; const float* w_ff2; const float* g_final;
    float* out; unsigned char* ws;
    int ph_lo, ph_hi;
};

__device__ __forceinline__ unsigned cvt_pk_bf16(float lo, float hi) { unsigned r; asm volatile("v_cvt_pk_bf16_f32 %0, %1, %2" : "=v"(r) : "v"(lo), "v"(hi)); return r; }
__device__ __forceinline__ int ltid() { int t = threadIdx.x; asm volatile("" : "+v"(t)); return t; }
__device__ __forceinline__ int lbid() { int t = blockIdx.x; asm volatile("" : "+s"(t)); return t; }
__device__ __forceinline__ float bf2f(bf16_t b) { return __uint_as_float(((unsigned)b) << 16); }
__device__ __forceinline__ float bflo(unsigned w) { return __uint_as_float(w << 16); }
__device__ __forceinline__ float bfhi(unsigned w) { return __uint_as_float(w & 0xffff0000u); }
__device__ __forceinline__ bf16_t f2bf(float f) { return (bf16_t)(cvt_pk_bf16(f, 0.f) & 0xffffu); }
__device__ __forceinline__ float wave_sum(float v) { for (int o = 32; o > 0; o >>= 1) v += __shfl_xor(v, o); return v; }
__device__ __forceinline__ float wave_max(float v) { for (int o = 32; o > 0; o >>= 1) v = fmaxf(v, __shfl_xor(v, o)); return v; }
__device__ __forceinline__ void unpack8(u32x4 w, float* f) { f[0] = bflo(w.x); f[1] = bfhi(w.x); f[2] = bflo(w.y); f[3] = bfhi(w.y); f[4] = bflo(w.z); f[5] = bfhi(w.z); f[6] = bflo(w.w); f[7] = bfhi(w.w); }
__device__ __forceinline__ u32x2 pack8_fp8(const float* f) { int a = 0, b = 0;
    a = __builtin_amdgcn_cvt_pk_fp8_f32(f[0], f[1], a, false); a = __builtin_amdgcn_cvt_pk_fp8_f32(f[2], f[3], a, true);
    b = __builtin_amdgcn_cvt_pk_fp8_f32(f[4], f[5], b, false); b = __builtin_amdgcn_cvt_pk_fp8_f32(f[6], f[7], b, true);
    u32x2 w; w.x = (unsigned)a; w.y = (unsigned)b; return w; }
__device__ __forceinline__ u32x4 pack8(const float* f) { u32x4 w; w.x = cvt_pk_bf16(f[0], f[1]); w.y = cvt_pk_bf16(f[2], f[3]); w.z = cvt_pk_bf16(f[4], f[5]); w.w = cvt_pk_bf16(f[6], f[7]); return w; }


#define XB_TMO      128
#define XB_XCNT(j)  (256  + 64 * (j))
#define XB_XSUB(j)  (1280 + 64 * (j))
#define XB_XGEN(j)  (2304 + 64 * (j))
#define XB_TOP      3328
#define XB_TOPGEN   3392
#define XCD_BAR_WORDS 3456
#define XB_SPIN_CAP (1u << 18)

__device__ __forceinline__ unsigned xb_ld(unsigned* p)              { return __hip_atomic_load(p, __ATOMIC_RELAXED, __HIP_MEMORY_SCOPE_AGENT); }
__device__ __forceinline__ unsigned xb_add(unsigned* p, unsigned v) { return __hip_atomic_fetch_add(p, v, __ATOMIC_RELAXED, __HIP_MEMORY_SCOPE_AGENT); }
__device__ __forceinline__ unsigned xb_xcc_id() { return (unsigned)__builtin_amdgcn_s_getreg((3 << 11) | 20) & 0xFu; }
#define XB_SPIN(cond, bar) do { unsigned _sp = 0; while (cond) { __builtin_amdgcn_s_sleep(1); \
    if ((++_sp & 255u) == 0u) { if (xb_ld(&(bar)[XB_TMO])) break; if (_sp > XB_SPIN_CAP) { atomicAdd(&(bar)[XB_TMO], 1u); break; } } } } while (0)

struct XcdBarrier {
    unsigned* bar; unsigned x;
    volatile LAS unsigned* st;
};

__device__ __forceinline__ XcdBarrier xcd_barrier_post(unsigned* bar, volatile LAS unsigned* st) {
    XcdBarrier b; b.bar = bar; b.x = xb_xcc_id(); b.st = st;
    if (threadIdx.x == 0) (void)xb_add(&bar[XB_XCNT(b.x)], 1u);
    return b;
}
__device__ __forceinline__ void xcd_barrier_complete(unsigned* bar, unsigned x, unsigned& nloc, unsigned& nx) {
    const unsigned G = gridDim.x * gridDim.y * gridDim.z;
    unsigned sum, cnt, mine, sp = 0u;
    for (;;) {
        sum = 0u; cnt = 0u; mine = 0u;
#pragma unroll
        for (unsigned j = 0; j < 16; ++j) { const unsigned c = xb_ld(&bar[XB_XCNT(j)]); sum += c; cnt += (c > 0u) ? 1u : 0u; mine = (j == x) ? c : mine; }
        if (sum == G) break;
        __builtin_amdgcn_s_sleep(1);
        if ((++sp & 255u) == 0u) { if (xb_ld(&bar[XB_TMO])) break; if (sp > XB_SPIN_CAP) { atomicAdd(&bar[XB_TMO], 1u); break; } }
    }
    nloc = mine > 0u ? mine : 1u; nx = cnt > 0u ? cnt : 1u;
}

__device__ __forceinline__ void xcd_barrier(const XcdBarrier& b) {
    asm volatile("s_waitcnt vmcnt(0)" ::: "memory");
    __syncthreads();
    if (threadIdx.x == 0) {
        unsigned* bar = b.bar;
        __builtin_amdgcn_s_waitcnt(0);
        unsigned nloc = b.st[0], nx = b.st[1];
        if (nloc == 0u) { xcd_barrier_complete(bar, b.x, nloc, nx); b.st[0] = nloc; b.st[1] = nx; }
        const unsigned old = xb_add(&bar[XB_XSUB(b.x)], 1u);
        const unsigned gen = old / nloc;
        if (old + 1u == (gen + 1u) * nloc) {
            __builtin_amdgcn_fence(__ATOMIC_RELEASE, "agent");
            asm volatile("s_waitcnt vmcnt(0)" ::: "memory");
            const unsigned og = xb_add(&bar[XB_TOP], 1u);
            const unsigned tg = og / nx;
            if (og + 1u == (tg + 1u) * nx) xb_add(&bar[XB_TOPGEN], 1u);
            else XB_SPIN(xb_ld(&bar[XB_TOPGEN]) == tg, bar);
            __builtin_amdgcn_fence(__ATOMIC_ACQUIRE, "agent");
            xb_add(&bar[XB_XGEN(b.x)], 1u);
            asm volatile("s_waitcnt vmcnt(0)" ::: "memory");
        } else {
            XB_SPIN(xb_ld(&bar[XB_XGEN(b.x)]) == gen, bar);
            __builtin_amdgcn_fence(__ATOMIC_ACQUIRE, "agent");
            asm volatile("s_waitcnt vmcnt(0)" ::: "memory");
        }
    }
    __syncthreads();
}

namespace pg8 {
constexpr int BM = 256, BK = 64, HALF = 128, HTB = HALF * BK * 2, STAGE_BYTES = 8 * HTB, NXCD = 8, WGM = 8;
__host__ __device__ __forceinline__ int lds_byte(int r, int c) { const int st = (r >> 4) * 2 + (c >> 5), rr = r & 15, cc = c & 31, ob = rr * 64 + cc * 2; return st * 1024 + (ob ^ (((ob >> 9) & 1) << 5)); }
__host__ __device__ __forceinline__ void stage_rc(int b, int& R, int& C) { const int st = b / 1024, sb = b % 1024, swz = sb ^ (((sb >> 9) & 1) << 5); R = (st >> 1) * 16 + swz / 64; C = (st & 1) * 32 + (swz % 64) / 2; }
__host__ __device__ __forceinline__ int perm32(int rho) { const int n = rho >> 4, i = rho & 15; return 8 * (i >> 2) + 4 * n + (i & 3); }
struct Unit { int pm, pn; };
struct Gemm { const bf16_t* A; const bf16_t* Bt; int M, N, K; };
struct StaticOrder {
    int nM, nN, nwg, G, c, skip_lo, skip_n, ioff = 0, icnt = 1 << 20;
    __device__ void init(int M, int N, int G_, int c_, int slo = 1 << 20, int sn = 0) { nM = M / BM; nN = N / BM; nwg = nM * nN; G = G_; c = c_; skip_lo = slo; skip_n = sn; }
    __device__ bool next(int i, Unit& u) const {
        if (i >= icnt) return false; const long L = (long)(i + ioff) * G + c; if (L >= nwg) return false;
        int wgid = (int)L; { const int q = nwg / NXCD, r = nwg % NXCD, xcd = wgid % NXCD, off = wgid / NXCD; wgid = (xcd < r ? xcd * (q + 1) : r * (q + 1) + (xcd - r) * q) + off; }
        const int nig = WGM * nN, gid = wgid / nig, fm = gid * WGM, gsz = (nM - fm) < WGM ? (nM - fm) : WGM;
        u.pm = fm + ((wgid % nig) % gsz); u.pn = (wgid % nig) / gsz; if (u.pn >= skip_lo) u.pn += skip_n; return true;
    }
};
template <class Epi>
__device__ __forceinline__ void gemm_phase(LAS unsigned char* lds, const Gemm g, const StaticOrder& S, const Epi& E) {
    const int tid = ltid(), wid = __builtin_amdgcn_readfirstlane(tid >> 6), lane = tid & 63, wr = wid >> 2, wc = wid & 3, fr = lane & 15, fq = lane >> 4;
    int K = g.K; asm volatile("" : "+s"(K)); const int nt = K / BK;
    unsigned voffA[2], voffB[2];
#pragma unroll
    for (int i = 0; i < 2; ++i) { int R, C; stage_rc(tid * 16 + i * 8192, R, C); const int Rb = Epi::PERM ? ((R & ~31) + perm32(R & 31)) : R;
        voffA[i] = (unsigned)(R * K + C) * 2u; voffB[i] = (unsigned)(Rb * K + C) * 2u; }
    const size_t kstep = (size_t)(BK * 2);
    const size_t hstep = (size_t)HALF * K * 2;
    const size_t tstep = 2 * hstep;
    const unsigned ldsw = (unsigned)wid * 1024u;
    const int aoff = lds_byte(wr * 64 + fr, fq * 8), boff = lds_byte(wc * 32 + fr, fq * 8);
#define PG8_SA(b, h) (((b) * 2 + (h)) * HTB)
#define PG8_SB(b, h) ((4 + (b) * 2 + (h)) * HTB)
#define PG8_STAGE(bufoff, gbase, voff) do { _Pragma("unroll") for (int _i = 0; _i < 2; ++_i) \
        __builtin_amdgcn_global_load_lds((const unsigned*)((const char*)(gbase) + (voff)[_i]), (LAS unsigned*)(lds + (bufoff) + ldsw + _i * 8192), 16, 0, 0); } while (0)
#define PG8_LDA(dst, b, h) do { _Pragma("unroll") for (int m = 0; m < 4; ++m) _Pragma("unroll") for (int k = 0; k < 2; ++k) dst[m][k] = *(const LAS bf16x8*)(lds + PG8_SA(b, h) + aoff + m * 2048 + k * 1024); } while (0)
#define PG8_LDB(dst, b, h) do { _Pragma("unroll") for (int n = 0; n < 2; ++n) _Pragma("unroll") for (int k = 0; k < 2; ++k) dst[n][k] = *(const LAS bf16x8*)(lds + PG8_SB(b, h) + boff + n * 2048 + k * 1024); } while (0)
#define PG8_MMA(ai, bj, At, Bt) do { __builtin_amdgcn_s_setprio(1); _Pragma("unroll") for (int m = 0; m < 4; ++m) _Pragma("unroll") for (int n = 0; n < 2; ++n) _Pragma("unroll") for (int k = 0; k < 2; ++k) \
        acc[ai][bj][m][n] = __builtin_amdgcn_mfma_f32_16x16x32_bf16(Bt[n][k], At[m][k], acc[ai][bj][m][n], 0, 0, 0); __builtin_amdgcn_s_setprio(0); } while (0)
#define PG8_WAIT_V(n) asm volatile("s_waitcnt vmcnt(" #n ")" ::: "memory")
#define PG8_WAIT_L(n) asm volatile("s_waitcnt lgkmcnt(" #n ")" ::: "memory")
#define PG8_BAR __builtin_amdgcn_s_barrier()
#define PG8_SCHED __builtin_amdgcn_sched_barrier(0)
    Unit cur, nxt; int ui = 0;
    if (!S.next(0, cur)) return;
    f32x4 acc[2][2][4][2];
#pragma unroll
    for (int a = 0; a < 2; ++a)
#pragma unroll
        for (int b = 0; b < 2; ++b)
#pragma unroll
            for (int m = 0; m < 4; ++m)
#pragma unroll
                for (int n = 0; n < 2; ++n) acc[a][b][m][n] = (f32x4){0.f, 0.f, 0.f, 0.f};
    bf16x8 At[4][2], B0[2][2], B1[2][2];
    const char* cA = (const char*)g.A + (size_t)cur.pm * tstep; const char* cB = (const char*)g.Bt + (size_t)cur.pn * tstep;
    if (Epi::PRE) E.stash(E.prefetch(cur.pm, tid), lds, 0, tid);
    PG8_STAGE(PG8_SB(0, 0), cB, voffB); PG8_STAGE(PG8_SA(0, 0), cA, voffA); PG8_STAGE(PG8_SB(0, 1), cB + hstep, voffB); PG8_STAGE(PG8_SA(0, 1), cA + hstep, voffA);
    if (wr == 1) PG8_BAR;
    PG8_WAIT_V(4); PG8_BAR;
    PG8_STAGE(PG8_SB(1, 0), cB + kstep, voffB); PG8_STAGE(PG8_SA(1, 0), cA + kstep, voffA); PG8_STAGE(PG8_SB(1, 1), cB + hstep + kstep, voffB);
    PG8_WAIT_V(6); PG8_BAR;
    for (;;) {
        const bool has_next = S.next(ui + 1, nxt);
        const char* nA = has_next ? (const char*)g.A + (size_t)nxt.pm * tstep : cA; const char* nB = has_next ? (const char*)g.Bt + (size_t)nxt.pn * tstep : cB;
        for (int t = 0; t < nt; t += 2) {
            const bool last = (t == nt - 2);
            const char* a1 = cA + (size_t)(t + 1) * kstep;
            const char* a2 = last ? nA : cA + (size_t)(t + 2) * kstep; const char* b2 = last ? nB : cB + (size_t)(t + 2) * kstep;
            const char* a3 = a2 + kstep; const char* b3 = b2 + kstep;
            PG8_LDB(B0, 0, 0); PG8_SCHED; PG8_LDA(At, 0, 0); PG8_STAGE(PG8_SA(1, 1), a1 + hstep, voffA);
            PG8_WAIT_L(8); PG8_BAR; PG8_WAIT_L(0); PG8_MMA(0, 0, At, B0); PG8_BAR; PG8_SCHED;
            PG8_LDB(B1, 0, 1); PG8_STAGE(PG8_SB(0, 0), b2, voffB);
            PG8_BAR; PG8_WAIT_L(0); PG8_MMA(0, 1, At, B1); PG8_BAR;
            PG8_LDA(At, 0, 1); PG8_STAGE(PG8_SA(0, 0), a2, voffA);
            PG8_BAR; PG8_WAIT_L(0); PG8_MMA(1, 0, At, B0); PG8_BAR; PG8_SCHED;
            PG8_STAGE(PG8_SB(0, 1), b2 + hstep, voffB);
            PG8_WAIT_V(6); PG8_BAR; PG8_MMA(1, 1, At, B1); PG8_BAR;
            PG8_LDB(B0, 1, 0); PG8_SCHED; PG8_LDA(At, 1, 0); PG8_STAGE(PG8_SA(0, 1), a2 + hstep, voffA);
            PG8_WAIT_L(8); PG8_BAR; PG8_WAIT_L(0); PG8_MMA(0, 0, At, B0); PG8_BAR; PG8_SCHED;
            PG8_LDB(B1, 1, 1); PG8_STAGE(PG8_SB(1, 0), b3, voffB);
            PG8_BAR; PG8_WAIT_L(0); PG8_MMA(0, 1, At, B1); PG8_BAR;
            PG8_LDA(At, 1, 1); PG8_STAGE(PG8_SA(1, 0), a3, voffA);
            PG8_BAR; PG8_WAIT_L(0); PG8_MMA(1, 0, At, B0); PG8_BAR; PG8_SCHED;
            PG8_STAGE(PG8_SB(1, 1), b3 + hstep, voffB);
            PG8_WAIT_V(6); PG8_BAR; PG8_MMA(1, 1, At, B1); PG8_BAR;
        }
        E(acc, cur, wr, wc, fr, fq, lds, ui & 1, has_next ? nxt.pm : -1, tid);
        if (!has_next) break;
#pragma unroll
        for (int a = 0; a < 2; ++a)
#pragma unroll
            for (int b = 0; b < 2; ++b)
#pragma unroll
                for (int m = 0; m < 4; ++m)
#pragma unroll
                    for (int n = 0; n < 2; ++n) acc[a][b][m][n] = (f32x4){0.f, 0.f, 0.f, 0.f};
        cur = nxt; cA = nA; cB = nB; ++ui;
    }
    PG8_WAIT_V(0);
    if (wr == 0) PG8_BAR;
    PG8_BAR;
#undef PG8_SA
#undef PG8_SB
#undef PG8_STAGE
#undef PG8_LDA
#undef PG8_LDB
#undef PG8_MMA
#undef PG8_WAIT_V
#undef PG8_WAIT_L
#undef PG8_BAR
#undef PG8_SCHED
}

template <int ACT> struct EpiBf16 {
    static constexpr bool PERM = true, PRE = true;
    bf16_t* O; int ldc; const unsigned long long* ssq;
    __device__ __forceinline__ unsigned long long prefetch(int pm, int tid) const { return tid < 256 ? ssq[pm * BM + tid] : 0ull; }
    __device__ __forceinline__ void stash(unsigned long long v, LAS unsigned char* lds, int par, int tid) const { if (tid < 256) *(LAS float*)(lds + 131072 + par * 1024 + tid * 4) = rsqrtf((float)v * (1.f / (1048576.f * DM)) + EPS_); }
    __device__ __forceinline__ void operator()(const f32x4 (&acc)[2][2][4][2], const Unit& u, int wr, int wc, int fr, int fq, LAS unsigned char* lds, int par, int npm, int tid) const {
        const int row0 = u.pm * BM + wr * 64 + fr, col0 = u.pn * BM + wc * 32 + 8 * fq;
        unsigned long long nx = 0ull; if (npm >= 0) nx = prefetch(npm, tid);
#pragma unroll
        for (int ai = 0; ai < 2; ++ai)
#pragma unroll
            for (int m = 0; m < 4; ++m) { const int row = row0 + ai * HALF + m * 16; bf16_t* rowp = O + (size_t)row * ldc + col0;
                const float rstd = *(const LAS float*)(lds + 131072 + par * 1024 + (wr * 64 + fr + ai * HALF + m * 16) * 4);
#pragma unroll
                for (int bj = 0; bj < 2; ++bj) { f32x4 v0 = acc[ai][bj][m][0] * rstd, v1 = acc[ai][bj][m][1] * rstd;
                    if (ACT == 1) {
#pragma unroll
                        for (int j = 0; j < 4; ++j) { const float a = fmaxf(v0[j], 0.f), b = fmaxf(v1[j], 0.f); v0[j] = a * a; v1[j] = b * b; } }
                    u32x4 w; w.x = cvt_pk_bf16(v0[0], v0[1]); w.y = cvt_pk_bf16(v0[2], v0[3]); w.z = cvt_pk_bf16(v1[0], v1[1]); w.w = cvt_pk_bf16(v1[2], v1[3]);
                    *(u32x4*)(rowp + bj * HALF) = w; } }
        if (npm >= 0) stash(nx, lds, par ^ 1, tid);
    }
};
struct EpiResid {
    static constexpr bool PERM = true, PRE = false;
    __device__ __forceinline__ unsigned long long prefetch(int, int) const { return 0ull; }
    __device__ __forceinline__ void stash(unsigned long long, LAS unsigned char*, int, int) const {}
    bf16_t* Hb; unsigned long long* ssq; int ldc;
    __device__ __forceinline__ void operator()(const f32x4 (&acc)[2][2][4][2], const Unit& u, int wr, int wc, int fr, int fq, LAS unsigned char* lds, int par, int npm, int tid) const {
        const int row0 = u.pm * BM + wr * 64 + fr, col0 = u.pn * BM + wc * 32 + 8 * fq;
        u32x4 old[2][4][2];
#pragma unroll
        for (int ai = 0; ai < 2; ++ai)
#pragma unroll
            for (int m = 0; m < 4; ++m)
#pragma unroll
                for (int bj = 0; bj < 2; ++bj) old[ai][m][bj] = *(const u32x4*)(Hb + (size_t)(row0 + ai * HALF + m * 16) * ldc + col0 + bj * HALF);
#pragma unroll
        for (int ai = 0; ai < 2; ++ai)
#pragma unroll
            for (int m = 0; m < 4; ++m) { const int row = row0 + ai * HALF + m * 16; bf16_t* hp = Hb + (size_t)row * ldc + col0;
                float part = 0.f;
#pragma unroll
                for (int bj = 0; bj < 2; ++bj) { float o[8]; unpack8(old[ai][m][bj], o);
                    const f32x4 a0 = acc[ai][bj][m][0], a1 = acc[ai][bj][m][1];
                    float v[8] = {o[0] + a0[0], o[1] + a0[1], o[2] + a0[2], o[3] + a0[3], o[4] + a1[0], o[5] + a1[1], o[6] + a1[2], o[7] + a1[3]};
#pragma unroll
                    for (int k = 0; k < 8; ++k) part += v[k] * v[k];
                    *(u32x4*)(hp + bj * HALF) = pack8(v); }
                part += __shfl_xor(part, 16); part += __shfl_xor(part, 32);
                if (fq == 0) atomicAdd(ssq + row, (unsigned long long)(part * 1048576.f)); }
    }
};
struct EpiQup {
    static constexpr bool PERM = true, PRE = false;
    __device__ __forceinline__ unsigned long long prefetch(int, int) const { return 0ull; }
    __device__ __forceinline__ void stash(unsigned long long, LAS unsigned char*, int, int) const {}
    unsigned char* Q; const float* rc; const float* rs;
    __device__ __forceinline__ void operator()(const f32x4 (&acc)[2][2][4][2], const Unit& u, int wr, int wc, int fr, int fq, LAS unsigned char* lds, int par, int npm, int tid) const {
        const int row0 = u.pm * BM + wr * 64 + fr;
        if (u.pn < 4) {
            unsigned char* d0 = Q + ((size_t)(u.pn * 2) * S_ + row0) * 192 + wc * 32 + 8 * fq;
#pragma unroll
            for (int ai = 0; ai < 2; ++ai)
#pragma unroll
                for (int m = 0; m < 4; ++m)
#pragma unroll
                    for (int bj = 0; bj < 2; ++bj) { const f32x4 v0 = acc[ai][bj][m][0], v1 = acc[ai][bj][m][1];
                        const float f[8] = {v0[0], v0[1], v0[2], v0[3], v1[0], v1[1], v1[2], v1[3]};
                        *(u32x2*)(d0 + (size_t)(ai * HALF + m * 16) * 192 + (size_t)bj * S_ * 192) = pack8_fp8(f); }
        } else {
            const int jj0 = (wc & 1) * 32 + 8 * fq, j0 = jj0 >> 1;
            unsigned char* d0 = Q + ((size_t)((u.pn - 4) * 4 + (wc >> 1)) * S_ + row0) * 192 + 128 + jj0;
            const float* c0 = rc + (size_t)row0 * 32 + j0; const float* s0 = rs + (size_t)row0 * 32 + j0;
            f32x4 cv[2][4], sv[2][4];
#pragma unroll
            for (int ai = 0; ai < 2; ++ai)
#pragma unroll
                for (int m = 0; m < 4; ++m) { const int ro = ai * HALF + m * 16; cv[ai][m] = *(const f32x4*)(c0 + ro * 32); sv[ai][m] = *(const f32x4*)(s0 + ro * 32); }
#pragma unroll
            for (int ai = 0; ai < 2; ++ai)
#pragma unroll
                for (int m = 0; m < 4; ++m) { const int ro = ai * HALF + m * 16; const f32x4 c = cv[ai][m], s = sv[ai][m];
#pragma unroll
                    for (int bj = 0; bj < 2; ++bj) { const f32x4 v0 = acc[ai][bj][m][0], v1 = acc[ai][bj][m][1];
                        const float f[8] = {v0[0] * c[0] - v0[1] * s[0], v0[1] * c[0] + v0[0] * s[0], v0[2] * c[1] - v0[3] * s[1], v0[3] * c[1] + v0[2] * s[1],
                                            v1[0] * c[2] - v1[1] * s[2], v1[1] * c[2] + v1[0] * s[2], v1[2] * c[3] - v1[3] * s[3], v1[3] * c[3] + v1[2] * s[3]};
                        *(u32x2*)(d0 + (size_t)ro * 192 + (size_t)bj * 2 * S_ * 192) = pack8_fp8(f); } }
        }
    }
};
struct EpiKnope {
    static constexpr bool PERM = true, PRE = false;
    __device__ __forceinline__ unsigned long long prefetch(int, int) const { return 0ull; }
    __device__ __forceinline__ void stash(unsigned long long, LAS unsigned char*, int, int) const {}
    unsigned char* Kb;
    __device__ __forceinline__ void operator()(const f32x4 (&acc)[2][2][4][2], const Unit& u, int wr, int wc, int fr, int fq, LAS unsigned char* lds, int par, int npm, int tid) const {
        const int row0 = u.pm * BM + wr * 64 + fr;
        unsigned char* d0 = Kb + ((size_t)(u.pn * 2) * S_ + row0) * 192 + wc * 32 + 8 * fq;
#pragma unroll
        for (int ai = 0; ai < 2; ++ai)
#pragma unroll
            for (int m = 0; m < 4; ++m)
#pragma unroll
                for (int bj = 0; bj < 2; ++bj) { const f32x4 v0 = acc[ai][bj][m][0], v1 = acc[ai][bj][m][1];
                    const float f[8] = {v0[0], v0[1], v0[2], v0[3], v1[0], v1[1], v1[2], v1[3]};
                    *(u32x2*)(d0 + (size_t)(ai * HALF + m * 16) * 192 + (size_t)bj * S_ * 192) = pack8_fp8(f); }
    }
};
struct EpiVT {
    static constexpr bool PERM = true, PRE = false;
    __device__ __forceinline__ unsigned long long prefetch(int, int) const { return 0ull; }
    __device__ __forceinline__ void stash(unsigned long long, LAS unsigned char*, int, int) const {}
    unsigned char* Vt;
    __device__ __forceinline__ void operator()(const f32x4 (&acc)[2][2][4][2], const Unit& u, int wr, int wc, int fr, int fq, LAS unsigned char* lds, int par, int npm, int tid) const {
        const int row0 = u.pm * BM + wr * 64 + fr, col0 = u.pn * BM + wc * 32 + 8 * fq;
#pragma unroll
        for (int ai = 0; ai < 2; ++ai)
#pragma unroll
            for (int m = 0; m < 4; ++m)
#pragma unroll
                for (int bj = 0; bj < 2; ++bj) { const f32x4 v0 = acc[ai][bj][m][0], v1 = acc[ai][bj][m][1];
                    const float f[8] = {v0[0], v0[1], v0[2], v0[3], v1[0], v1[1], v1[2], v1[3]};
                    *(u32x2*)(Vt + (size_t)(row0 + ai * HALF + m * 16) * S_ + col0 + bj * HALF) = pack8_fp8(f); }
    }
};
}

namespace att {
constexpr int DQ = 192, DV = 128, NW = 8, QBLK = 32, KVBLK = 64;
constexpr float SCALE = 0.07216878364870322f;
constexpr float THR = 2.f;
#ifndef ATT_SDEPTH
#define ATT_SDEPTH 1
#endif
constexpr int SDEPTH = ATT_SDEPTH;
#ifndef ATT_NQREG
#define ATT_NQREG 12
#endif
constexpr int NQREG = ATT_NQREG;
constexpr int LDQ = 192, LDKK = 192, LDVV = 128, LDO = 2048;
constexpr int SHM_V = DV * 80, SHM_K = KVBLK * 208, SHM_QR = 2 * SHM_V + 2 * SHM_K + NW * 64 * 4, SHM_ATTN = SHM_QR + NW * (12 - NQREG) * 64 * 16;
#define KSWZ(row, colB) ((row) * 208 + (colB))
#define SBAR() __builtin_amdgcn_sched_barrier(0)
__device__ __forceinline__ int crow(int r, int hi) { return (r & 3) + 8 * (r >> 2) + 4 * hi; }
__device__ __forceinline__ void partialSM(f32x16& p0, f32x16& p1, float& m_reg, float& mn, float& alpha) {
  constexpr float C = SCALE * 1.4426950408889634f;
  float pmax = p0[0]; for (int r = 1; r < 16; ++r) pmax = fmaxf(pmax, p0[r]); for (int r = 0; r < 16; ++r) pmax = fmaxf(pmax, p1[r]);
  { auto rr = __builtin_amdgcn_permlane32_swap(__float_as_uint(pmax), __float_as_uint(pmax), false, false);
    pmax = fmaxf(__uint_as_float(rr[0]), __uint_as_float(rr[1])); }
  if (__builtin_expect(__all(pmax - m_reg <= THR / SCALE), 1)) { mn = m_reg; alpha = 1.f; }
  else { mn = fmaxf(m_reg, pmax); alpha = __builtin_amdgcn_exp2f((m_reg - mn) * C); m_reg = mn; }
  float mnC = -mn * C + 5.f;
  for (int r = 0; r < 16; ++r) p0[r] = fmaf(p0[r], C, mnC); for (int r = 0; r < 16; ++r) p1[r] = fmaf(p1[r], C, mnC);
  for (int r = 0; r < 16; ++r) p0[r] = __builtin_amdgcn_exp2f(p0[r]);
}
__device__ __forceinline__ void finishSM(f32x16& p0, f32x16& p1, float alpha, float& l_reg, i32x8& pa) {
  for (int r = 0; r < 16; ++r) p1[r] = __builtin_amdgcn_exp2f(p1[r]);
  float ps = 0; for (int r = 0; r < 16; ++r) ps += p0[r]; for (int r = 0; r < 16; ++r) ps += p1[r];
  { auto rr = __builtin_amdgcn_permlane32_swap(__float_as_uint(ps), __float_as_uint(ps), false, false);
    ps = __uint_as_float(rr[0]) + __uint_as_float(rr[1]); }
  l_reg = l_reg * alpha + ps;
#pragma unroll
  for (int i = 0; i < 4; ++i) { int w0 = 0, w1 = 0;
    w0 = __builtin_amdgcn_cvt_pk_fp8_f32(p0[4 * i], p0[4 * i + 1], w0, false); w0 = __builtin_amdgcn_cvt_pk_fp8_f32(p0[4 * i + 2], p0[4 * i + 3], w0, true);
    w1 = __builtin_amdgcn_cvt_pk_fp8_f32(p1[4 * i], p1[4 * i + 1], w1, false); w1 = __builtin_amdgcn_cvt_pk_fp8_f32(p1[4 * i + 2], p1[4 * i + 3], w1, true);
    pa[i] = w0; pa[4 + i] = w1; }
}
__device__ __forceinline__ void qkt(f32x16& p0, f32x16& p1, const unsigned char* Ks, const i32x8* qr, int r32, int hi) {
  p0 = f32x16{}; p1 = f32x16{};
#pragma unroll
  for (int m = 0; m < 3; ++m) { const int cb = m * 64 + hi * 32;
    const u32x4 a0 = *reinterpret_cast<const u32x4*>(Ks + KSWZ(r32, cb)), a1 = *reinterpret_cast<const u32x4*>(Ks + KSWZ(r32, cb) + 16);
    const u32x4 c0 = *reinterpret_cast<const u32x4*>(Ks + KSWZ(32 + r32, cb)), c1 = *reinterpret_cast<const u32x4*>(Ks + KSWZ(32 + r32, cb) + 16);
    const i32x8 b0 = {(int)a0.x, (int)a0.y, (int)a0.z, (int)a0.w, (int)a1.x, (int)a1.y, (int)a1.z, (int)a1.w};
    const i32x8 b1 = {(int)c0.x, (int)c0.y, (int)c0.z, (int)c0.w, (int)c1.x, (int)c1.y, (int)c1.z, (int)c1.w};
    p0 = __builtin_amdgcn_mfma_scale_f32_32x32x64_f8f6f4(b0, qr[m], p0, 0, 0, 0, 0x7F7F7F7F, 0, 0x7F7F7F7F);
    p1 = __builtin_amdgcn_mfma_scale_f32_32x32x64_f8f6f4(b1, qr[m], p1, 0, 0, 0, 0x7F7F7F7F, 0, 0x7F7F7F7F); }
}
__device__ __forceinline__ void pv_d0(f32x16* o, const unsigned char* Vs, const i32x8& pa, int r32, int hi) {
#pragma unroll
  for (int d0 = 0; d0 < 4; ++d0) { const unsigned char* vp = Vs + (32 * d0 + r32) * 80 + hi * 32;
    const u32x4 a0 = *reinterpret_cast<const u32x4*>(vp), a1 = *reinterpret_cast<const u32x4*>(vp + 16);
    const i32x8 vb = {(int)a0.x, (int)a0.y, (int)a0.z, (int)a0.w, (int)a1.x, (int)a1.y, (int)a1.z, (int)a1.w};
    o[d0] = __builtin_amdgcn_mfma_scale_f32_32x32x64_f8f6f4(pa, vb, o[d0], 0, 0, 0, 0x7A7A7A7A, 0, 0x7F7F7F7F); }
}
__device__ __forceinline__ void attn_body(const unsigned char* __restrict__ Qb, const unsigned char* __restrict__ Kh, const unsigned char* __restrict__ Vt,
                                          bf16_t* __restrict__ Ob, int seq, char* lds) {
  const int tid = ltid(), wid = tid >> 6, lane = tid & 63, r32 = lane & 31, hi = lane >> 5;
  unsigned char* V_lds = (unsigned char*)lds; unsigned char* K_lds = (unsigned char*)(lds + 2 * SHM_V);
  float* ws = (float*)(lds + 2 * SHM_V + 2 * SHM_K) + wid * 64; float* li_l = ws; float* al_l = ws + 32;
  float m_reg = -1e30f, l_reg = 0; f32x16 o[4] = {}; i32x8 qr[3];
  const unsigned char* Qw = Qb + (long)(wid * QBLK + r32) * 192 + hi * 32;
#pragma unroll
  for (int m = 0; m < 3; ++m) { const u32x4 a0 = *reinterpret_cast<const u32x4*>(Qw + m * 64), a1 = *reinterpret_cast<const u32x4*>(Qw + m * 64 + 16);
    qr[m] = (i32x8){(int)a0.x, (int)a0.y, (int)a0.z, (int)a0.w, (int)a1.x, (int)a1.y, (int)a1.z, (int)a1.w}; }
  const unsigned char* vsrc = Vt + (size_t)(tid >> 2) * S_ + (tid & 3) * 16;
  const int vw = (tid >> 2) * 80 + ((tid & 3) >> 1) * 16 + (tid & 1) * 8;
  const int kw0 = KSWZ(tid / 12, (tid % 12) * 16), kw1 = KSWZ((tid + 512) / 12, ((tid + 512) % 12) * 16);
  const bool k2 = tid < 256;
  struct { u32x4 vs, ks0, ks1; } sr_[SDEPTH];
#define SLOAD(i, k0) do { sr_[i].vs = *(const u32x4*)(vsrc + (k0)); \
    { const unsigned char* kt_ = Kh + (size_t)(k0) * 192; sr_[i].ks0 = *(const u32x4*)(kt_ + tid * 16); if (k2) sr_[i].ks1 = *(const u32x4*)(kt_ + 8192 + tid * 16); } } while (0)
#define SWRITE(b, i) do { { unsigned char* vd_ = V_lds + (b) * SHM_V + vw; \
      *(unsigned*)(vd_) = sr_[i].vs.x; *(unsigned*)(vd_ + 32) = sr_[i].vs.y; *(unsigned*)(vd_ + 4) = sr_[i].vs.z; *(unsigned*)(vd_ + 36) = sr_[i].vs.w; } \
    { unsigned char* kd_ = K_lds + (b) * SHM_K; u32x2 lo_ = {sr_[i].ks0.x, sr_[i].ks0.y}, hi_ = {sr_[i].ks0.z, sr_[i].ks0.w}; \
      *(u32x2*)(kd_ + kw0) = lo_; *(u32x2*)(kd_ + kw0 + 8) = hi_; \
      if (k2) { u32x2 lo2_ = {sr_[i].ks1.x, sr_[i].ks1.y}, hi2_ = {sr_[i].ks1.z, sr_[i].ks1.w}; *(u32x2*)(kd_ + kw1) = lo2_; *(u32x2*)(kd_ + kw1 + 8) = hi2_; } } } while (0)
#define SWAIT() do { if constexpr (SDEPTH == 2) asm volatile("s_waitcnt vmcnt(3)" ::: "memory"); else asm volatile("s_waitcnt vmcnt(0)" ::: "memory"); } while (0)
#define RESC(a) do { if (__any((a) < 1.f)) { if (hi == 0) al_l[r32] = (a); asm volatile("s_waitcnt lgkmcnt(0)" ::: "memory"); \
    for (int d = 0; d < 4; ++d) for (int r = 0; r < 16; ++r) o[d][r] *= al_l[crow(r, hi)]; } } while (0)
  f32x16 pA0, pA1, pB0, pB1; float mnA, mnB, alA, alB; i32x8 pa; const int NT = seq / KVBLK;
  constexpr int SE = 0, SO = SDEPTH - 1;
  SLOAD(SE, 0); asm volatile("s_waitcnt vmcnt(0)" ::: "memory"); SWRITE(0, SE); __syncthreads();
  qkt(pA0, pA1, K_lds, qr, r32, hi); partialSM(pA0, pA1, m_reg, mnA, alA);
  SLOAD(SO, KVBLK); if constexpr (SDEPTH == 2) { if (2 < NT) SLOAD(SE, 2 * KVBLK); }
  SWAIT(); SWRITE(1, SO); __syncthreads();
  for (int j = 1; j + 1 < NT; j += 2) {
    SBAR(); qkt(pB0, pB1, K_lds + SHM_K, qr, r32, hi);
    finishSM(pA0, pA1, alA, l_reg, pa); SBAR();
    SLOAD(SO, (j + SDEPTH) * KVBLK); SBAR();
    pv_d0(o, V_lds, pa, r32, hi); partialSM(pB0, pB1, m_reg, mnB, alB);
    __syncthreads(); SWAIT(); SWRITE(0, SE);
    RESC(alB); __syncthreads();
    SBAR(); qkt(pA0, pA1, K_lds, qr, r32, hi);
    finishSM(pB0, pB1, alB, l_reg, pa); SBAR();
    if (SDEPTH == 1 || j + 3 < NT) SLOAD(SE, (j + 1 + SDEPTH) * KVBLK); SBAR();
    pv_d0(o, V_lds + SHM_V, pa, r32, hi); partialSM(pA0, pA1, m_reg, mnA, alA);
    __syncthreads(); SWAIT(); SWRITE(1, SO);
    RESC(alA); __syncthreads();
  }
  SBAR(); qkt(pB0, pB1, K_lds + SHM_K, qr, r32, hi);
  finishSM(pA0, pA1, alA, l_reg, pa); SBAR();
  pv_d0(o, V_lds, pa, r32, hi); partialSM(pB0, pB1, m_reg, mnB, alB);
  __syncthreads(); RESC(alB);
  finishSM(pB0, pB1, alB, l_reg, pa); SBAR();
  pv_d0(o, V_lds + SHM_V, pa, r32, hi);
  if (hi == 0) li_l[r32] = l_reg; asm volatile("s_waitcnt lgkmcnt(0)" ::: "memory");
  float rli[16];
#pragma unroll
  for (int r = 0; r < 16; ++r) rli[r] = 32.f * __builtin_amdgcn_rcpf(li_l[crow(r, hi)]);
  bf16_t* Ow = Ob + (long)(wid * QBLK) * LDO;
#pragma unroll
  for (int r = 0; r < 16; ++r) { int orow = crow(r, hi);
    for (int d0 = 0; d0 < 4; ++d0) Ow[(long)orow * LDO + d0 * 32 + r32] = f2bf(o[d0][r] * rli[r]); }
  asm volatile("s_waitcnt vmcnt(0)" ::: "memory");
  __syncthreads();
#undef SLOAD
#undef SWRITE
#undef SWAIT
#undef RESC
}
}

template <int K, int NT>
__device__ __forceinline__ void mma_tile(f32x4 (&acc)[4][NT], const LAS bf16_t* A, int lda, const LAS bf16_t* Bt, int ldb, int wr, int wc, int fr, int fq) {
#pragma unroll 1
    for (int k0 = 0; k0 < K; k0 += 32) {
        bf16x8 a[4], b[NT];
#pragma unroll
        for (int m = 0; m < 4; ++m) a[m] = *(const LAS bf16x8*)(A + (64 * wr + 16 * m + fr) * lda + k0 + fq * 8);
#pragma unroll
        for (int n = 0; n < NT; ++n) b[n] = *(const LAS bf16x8*)(Bt + (16 * NT * wc + 16 * n + fr) * ldb + k0 + fq * 8);
#pragma unroll
        for (int m = 0; m < 4; ++m)
#pragma unroll
            for (int n = 0; n < NT; ++n) acc[m][n] = __builtin_amdgcn_mfma_f32_16x16x32_bf16(a[m], b[n], acc[m][n], 0, 0, 0);
    }
}
template <int NT> __device__ __forceinline__ void zero_acc(f32x4 (&acc)[4][NT]) {
#pragma unroll
    for (int m = 0; m < 4; ++m)
#pragma unroll
        for (int n = 0; n < NT; ++n) acc[m][n] = (f32x4){0.f, 0.f, 0.f, 0.f};
}
template <int R, int C> __device__ __forceinline__ void stage_N(LAS bf16_t* dst, int ld, const bf16_t* __restrict__ src, size_t ldg) {
    constexpr int CH = C / 8;
    for (int idx = ltid(); idx < R * CH; idx += 512) { const int r = idx / CH, c = (idx % CH) * 8;
        *(LAS u32x4*)(dst + r * ld + c) = *(const u32x4*)(src + (size_t)r * ldg + c); }
}
template <int C, bool SCL> __device__ __forceinline__ void stage_T(LAS bf16_t* dst, int ld, const bf16_t* __restrict__ src, size_t ldg, const LAS float* sc) {
    for (int idx = ltid(); idx < 128 * (C / 8); idx += 512) { const int r = idx & 127, c0 = (idx >> 7) * 8;
        const u32x4 w = *(const u32x4*)(src + (size_t)r * ldg + c0); float f[8]; unpack8(w, f);
        float s = 1.f; if (SCL) s = sc[r];
#pragma unroll
        for (int i = 0; i < 8; ++i) dst[(c0 + i) * ld + r] = f2bf(f[i] * s); }
}
template <int R, int C> __device__ __forceinline__ void ld_N(u32x4 (&r)[R * C / 8 / 512], const bf16_t* __restrict__ src, size_t ldg, int tid) {
    constexpr int CH = C / 8;
#pragma unroll
    for (int i = 0; i < R * CH / 512; ++i) { const int idx = tid + 512 * i, rr = idx / CH, c = (idx % CH) * 8; r[i] = *(const u32x4*)(src + (size_t)rr * ldg + c); }
}
template <int R, int C> __device__ __forceinline__ void st_N(LAS bf16_t* dst, int ld, const u32x4 (&r)[R * C / 8 / 512], int tid) {
    constexpr int CH = C / 8;
#pragma unroll
    for (int i = 0; i < R * CH / 512; ++i) { const int idx = tid + 512 * i, rr = idx / CH, c = (idx % CH) * 8; *(LAS u32x4*)(dst + rr * ld + c) = r[i]; }
}
template <int C> __device__ __forceinline__ void ld_T(u32x4 (&r)[128 * C / 8 / 512], const bf16_t* __restrict__ src, size_t ldg, int tid) {
#pragma unroll
    for (int i = 0; i < 128 * C / 8 / 512; ++i) { const int idx = tid + 512 * i, rr = idx & 127, c0 = (idx >> 7) * 8; r[i] = *(const u32x4*)(src + (size_t)rr * ldg + c0); }
}
template <int C, bool SCL> __device__ __forceinline__ void st_T(LAS bf16_t* dst, int ld, const u32x4 (&r)[128 * C / 8 / 512], const LAS float* sc, int tid) {
#pragma unroll
    for (int i = 0; i < 128 * C / 8 / 512; ++i) { const int idx = tid + 512 * i, rr = idx & 127, c0 = (idx >> 7) * 8;
        if (SCL) { float f[8]; unpack8(r[i], f); const float sv = sc[rr];
#pragma unroll
            for (int k = 0; k < 8; ++k) dst[(c0 + k) * ld + rr] = f2bf(f[k] * sv); }
        else { const unsigned w[4] = {r[i].x, r[i].y, r[i].z, r[i].w};
#pragma unroll
            for (int k = 0; k < 4; ++k) { dst[(c0 + 2 * k) * ld + rr] = (bf16_t)(w[k] & 0xffffu); dst[(c0 + 2 * k + 1) * ld + rr] = (bf16_t)(w[k] >> 16); } } }
}
__device__ __forceinline__ float scan_add64(float v, int lane) {
#pragma unroll
    for (int o = 1; o < 64; o <<= 1) { const float t = __shfl_up(v, o); if (lane >= o) v += t; } return v; }
__device__ __forceinline__ float scan_max64(float v, int lane) {
#pragma unroll
    for (int o = 1; o < 64; o <<= 1) { const float t = __shfl_up(v, o); if (lane >= o) v = fmaxf(v, t); } return v; }

constexpr int CB0 = 0, CB1 = 34816, CB2 = 69632, CB3 = 104448, CVEC = 139264;
constexpr int RQB = 0, RKB = 18432, RST_ = 36864, RVT = 71680, RRT = 106496;

struct Bufs {
    bf16_t *Wl, *H, *Y, *QKML, *RQK, *CQN, *CKVN, *CST, *RST, *PROJ, *Q, *K, *V, *ACT;
    float *X, *RC, *RS, *G, *CLOC, *NLOC, *NST, *MLOC, *BLAST, *MST, *RLOC;
};

__device__ __forceinline__ void mlstm_local(const Bufs& B, int item, LAS unsigned char* lds) {
    const int tid = ltid(), wid = tid >> 6, lane = tid & 63, wr = wid >> 2, wc = wid & 3, fr = lane & 15, fq = lane >> 4;
    const int c = item & 63, h = (item >> 6) & 3, dir = item >> 8, s0 = c * 128;
    LAS bf16_t* T0 = (LAS bf16_t*)(lds + CB0); LAS bf16_t* T1 = (LAS bf16_t*)(lds + CB1); LAS float* ve = (LAS float*)(lds + CVEC);
    u32x4 rk[4], rv[4];
    ld_T<128>(rk, B.QKML + (size_t)s0 * 1024 + 512 + h * 128, 1024, tid);
    ld_T<128>(rv, B.PROJ + (size_t)s0 * NPROJP + PC_MLV + h * 128, NPROJP, tid);
    if (wid == 0) {
        const int l0 = 2 * lane, l1 = l0 + 1, p0 = dir ? 127 - l0 : l0, p1 = dir ? 127 - l1 : l1, gi = 8 * dir + h, gf = gi + 4;
        const float li0 = B.G[(size_t)(s0 + p0) * 16 + gi], lf0 = B.G[(size_t)(s0 + p0) * 16 + gf], li1 = B.G[(size_t)(s0 + p1) * 16 + gi], lf1 = B.G[(size_t)(s0 + p1) * 16 + gf];
        const float t = lf0 + lf1, incl = scan_add64(t, lane), b0 = incl - t + lf0, b1 = incl, btot = __shfl(incl, 63);
        const float w0 = btot - b0 + li0, w1 = btot - b1 + li1, mloc = wave_max(fmaxf(w0, w1));
        ve[p0] = __expf(w0 - mloc); ve[p1] = __expf(w1 - mloc);
        if (lane == 0) { B.MLOC[item] = mloc; B.BLAST[item] = btot; }
    }
    st_T<128, false>(T0, 136, rk, ve, tid);
    __syncthreads();
    st_T<128, true>(T1, 136, rv, ve, tid);
    __syncthreads();
    f32x4 acc[4][2]; zero_acc<2>(acc);
    mma_tile<128, 2>(acc, T1, 136, T0, 136, wr, wc, fr, fq);
    float* dst = B.CLOC + (size_t)item * 16384;
#pragma unroll
    for (int m = 0; m < 4; ++m)
#pragma unroll
        for (int n = 0; n < 2; ++n)
#pragma unroll
            for (int j = 0; j < 4; ++j) dst[(64 * wr + 16 * m + 4 * fq + j) * 128 + 32 * wc + 16 * n + fr] = acc[m][n][j];
    { const int dk = tid >> 2, qd = tid & 3; float s = 0.f;
#pragma unroll
        for (int i = 0; i < 4; ++i) { float kv[8]; unpack8(*(const LAS u32x4*)(T0 + dk * 136 + qd * 32 + i * 8), kv);
#pragma unroll
            for (int k = 0; k < 8; ++k) s += kv[k] * ve[qd * 32 + i * 8 + k]; }
        s += __shfl_xor(s, 1); s += __shfl_xor(s, 2);
        if (qd == 0) B.NLOC[(size_t)item * 128 + dk] = s; }
    __syncthreads();
}

__device__ __forceinline__ void ret_local(const Bufs& B, int item, LAS unsigned char* lds) {
    const int tid = ltid(), wid = tid >> 6, lane = tid & 63, wr = wid >> 2, wc = wid & 3, fr = lane & 15, fq = lane >> 4;
    const int c = item & 63, h = (item >> 6) & 3, dir = item >> 8, s0 = c * 128, hd = dir ? 3 - h : h;
    const float lg = log1pf(-exp2f(-5.f - (float)hd));
    LAS bf16_t* T0 = (LAS bf16_t*)(lds + CB0); LAS bf16_t* T1 = (LAS bf16_t*)(lds + CB1); LAS float* vz = (LAS float*)(lds + CVEC);
    u32x4 rk[2], rv[4];
    ld_T<64>(rk, B.RQK + (size_t)s0 * 512 + 256 + h * 64, 512, tid);
    ld_T<128>(rv, B.PROJ + (size_t)s0 * NPROJP + PC_RV + h * 128, NPROJP, tid);
    if (tid < 128) { const int lp = dir ? 127 - tid : tid; vz[tid] = __expf((float)(127 - lp) * lg); }
    st_T<64, false>(T0, 136, rk, vz, tid);
    __syncthreads();
    st_T<128, true>(T1, 136, rv, vz, tid);
    __syncthreads();
    f32x4 acc[4][1]; zero_acc<1>(acc);
    mma_tile<128, 1>(acc, T1, 136, T0, 136, wr, wc, fr, fq);
    float* dst = B.RLOC + (size_t)item * 8192;
#pragma unroll
    for (int m = 0; m < 4; ++m)
#pragma unroll
        for (int j = 0; j < 4; ++j) dst[(64 * wr + 16 * m + 4 * fq + j) * 64 + 16 * wc + fr] = acc[m][0][j];
    __syncthreads();
}

__device__ __forceinline__ void scan_phase(const Bufs& B) {
    const int gt = lbid() * 512 + ltid();
    if (gt < 131072) {
        const int dh = gt >> 14, idx = gt & 16383, dir = dh >> 2;
        float cst = 0.f, nst = 0.f, m = -1e30f;
#pragma unroll 1
        for (int s0 = 0; s0 < 64; s0 += 16) {
            float cl[16], ml[16], bl[16], nl[16];
#pragma unroll
            for (int u = 0; u < 16; ++u) { const int ch = dir ? 63 - (s0 + u) : s0 + u, it = dh * 64 + ch;
                cl[u] = B.CLOC[(size_t)it * 16384 + idx]; ml[u] = B.MLOC[it]; bl[u] = B.BLAST[it]; nl[u] = idx < 128 ? B.NLOC[(size_t)it * 128 + idx] : 0.f; }
#pragma unroll
            for (int u = 0; u < 16; ++u) { const int ch = dir ? 63 - (s0 + u) : s0 + u, it = dh * 64 + ch;
                B.CST[(size_t)it * 16384 + idx] = f2bf(cst);
                if (idx < 128) { B.NST[(size_t)it * 128 + idx] = nst; if (idx == 0) B.MST[it] = m; }
                const float mnew = fmaxf(bl[u] + m, ml[u]), a = __expf(bl[u] + m - mnew), g = __expf(ml[u] - mnew);
                cst = a * cst + g * cl[u]; nst = a * nst + g * nl[u]; m = mnew; }
        }
    }
    if (gt < 65536) {
        const int dh = gt >> 13, idx = gt & 8191, dir = dh >> 2, h = dh & 3, hd = dir ? 3 - h : h;
        const float cd = __expf(128.f * log1pf(-exp2f(-5.f - (float)hd)));
        float r = 0.f;
#pragma unroll 1
        for (int s0 = 0; s0 < 64; s0 += 16) {
            float rl[16];
#pragma unroll
            for (int u = 0; u < 16; ++u) { const int ch = dir ? 63 - (s0 + u) : s0 + u; rl[u] = B.RLOC[(size_t)(dh * 64 + ch) * 8192 + idx]; }
#pragma unroll
            for (int u = 0; u < 16; ++u) { const int ch = dir ? 63 - (s0 + u) : s0 + u; B.RST[(size_t)(dh * 64 + ch) * 8192 + idx] = f2bf(r); r = cd * r + rl[u]; }
        }
    }
}

__device__ __forceinline__ void mlstm_out(const Bufs& B, const float* __restrict__ g_out, int item, LAS unsigned char* lds) {
    const int tid = ltid(), wid = tid >> 6, lane = tid & 63, wr = wid >> 2, wc = wid & 3, fr = lane & 15, fq = lane >> 4;
    const int c = item >> 2, h = item & 3, s0 = c * 128;
    constexpr float SC = 0.08838834764831845f;
    LAS bf16_t* T0 = (LAS bf16_t*)(lds + CB0); LAS bf16_t* T1 = (LAS bf16_t*)(lds + CB1); LAS bf16_t* T2 = (LAS bf16_t*)(lds + CB2); LAS bf16_t* T3 = (LAS bf16_t*)(lds + CB3);
    LAS float* vea = (LAS float*)(lds + CVEC); LAS float* veM = vea + 256; LAS float* vedn = vea + 512; LAS float* vn = vea + 768; LAS float* vqn = vea + 1024;
    LAS float* vrs = vea + 1280; LAS float* vf = vea + 1408; LAS float* vsc = vea + 1536;
    LAS float* HT = (LAS float*)(lds + CB1);
    const float mst0 = B.MST[(0 * 4 + h) * 64 + c], mst1 = B.MST[(1 * 4 + h) * 64 + c];
    { u32x4 rq[4], rk[4], rv[4], rc[4];
        ld_N<128, 128>(rq, B.QKML + (size_t)s0 * 1024 + h * 128, 1024, tid);
        ld_N<128, 128>(rk, B.QKML + (size_t)s0 * 1024 + 512 + h * 128, 1024, tid);
        ld_T<128>(rv, B.PROJ + (size_t)s0 * NPROJP + PC_MLV + h * 128, NPROJP, tid);
        ld_N<128, 128>(rc, B.CST + (size_t)((0 * 4 + h) * 64 + c) * 16384, 128, tid);
        st_N<128, 128>(T0, 136, rq, tid); st_N<128, 128>(T1, 136, rk, tid); st_T<128, false>(T2, 136, rv, vea, tid); st_N<128, 128>(T3, 136, rc, tid); }
    if (wid < 2) {
        const int dir = wid; const float mst = dir ? mst1 : mst0;
        const int l0 = 2 * lane, l1 = l0 + 1, p0 = dir ? 127 - l0 : l0, p1 = dir ? 127 - l1 : l1, gi = 8 * dir + h, gf = gi + 4;
        const float li0 = B.G[(size_t)(s0 + p0) * 16 + gi], lf0 = B.G[(size_t)(s0 + p0) * 16 + gf], li1 = B.G[(size_t)(s0 + p1) * 16 + gi], lf1 = B.G[(size_t)(s0 + p1) * 16 + gf];
        const float t = lf0 + lf1, incl = scan_add64(t, lane), b0 = incl - t + lf0, b1 = incl;
        const float a0 = li0 - b0, a1 = li1 - b1, inm = scan_max64(fmaxf(a0, a1), lane);
        float exm = __shfl_up(inm, 1); if (lane == 0) exm = -3.0e38f;
        const float A0 = fmaxf(exm, a0), A1 = inm, amax = __shfl(inm, 63), cc = fmaxf(amax, mst);
        const float M0 = fmaxf(A0, mst), M1 = fmaxf(A1, mst);
        vea[dir * 128 + p0] = __expf(a0 - cc); vea[dir * 128 + p1] = __expf(a1 - cc);
        veM[dir * 128 + p0] = __expf(cc - M0) * SC; veM[dir * 128 + p1] = __expf(cc - M1) * SC;
        vedn[dir * 128 + p0] = __expf(-(b0 + M0)); vedn[dir * 128 + p1] = __expf(-(b1 + M1));
        if (lane == 0) vsc[dir] = __expf(mst - cc);
    }
    if (tid < 256) { const int dir = tid >> 7, d = tid & 127; vn[tid] = B.NST[(size_t)((dir * 4 + h) * 64 + c) * 128 + d]; }
    __syncthreads();
    f32x4 accS[4][2]; zero_acc<2>(accS);
    mma_tile<128, 2>(accS, T1, 136, T0, 136, wr, wc, fr, fq);
    { const int row = tid >> 2, qd = tid & 3; float q0 = 0.f, q1 = 0.f;
#pragma unroll
        for (int i = 0; i < 4; ++i) { float qv[8]; unpack8(*(const LAS u32x4*)(T0 + row * 136 + qd * 32 + i * 8), qv);
            const f32x4 n0a = *(const LAS f32x4*)(vn + qd * 32 + i * 8), n0b = *(const LAS f32x4*)(vn + qd * 32 + i * 8 + 4);
            const f32x4 n1a = *(const LAS f32x4*)(vn + 128 + qd * 32 + i * 8), n1b = *(const LAS f32x4*)(vn + 128 + qd * 32 + i * 8 + 4);
#pragma unroll
            for (int k = 0; k < 4; ++k) { q0 += qv[k] * n0a[k] + qv[4 + k] * n0b[k]; q1 += qv[k] * n1a[k] + qv[4 + k] * n1b[k]; } }
        q0 += __shfl_xor(q0, 1); q0 += __shfl_xor(q0, 2); q1 += __shfl_xor(q1, 1); q1 += __shfl_xor(q1, 2);
        if (qd == 0) { vqn[row] = q0; vqn[128 + row] = q1; } }
    __syncthreads();
    f32x4 hacc[4][2]; zero_acc<2>(hacc);
    u32x4 rc1[4]; ld_N<128, 128>(rc1, B.CST + (size_t)((1 * 4 + h) * 64 + c) * 16384, 128, tid);
#pragma unroll 1
    for (int dir = 0; dir < 2; ++dir) {
        if (dir == 1) st_N<128, 128>(T3, 136, rc1, tid);
        const float r = vsc[dir];
#pragma unroll
        for (int m = 0; m < 4; ++m)
#pragma unroll
            for (int n = 0; n < 2; ++n) { const int l = 32 * wc + 16 * n + fr, sb = 64 * wr + 16 * m + 4 * fq;
                const f32x4 e4 = *(const LAS f32x4*)(vea + dir * 128 + sb); float v[4];
#pragma unroll
                for (int j = 0; j < 4; ++j) { const int s = sb + j; const bool ok = dir ? (s >= l) : (s <= l); v[j] = ok ? accS[m][n][j] * e4[j] : 0.f; }
                u32x2 w; w.x = cvt_pk_bf16(v[0], v[1]); w.y = cvt_pk_bf16(v[2], v[3]);
                *(LAS u32x2*)(T1 + l * 136 + sb) = w; }
        __syncthreads();
        { const int row = tid >> 2, qd = tid & 3; float s = 0.f;
#pragma unroll
            for (int i = 0; i < 4; ++i) { float sv[8]; unpack8(*(const LAS u32x4*)(T1 + row * 136 + qd * 32 + i * 8), sv);
#pragma unroll
                for (int k = 0; k < 8; ++k) s += sv[k]; }
            s += __shfl_xor(s, 1); s += __shfl_xor(s, 2);
            if (qd == 0) { const float eM = veM[dir * 128 + row], den = eM * (s + r * vqn[dir * 128 + row]);
                vf[row] = eM / fmaxf(fabsf(den), vedn[dir * 128 + row]); } }
        f32x4 accN[4][2]; zero_acc<2>(accN);
        mma_tile<128, 2>(accN, T0, 136, T3, 136, wr, wc, fr, fq);
#pragma unroll
        for (int m = 0; m < 4; ++m)
#pragma unroll
            for (int n = 0; n < 2; ++n) accN[m][n] *= r;
        mma_tile<128, 2>(accN, T1, 136, T2, 136, wr, wc, fr, fq);
        __syncthreads();
#pragma unroll
        for (int m = 0; m < 4; ++m) { const f32x4 f4 = *(const LAS f32x4*)(vf + 64 * wr + 16 * m + 4 * fq);
#pragma unroll
            for (int n = 0; n < 2; ++n) hacc[m][n] += accN[m][n] * f4; }
        __syncthreads();
    }
    const int erow = tid >> 2, eqd = tid & 3, es = s0 + erow;
    u32x4 og4[4]; f32x4 gp4[8];
    { const bf16_t* og = B.PROJ + (size_t)es * NPROJP + PC_MLO + h * 128 + eqd * 32; const float* gp = g_out + h * 128 + eqd * 32;
#pragma unroll
        for (int i = 0; i < 4; ++i) og4[i] = *(const u32x4*)(og + i * 8);
#pragma unroll
        for (int i = 0; i < 8; ++i) gp4[i] = *(const f32x4*)(gp + i * 4); }
#pragma unroll
    for (int m = 0; m < 4; ++m)
#pragma unroll
        for (int n = 0; n < 2; ++n)
#pragma unroll
            for (int j = 0; j < 4; ++j) HT[(64 * wr + 16 * m + 4 * fq + j) * 132 + 32 * wc + 16 * n + fr] = hacc[m][n][j];
    __syncthreads();
    { float ssq = 0.f; f32x4 x4[8];
#pragma unroll
        for (int i = 0; i < 8; ++i) { x4[i] = *(const LAS f32x4*)(HT + erow * 132 + eqd * 32 + i * 4);
            ssq += x4[i][0] * x4[i][0] + x4[i][1] * x4[i][1] + x4[i][2] * x4[i][2] + x4[i][3] * x4[i][3]; }
        ssq += __shfl_xor(ssq, 1); ssq += __shfl_xor(ssq, 2);
        const float rstd = rsqrtf(ssq * (1.f / 128.f) + EPS_);
        bf16_t* yo = B.Y + (size_t)es * DM + h * 128 + eqd * 32;
#pragma unroll
        for (int i = 0; i < 4; ++i) { float o8[8]; unpack8(og4[i], o8); float r8[8];
#pragma unroll
            for (int k = 0; k < 8; ++k) { const float sg = __builtin_amdgcn_rcpf(1.f + __expf(-o8[k])); r8[k] = sg * x4[2 * i + (k >> 2)][k & 3] * rstd * gp4[2 * i + (k >> 2)][k & 3]; }
            *(u32x4*)(yo + i * 8) = pack8(r8); } }
    __syncthreads();
}

__device__ __forceinline__ void ret_out(const Bufs& B, const float* __restrict__ g_out, int item, LAS unsigned char* lds) {
    const int tid = ltid(), wid = tid >> 6, lane = tid & 63, wr = wid >> 2, wc = wid & 3, fr = lane & 15, fq = lane >> 4;
    const int c = item >> 2, h = item & 3, s0 = c * 128;
    LAS bf16_t* QB = (LAS bf16_t*)(lds + RQB); LAS bf16_t* KB = (LAS bf16_t*)(lds + RKB); LAS bf16_t* ST = (LAS bf16_t*)(lds + RST_); LAS bf16_t* VT = (LAS bf16_t*)(lds + RVT); LAS bf16_t* RT = (LAS bf16_t*)(lds + RRT);
    LAS float* HT = (LAS float*)(lds + RST_); LAS float* vcs = (LAS float*)(lds + CVEC); LAS float* vrw = vcs + 256;
    u32x4 rr1[2];
    { u32x4 rq[2], rk[2], rv[4], rr0[2];
        ld_N<128, 64>(rq, B.RQK + (size_t)s0 * 512 + h * 64, 512, tid);
        ld_N<128, 64>(rk, B.RQK + (size_t)s0 * 512 + 256 + h * 64, 512, tid);
        ld_T<128>(rv, B.PROJ + (size_t)s0 * NPROJP + PC_RV + h * 128, NPROJP, tid);
        ld_N<128, 64>(rr0, B.RST + (size_t)((0 * 4 + h) * 64 + c) * 8192, 64, tid);
        ld_N<128, 64>(rr1, B.RST + (size_t)((1 * 4 + h) * 64 + c) * 8192, 64, tid);
        st_N<128, 64>(QB, 72, rq, tid); st_N<128, 64>(KB, 72, rk, tid); st_T<128, false>(VT, 136, rv, HT, tid); st_N<128, 64>(RT, 72, rr0, tid); }
    if (tid < 256) { const int dir = tid >> 7, p = tid & 127, lp = dir ? 127 - p : p, hd = dir ? 3 - h : h; const float lg = log1pf(-exp2f(-5.f - (float)hd));
        vcs[tid] = __expf(-(float)lp * lg); vrw[tid] = __expf((float)lp * lg); }
    __syncthreads();
    f32x4 accS[4][2]; zero_acc<2>(accS);
    mma_tile<64, 2>(accS, KB, 72, QB, 72, wr, wc, fr, fq);
    f32x4 yacc[4][2]; zero_acc<2>(yacc);
#pragma unroll 1
    for (int dir = 0; dir < 2; ++dir) {
        const int hd = dir ? 3 - h : h; const float gam = 1.f - exp2f(-5.f - (float)hd);
        if (dir == 1) st_N<128, 64>(RT, 72, rr1, tid);
#pragma unroll
        for (int m = 0; m < 4; ++m)
#pragma unroll
            for (int n = 0; n < 2; ++n) { const int l = 32 * wc + 16 * n + fr, sb = 64 * wr + 16 * m + 4 * fq;
                const f32x4 c4 = *(const LAS f32x4*)(vcs + dir * 128 + sb); float v[4];
#pragma unroll
                for (int j = 0; j < 4; ++j) { const int s = sb + j; const bool ok = dir ? (s >= l) : (s <= l); v[j] = ok ? accS[m][n][j] * c4[j] : 0.f; }
                u32x2 w; w.x = cvt_pk_bf16(v[0], v[1]); w.y = cvt_pk_bf16(v[2], v[3]);
                *(LAS u32x2*)(ST + l * 136 + sb) = w; }
        __syncthreads();
        f32x4 accR[4][2]; zero_acc<2>(accR);
        mma_tile<64, 2>(accR, QB, 72, RT, 72, wr, wc, fr, fq);
#pragma unroll
        for (int m = 0; m < 4; ++m)
#pragma unroll
            for (int n = 0; n < 2; ++n) accR[m][n] *= gam;
        mma_tile<128, 2>(accR, ST, 136, VT, 136, wr, wc, fr, fq);
        __syncthreads();
#pragma unroll
        for (int m = 0; m < 4; ++m) { const f32x4 r4 = *(const LAS f32x4*)(vrw + dir * 128 + 64 * wr + 16 * m + 4 * fq);
#pragma unroll
            for (int n = 0; n < 2; ++n) yacc[m][n] += accR[m][n] * r4; }
    }
    const int erow = tid >> 2, eqd = tid & 3, es = s0 + erow;
    u32x4 og4[4]; f32x4 gp4[8];
    { const bf16_t* gg = B.PROJ + (size_t)es * NPROJP + PC_RG + h * 128 + eqd * 32; const float* gp = g_out + h * 128 + eqd * 32;
#pragma unroll
        for (int i = 0; i < 4; ++i) og4[i] = *(const u32x4*)(gg + i * 8);
#pragma unroll
        for (int i = 0; i < 8; ++i) gp4[i] = *(const f32x4*)(gp + i * 4); }
#pragma unroll
    for (int m = 0; m < 4; ++m)
#pragma unroll
        for (int n = 0; n < 2; ++n)
#pragma unroll
            for (int j = 0; j < 4; ++j) HT[(64 * wr + 16 * m + 4 * fq + j) * 132 + 32 * wc + 16 * n + fr] = yacc[m][n][j];
    __syncthreads();
    { float ssq = 0.f; f32x4 x4[8];
#pragma unroll
        for (int i = 0; i < 8; ++i) { x4[i] = *(const LAS f32x4*)(HT + erow * 132 + eqd * 32 + i * 4);
            ssq += x4[i][0] * x4[i][0] + x4[i][1] * x4[i][1] + x4[i][2] * x4[i][2] + x4[i][3] * x4[i][3]; }
        ssq += __shfl_xor(ssq, 1); ssq += __shfl_xor(ssq, 2);
        const float rstd = rsqrtf(ssq * (1.f / 128.f) + EPS_);
        bf16_t* yo = B.Y + (size_t)es * DM + 512 + h * 128 + eqd * 32;
#pragma unroll
        for (int i = 0; i < 4; ++i) { float o8[8]; unpack8(og4[i], o8); float r8[8];
#pragma unroll
            for (int k = 0; k < 8; ++k) { const float sl = o8[k] * __builtin_amdgcn_rcpf(1.f + __expf(-o8[k])); r8[k] = sl * x4[2 * i + (k >> 2)][k & 3] * rstd * gp4[2 * i + (k >> 2)][k & 3]; }
            *(u32x4*)(yo + i * 8) = pack8(r8); } }
    __syncthreads();
}

__device__ __forceinline__ int map_col(int n, int mode) {
    if (mode == 1) { const int h = n / 192, d = n % 192; if (d < 128) return h * 128 + d; const int jj = d - 128; return 1024 + h * 64 + 2 * (jj & 31) + (jj >> 5); }
    if (mode == 2) { const int h = n >> 8, d = n & 255; return d < 128 ? h * 128 + d : 1024 + h * 128 + (d - 128); }
    return n;
}
struct CvtTile { const float* W; bf16_t* dst; const float* gk; int K, N, kt, nt, mode; };
constexpr int TILES_L = 576 + 48 + 32 + 256 + 1024 + 1024;
__device__ __forceinline__ CvtTile cvt_get(const Params& p, int t) {
    const int l = t / TILES_L; int r = t % TILES_L; unsigned char* Wl = p.ws + OFF_W + (size_t)l * SZ_WL; CvtTile c; int nT; c.mode = 0; c.gk = nullptr;
    if (r < 576) { c.W = p.w_in + (size_t)l * DM * NPROJ; c.K = DM; c.N = NPROJ; nT = 18; c.dst = (bf16_t*)(Wl + WO_IN); c.gk = p.g_mix + l * DM; }
    else if ((r -= 576) < 48) { c.W = p.w_q_up + (size_t)l * 512 * 1536; c.K = 512; c.N = 1536; nT = 6; c.mode = 1; c.dst = (bf16_t*)(Wl + WO_Q); }
    else if ((r -= 48) < 32) { c.W = p.w_kv_up + (size_t)l * 256 * 2048; c.K = 256; c.N = 2048; nT = 8; c.mode = 2; c.dst = (bf16_t*)(Wl + WO_KV); }
    else if ((r -= 32) < 256) { c.W = p.w_out + (size_t)l * DM * DM; c.K = DM; c.N = DM; nT = 8; c.dst = (bf16_t*)(Wl + WO_OUT); }
    else if ((r -= 256) < 1024) { c.W = p.w_ff1 + (size_t)l * DM * DFF; c.K = DM; c.N = DFF; nT = 32; c.dst = (bf16_t*)(Wl + WO_1); c.gk = p.g_ffn + l * DM; }
    else { r -= 1024; c.W = p.w_ff2 + (size_t)l * DFF * DM; c.K = DFF; c.N = DM; nT = 8; c.dst = (bf16_t*)(Wl + WO_2); }
    c.kt = r / nT; c.nt = r % nT; return c;
}
__device__ __forceinline__ void cvt_load(const CvtTile& c, f32x4 (&v)[8], int tid) {
#pragma unroll
    for (int i = 0; i < 8; ++i) { const int k = (tid >> 6) + 8 * i, gn = c.nt * 256 + (tid & 63) * 4;
        v[i] = (f32x4){0.f, 0.f, 0.f, 0.f};
        if (gn < c.N) { v[i] = __builtin_nontemporal_load((const f32x4*)(c.W + (size_t)(c.kt * 64 + k) * c.N + gn)); if (c.gk) v[i] = v[i] * c.gk[c.kt * 64 + k]; } }
}
__device__ __forceinline__ void convert_phase(const Params& p, LAS unsigned char* lds) {
    LAS float* T = (LAS float*)lds;
    const int tid = ltid(), G = gridDim.x;
    int t = lbid();
    f32x4 v[8]; CvtTile c;
    if (t < NLAYER * TILES_L) { c = cvt_get(p, t); cvt_load(c, v, tid); }
    while (t < NLAYER * TILES_L) {
#pragma unroll
        for (int i = 0; i < 8; ++i) { const int k = (tid >> 6) + 8 * i, n4 = (tid & 63) * 4;
            T[k * 257 + n4] = v[i][0]; T[k * 257 + n4 + 1] = v[i][1]; T[k * 257 + n4 + 2] = v[i][2]; T[k * 257 + n4 + 3] = v[i][3]; }
        __syncthreads();
        const CvtTile cur = c; const int tn = t + G;
        if (tn < NLAYER * TILES_L) { c = cvt_get(p, tn); cvt_load(c, v, tid); }
#pragma unroll
        for (int i = 0; i < 4; ++i) { const int ch = tid + 512 * i, n = ch >> 3, k8 = (ch & 7) * 8, gn = cur.nt * 256 + n;
            if (gn < cur.N) { float f[8];
#pragma unroll
                for (int j = 0; j < 8; ++j) f[j] = T[(k8 + j) * 257 + n];
                *(u32x4*)(cur.dst + (size_t)map_col(gn, cur.mode) * cur.K + cur.kt * 64 + k8) = pack8(f); } }
        __syncthreads();
        t = tn;
    }
    constexpr int PADV = (NPROJP - NPROJ) * DM * 2 / 16;
    for (int i = lbid() * 512 + tid; i < NLAYER * PADV; i += G * 512) { const int l = i / PADV, j = i % PADV;
        ((u32x4*)(p.ws + OFF_W + (size_t)l * SZ_WL + WO_IN + (size_t)NPROJ * DM * 2))[j] = (u32x4){0u, 0u, 0u, 0u}; }
    for (int i = lbid() * 512 + tid; i < S_ * 32; i += G * 512) { const int s = i >> 5, j = i & 31;
        const float inv = powf(10000.f, -(float)j * (1.f / 32.f)); const float ang = (float)p.pos[s] * inv;
        const double a = (double)ang, tw = 6.283185307179586476925; const double r = a - tw * rint(a / tw); const float rf = (float)r;
        ((float*)(p.ws + OFF_ROPE))[i] = __cosf(rf); ((float*)(p.ws + OFF_ROPE))[S_ * 32 + i] = __sinf(rf); }
    { const int wid = tid >> 6, lane = tid & 63; bf16_t* H = (bf16_t*)(p.ws + OFF_H); unsigned long long* ssqa = (unsigned long long*)(p.ws + OFF_SSQA);
        for (int row = lbid() * 8 + wid; row < S_; row += G * 8) { const float* xr = p.x + (size_t)row * DM; float ssq = 0.f;
#pragma unroll
            for (int i = 0; i < 8; ++i) { const int col = (i * 64 + lane) * 4; const f32x4 x = *(const f32x4*)(xr + col);
                ssq += x[0] * x[0] + x[1] * x[1] + x[2] * x[2] + x[3] * x[3];
                u32x2 w; w.x = cvt_pk_bf16(x[0], x[1]); w.y = cvt_pk_bf16(x[2], x[3]); *(u32x2*)(H + (size_t)row * DM + col) = w; }
            ssq = wave_sum(ssq); if (lane == 0) ssqa[row] = (unsigned long long)(ssq * 1048576.f); } }
}

template <int MODE>
__device__ __forceinline__ void rms_phase(const float* __restrict__ src, const float* __restrict__ g, bf16_t* __restrict__ H, float* __restrict__ Xcopy, float* __restrict__ outf) {
    const int wid = ltid() >> 6, lane = ltid() & 63;
    for (int row = lbid() * 8 + wid; row < S_; row += gridDim.x * 8) {
        const float* xr = src + (size_t)row * DM; f32x4 v[8]; float ssq = 0.f;
#pragma unroll
        for (int i = 0; i < 8; ++i) { v[i] = *(const f32x4*)(xr + (i * 64 + lane) * 4); ssq += v[i][0] * v[i][0] + v[i][1] * v[i][1] + v[i][2] * v[i][2] + v[i][3] * v[i][3]; }
        ssq = wave_sum(ssq);
        const float rstd = rsqrtf(ssq * (1.f / DM) + EPS_);
#pragma unroll
        for (int i = 0; i < 8; ++i) { const int col = (i * 64 + lane) * 4; const f32x4 gv = *(const f32x4*)(g + col);
            const f32x4 y = v[i] * rstd * gv;
            if (MODE == 0) { u32x2 w; w.x = cvt_pk_bf16(y[0], y[1]); w.y = cvt_pk_bf16(y[2], y[3]); *(u32x2*)(H + (size_t)row * DM + col) = w;
                if (Xcopy) *(f32x4*)(Xcopy + (size_t)row * DM + col) = v[i]; }
            else *(f32x4*)(outf + (size_t)row * DM + col) = y; }
    }
}

__device__ __forceinline__ void final_phase(const bf16_t* __restrict__ H, const float* __restrict__ g, float* __restrict__ outf) {
    const int tid = ltid(), wid = tid >> 6, lane = tid & 63;
    for (int row = lbid() * 8 + wid; row < S_; row += gridDim.x * 8) {
        float v[32]; float ssq = 0.f;
#pragma unroll
        for (int i = 0; i < 4; ++i) { float f[8]; unpack8(*(const u32x4*)(H + (size_t)row * DM + (i * 64 + lane) * 8), f);
#pragma unroll
            for (int k = 0; k < 8; ++k) { v[i * 8 + k] = f[k]; ssq += f[k] * f[k]; } }
        ssq = wave_sum(ssq);
        const float rstd = rsqrtf(ssq * (1.f / DM) + EPS_);
#pragma unroll
        for (int i = 0; i < 4; ++i) { const int col = (i * 64 + lane) * 8;
#pragma unroll
            for (int q = 0; q < 2; ++q) { const f32x4 gv = *(const f32x4*)(g + col + q * 4); f32x4 y;
#pragma unroll
                for (int k = 0; k < 4; ++k) y[k] = v[i * 8 + q * 4 + k] * rstd * gv[k];
                *(f32x4*)(outf + (size_t)row * DM + col + q * 4) = y; } }
    }
}

__device__ __forceinline__ void prep_phase(const Params& p, const Bufs& B, int l) {
    const int wid = ltid() >> 6, lane = ltid() & 63;
    const float* wconv = p.w_conv + (size_t)l * 3 * 1024; const float* bg = p.b_gates + l * 16;
    const float* gq = p.g_q_norm + l * 512; const float* gkv = p.g_kv_norm + l * 256;
    for (int s = lbid() * 8 + wid; s < S_; s += gridDim.x * 8) {
        const bf16_t* pr = B.PROJ + (size_t)s * NPROJP;
        const u32x4 z4 = (u32x4){0u, 0u, 0u, 0u};
        u32x4 cm[2], cc[2], cp[2];
#pragma unroll
        for (int hf = 0; hf < 2; ++hf) { const int c0 = lane * 16 + hf * 8;
            cm[hf] = s > 0 ? *(const u32x4*)(pr - NPROJP + c0) : z4; cc[hf] = *(const u32x4*)(pr + c0); cp[hf] = s < S_ - 1 ? *(const u32x4*)(pr + NPROJP + c0) : z4; }
        const int tensor = lane >> 5, head = (lane & 31) >> 3, j0 = (lane & 7) * 4, base = PC_RQ + tensor * 256 + head * 64;
        const u32x2 w1 = *(const u32x2*)(pr + base + j0), w2 = *(const u32x2*)(pr + base + 32 + j0);
        const f32x4 rc4 = *(const f32x4*)(B.RC + (size_t)s * 32 + j0), rs4 = *(const f32x4*)(B.RS + (size_t)s * 32 + j0);
        const u32x4 cqv = *(const u32x4*)(pr + PC_CQ + lane * 8); const u32x2 ckvv = *(const u32x2*)(pr + PC_CKV + lane * 4);
        const int l32 = lane & 31, l16 = lane & 15;
        const bf16_t kr1 = pr[PC_KR + l32], kr2 = pr[PC_KR + 32 + l32]; const float krc = B.RC[(size_t)s * 32 + l32], krs = B.RS[(size_t)s * 32 + l32];
        const bf16_t gt = pr[PC_GATE + l16]; const float bgl = bg[l16];
#pragma unroll
        for (int hf = 0; hf < 2; ++hf) { const int c0 = lane * 16 + hf * 8; float xm[8], x0[8], xp[8], r[8];
            unpack8(cm[hf], xm); unpack8(cc[hf], x0); unpack8(cp[hf], xp);
#pragma unroll
            for (int i = 0; i < 8; ++i) { const float v = xm[i] * wconv[c0 + i] + x0[i] * wconv[1024 + c0 + i] + xp[i] * wconv[2048 + c0 + i]; r[i] = v * __builtin_amdgcn_rcpf(1.f + __expf(-v)); }
            *(u32x4*)(B.QKML + (size_t)s * 1024 + c0) = pack8(r); }
        { const float x1[4] = {bflo(w1.x), bfhi(w1.x), bflo(w1.y), bfhi(w1.y)}, x2[4] = {bflo(w2.x), bfhi(w2.x), bflo(w2.y), bfhi(w2.y)};
            const float sc = tensor ? 0.125f : 1.f; float o1[4], o2[4];
#pragma unroll
            for (int i = 0; i < 4; ++i) { o1[i] = (x1[i] * rc4[i] - x2[i] * rs4[i]) * sc; o2[i] = (x2[i] * rc4[i] + x1[i] * rs4[i]) * sc; }
            u32x2 a, b2; a.x = cvt_pk_bf16(o1[0], o1[1]); a.y = cvt_pk_bf16(o1[2], o1[3]); b2.x = cvt_pk_bf16(o2[0], o2[1]); b2.y = cvt_pk_bf16(o2[2], o2[3]);
            bf16_t* d = B.RQK + (size_t)s * 512 + tensor * 256 + head * 64 + j0; *(u32x2*)d = a; *(u32x2*)(d + 32) = b2; }
        { float f[8]; unpack8(cqv, f); float g4[4] = {bflo(ckvv.x), bfhi(ckvv.x), bflo(ckvv.y), bfhi(ckvv.y)};
            float ssq = 0.f, ssk = g4[0] * g4[0] + g4[1] * g4[1] + g4[2] * g4[2] + g4[3] * g4[3];
#pragma unroll
            for (int i = 0; i < 8; ++i) ssq += f[i] * f[i];
#pragma unroll
            for (int o = 32; o > 0; o >>= 1) { ssq += __shfl_xor(ssq, o); ssk += __shfl_xor(ssk, o); }
            const float rstd = rsqrtf(ssq * (1.f / 512.f) + EPS_), rstk = rsqrtf(ssk * (1.f / 256.f) + EPS_);
#pragma unroll
            for (int i = 0; i < 8; ++i) f[i] = f[i] * rstd * gq[lane * 8 + i];
            *(u32x4*)(B.CQN + (size_t)s * 512 + lane * 8) = pack8(f);
#pragma unroll
            for (int i = 0; i < 4; ++i) g4[i] = g4[i] * rstk * gkv[lane * 4 + i];
            u32x2 o; o.x = cvt_pk_bf16(g4[0], g4[1]); o.y = cvt_pk_bf16(g4[2], g4[3]); *(u32x2*)(B.CKVN + (size_t)s * 256 + lane * 4) = o; }
        if (lane < 32) { const float x1 = bf2f(kr1), x2 = bf2f(kr2);
            const unsigned short w = (unsigned short)(__builtin_amdgcn_cvt_pk_fp8_f32(x1 * krc - x2 * krs, x2 * krc + x1 * krs, 0, false) & 0xffff);
#pragma unroll
            for (int h = 0; h < 8; ++h) *(unsigned short*)((unsigned char*)B.K + ((size_t)h * S_ + s) * 192 + 128 + 2 * lane) = w; }
        if (lane < 16) { float v = bf2f(gt) + bgl;
            if ((lane >> 2) & 1) v = fminf(v, 0.f) - log1pf(__expf(-fabsf(v)));
            B.G[(size_t)s * 16 + lane] = v; }
    }
}

constexpr int NSUB = 8;
constexpr int NPHASE = 2 + NLAYER * NSUB;
__global__ void __launch_bounds__(512) mega_fwd(Params p) {
    extern __shared__ __attribute__((aligned(16))) unsigned char lds_raw[];
    LAS unsigned char* lds = (LAS unsigned char*)lds_raw;
    cg::grid_group grid = cg::this_grid();
    const int G = gridDim.x;
    volatile LAS unsigned* xst = (volatile LAS unsigned*)(lds + LDS_BYTES - 16);
    if (threadIdx.x == 0) { xst[0] = 0u; xst[1] = 0u; }
    if (blockIdx.x == 0) { unsigned* bw = (unsigned*)(p.ws + OFF_BAR); for (int i = threadIdx.x; i < XCD_BAR_WORDS; i += 512) bw[i] = 0u; __threadfence(); }
    __syncthreads();
    XcdBarrier xbar; xbar.bar = (unsigned*)(p.ws + OFF_BAR); xbar.x = 0; xbar.st = xst;
    for (int ph = p.ph_lo; ph < p.ph_hi; ++ph) {
        if (ph > p.ph_lo) { if (ph == p.ph_lo + 1) { grid.sync(); xbar = xcd_barrier_post((unsigned*)(p.ws + OFF_BAR), xst); } else xcd_barrier(xbar); }
        const int bx = lbid();
        unsigned char* ws = p.ws; asm volatile("" : "+s"(ws));
        Bufs B;
        B.H = (bf16_t*)(ws + OFF_H); B.Y = (bf16_t*)(ws + OFF_Y); B.QKML = (bf16_t*)(ws + OFF_QKML); B.RQK = (bf16_t*)(ws + OFF_RQK); B.CQN = (bf16_t*)(ws + OFF_CQN);
        B.CKVN = (bf16_t*)(ws + OFF_CKVN); B.CST = (bf16_t*)(ws + OFF_CST); B.RST = (bf16_t*)(ws + OFF_RST); B.PROJ = (bf16_t*)(ws + OFF_PROJ);
        B.Q = (bf16_t*)(ws + OFF_Q); B.K = (bf16_t*)(ws + OFF_K); B.V = (bf16_t*)(ws + OFF_V); B.ACT = (bf16_t*)(ws + OFF_ACT);
        B.X = (float*)(ws + OFF_X); B.RC = (float*)(ws + OFF_ROPE); B.RS = B.RC + S_ * 32; B.G = (float*)(ws + OFF_G); B.CLOC = (float*)(ws + OFF_CLOC);
        B.NLOC = (float*)(ws + OFF_NLOC); B.NST = (float*)(ws + OFF_NST); B.MLOC = (float*)(ws + OFF_MLOC); B.BLAST = (float*)(ws + OFF_BLAST); B.MST = (float*)(ws + OFF_MST);
        B.RLOC = (float*)(ws + OFF_RLOC); B.Wl = nullptr;
        unsigned long long* ssqa = (unsigned long long*)(ws + OFF_SSQA); unsigned long long* ssqb = (unsigned long long*)(ws + OFF_SSQB);
        if (ph == 0) { convert_phase(p, lds); continue; }
        if (ph == NPHASE - 1) { final_phase(B.H, p.g_final, p.out); continue; }
        const int l = (ph - 1) / NSUB, sub = (ph - 1) % NSUB;
        unsigned char* Wl = ws + OFF_W + (size_t)l * SZ_WL;
        pg8::StaticOrder so;
        switch (sub) {
        case 0: { so.init(S_, NPROJP - 512, G, bx, 6, 2); pg8::Gemm g{B.H, (const bf16_t*)(Wl + WO_IN), S_, NPROJP, DM}; pg8::EpiBf16<0> e{B.PROJ, NPROJP, ssqa}; pg8::gemm_phase(lds, g, so, e); } break;
        case 1: prep_phase(p, B, l); break;
        case 2: {
            if (bx < 192) { so.init(S_, 1536, 192, bx); pg8::Gemm g{B.CQN, (const bf16_t*)(Wl + WO_Q), S_, 1536, 512}; pg8::EpiQup e{(unsigned char*)B.Q, B.RC, B.RS}; pg8::gemm_phase(lds, g, so, e); }
            else { so.init(S_, 512, 64, bx - 192, 0, 6); pg8::Gemm g{B.H, (const bf16_t*)(Wl + WO_IN), S_, NPROJP, DM}; pg8::EpiBf16<0> e{B.PROJ, NPROJP, ssqa}; pg8::gemm_phase(lds, g, so, e); }
            if (bx < 128) { so.init(S_, 1024, 128, bx); pg8::Gemm g{B.CKVN, (const bf16_t*)(Wl + WO_KV), S_, 1024, 256}; pg8::EpiKnope e{(unsigned char*)B.K}; pg8::gemm_phase(lds, g, so, e); }
            else { so.init(1024, S_, 128, bx - 128); pg8::Gemm g{(const bf16_t*)(Wl + WO_KV) + (size_t)1024 * 256, B.CKVN, 1024, S_, 256}; pg8::EpiVT e{(unsigned char*)B.V}; pg8::gemm_phase(lds, g, so, e); }
            if (bx < 192) for (int it = bx; it < 1024; it += 192) { if (it < 512) mlstm_local(B, it, lds); else ret_local(B, it - 512, lds); }
        } break;
        case 3: { scan_phase(B);
            for (int i = bx * 512 + ltid(); i < S_; i += G * 512) { ssqa[i] = 0ull; ssqb[i] = 0ull; } } break;
        case 4: {
            for (int it = bx; it < 256; it += G) mlstm_out(B, p.g_ml_out + l * 512, it, lds);
            for (int it = bx; it < 256; it += G) ret_out(B, p.g_ret_out + l * 512, it, lds);
            for (int it = bx; it < 256; it += G) { const int h = it & 7, qb = it >> 3;
                att::attn_body((const unsigned char*)B.Q + ((size_t)h * S_ + qb * 256) * 192, (const unsigned char*)B.K + (size_t)h * S_ * 192, (const unsigned char*)B.V + (size_t)h * 128 * S_,
                               B.Y + (size_t)(qb * 256) * DM + 1024 + h * 128, S_, (char*)lds_raw); }
        } break;
        case 5: { so.init(S_, DM, G, bx); pg8::Gemm g{B.Y, (const bf16_t*)(Wl + WO_OUT), S_, DM, DM};
 pg8::EpiResid e{B.H, ssqb, DM}; pg8::gemm_phase(lds, g, so, e); } break;
        case 6: { so.init(S_, DFF, G, bx); pg8::Gemm g{B.H, (const bf16_t*)(Wl + WO_1), S_, DFF, DM}; pg8::EpiBf16<1> e{B.ACT, DFF, ssqb}; pg8::gemm_phase(lds, g, so, e); } break;
        case 7: { so.init(S_, DM, G, bx); pg8::Gemm g{B.ACT, (const bf16_t*)(Wl + WO_2), S_, DM, DFF};
            pg8::EpiResid e{B.H, ssqa, DM}; pg8::gemm_phase(lds, g, so, e); } break;
        }
    }
}

#ifndef MK_MULTI
#define MK_MULTI 0
#endif
extern "C" void kernel_launch(void* const* d_in, const int* in_sizes, int n_in, void* d_out, int out_size, void* d_ws, size_t ws_size, hipStream_t stream) {
    static int grid = 0;
    if (grid == 0) {
        if (n_in != 17 || out_size != S_ * DM || ws_size < WS_END) { fprintf(stderr, "kernel_launch: unexpected shapes: n_in %d out %d ws %zu (need %zu)\n", n_in, out_size, ws_size, (size_t)WS_END); grid = -1; return; }
        int dev = 0, cus = 0, per_cu = 0;
        hipGetDevice(&dev); hipDeviceGetAttribute(&cus, hipDeviceAttributeMultiprocessorCount, dev);
        if (hipFuncSetAttribute((const void*)mega_fwd, hipFuncAttributeMaxDynamicSharedMemorySize, LDS_BYTES) != hipSuccess) { fprintf(stderr, "kernel_launch: hipFuncSetAttribute failed\n"); grid = -1; return; }
        if (hipOccupancyMaxActiveBlocksPerMultiprocessor(&per_cu, (const void*)mega_fwd, 512, LDS_BYTES) != hipSuccess || per_cu < 1) { fprintf(stderr, "kernel_launch: occupancy query says %d\n", per_cu); per_cu = 1; }
        (void)hipGetLastError();
        grid = cus * 1;
        fprintf(stderr, "kernel_launch: cus %d per_cu %d grid %d\n", cus, per_cu, grid);
    }
    if (grid < 0) return;
    Params p{};
    p.x = (const float*)d_in[0]; p.pos = (const int*)d_in[1]; p.g_mix = (const float*)d_in[2]; p.w_in = (const float*)d_in[3]; p.b_gates = (const float*)d_in[4];
    p.w_conv = (const float*)d_in[5]; p.g_ml_out = (const float*)d_in[6]; p.g_ret_out = (const float*)d_in[7]; p.g_q_norm = (const float*)d_in[8]; p.w_q_up = (const float*)d_in[9];
    p.g_kv_norm = (const float*)d_in[10]; p.w_kv_up = (const float*)d_in[11]; p.w_out = (const float*)d_in[12]; p.g_ffn = (const float*)d_in[13]; p.w_ff1 = (const float*)d_in[14];
    p.w_ff2 = (const float*)d_in[15]; p.g_final = (const float*)d_in[16]; p.out = (float*)d_out; p.ws = (unsigned char*)d_ws;
#if MK_MULTI
    for (int ph = 0; ph < NPHASE; ++ph) { p.ph_lo = ph; p.ph_hi = ph + 1; hipLaunchKernelGGL(mega_fwd, dim3(grid), dim3(512), LDS_BYTES, stream, p); }
#else
    p.ph_lo = 0; p.ph_hi = NPHASE;
    void* args[] = {&p};
    hipError_t e = hipLaunchCooperativeKernel((const void*)mega_fwd, dim3(grid), dim3(512), args, LDS_BYTES, stream);
    if (e != hipSuccess) fprintf(stderr, "kernel_launch: cooperative launch failed: %s (grid %d)\n", hipGetErrorString(e), grid);
#endif
}
```
